# Optimizing an MI355X kernel written in HIP

```python
import jax, jax.numpy as jnp
from jax import lax
import numpy as np

D_MODEL = 4096
BATCH = 2
SEQ = 4096
DEPTH = 2

HEAD_DIM = 128
D_MIX = D_MODEL
D_ATTN = D_MIX // 2
D_SGU = D_MIX - D_ATTN
N_ATTN_HEADS = D_ATTN // HEAD_DIM
SGU_GROUP_DIM = 128
N_SGU_GROUPS = D_SGU // SGU_GROUP_DIM
SGU_CHUNK = 128
DILATED_CONFIGS = ((128, 1), (512, 4), (2048, 16))
BLOCK = 128
N_IN = 3 * D_ATTN + 2 * D_SGU
D_FF = 256 * ((8 * D_MODEL // 3 + 255) // 256)
CONV_WIDTH = 3
NORM_GROUP = 128
NORM_EPS = 1e-6

kernel_name = "hybrid_dilated_attn_gmlp_convffn"


def rmsnorm(x, g):
    xf = x.astype(jnp.float32)
    y = xf * lax.rsqrt(jnp.mean(xf * xf, axis=-1, keepdims=True) + NORM_EPS)
    return (y * g.astype(jnp.float32)).astype(x.dtype)


def group_rmsnorm(x, g, group):
    shp = x.shape
    xf = x.astype(jnp.float32).reshape(shp[:-1] + (shp[-1] // group, group))
    y = xf * lax.rsqrt(jnp.mean(xf * xf, axis=-1, keepdims=True) + NORM_EPS)
    return (y.reshape(shp) * g.astype(jnp.float32)).astype(x.dtype)


def alibi_slopes(n):
    return 2.0 ** (-8.0 * jnp.arange(1, n + 1, dtype=jnp.float32) / n)


def dilated_window_branch(q, k, v, slopes, window, dilation):
    B, H, S, E = q.shape
    d = dilation
    span = window // d
    L = S // d
    nb = -(-L // BLOCK)
    lp = nb * BLOCK

    def strided(t):
        t = t.reshape(B, H, L, d, E).transpose(0, 1, 3, 2, 4)
        t = jnp.pad(t, ((0, 0), (0, 0), (0, 0), (0, lp - L), (0, 0)))
        return t.reshape(B, H, d, nb, BLOCK, E)

    def with_prev(t):
        prev = jnp.pad(t[:, :, :, :-1], ((0, 0), (0, 0), (0, 0), (1, 0), (0, 0), (0, 0)))
        return jnp.concatenate([prev, t], axis=4)

    qb = strided(q)
    kk = with_prev(strided(k))
    vv = with_prev(strided(v))

    s = jnp.einsum('bhrnqe,bhrnke->bhrnqk', qb, kk).astype(jnp.float32) * (HEAD_DIM ** -0.5)
    qi = jnp.arange(BLOCK)[:, None]
    kj = jnp.arange(2 * BLOCK)[None, :]
    dist = qi + BLOCK - kj
    key_idx = jnp.arange(nb)[:, None, None] * BLOCK + kj[None] - BLOCK
    valid = (dist >= 0) & (dist <= span) & (key_idx >= 0)
    bias = -slopes[:, None, None, None, None] * (dist * d).astype(jnp.float32)[None, None, None]
    s = jnp.where(valid, s + bias, jnp.finfo(jnp.float32).min)
    lse = jax.nn.logsumexp(s, axis=-1)
    p = jnp.exp(s - lse[..., None])
    o = jnp.einsum('bhrnqk,bhrnke->bhrnqe', p, vv.astype(jnp.float32))

    def unstrided(t):
        rest = t.shape[5:]
        t = t.reshape((B, H, d, lp) + rest)[:, :, :, :L]
        t = jnp.swapaxes(t, 2, 3)
        return t.reshape((B, H, S) + rest)

    return unstrided(o), unstrided(lse)


def dilated_attention(q, k, v):
    slopes = alibi_slopes(q.shape[1])
    outs, lses = [], []
    for window, dilation in DILATED_CONFIGS:
        o, lse = dilated_window_branch(q, k, v, slopes, window, dilation)
        outs.append(o)
        lses.append(lse)
    wts = jax.nn.softmax(jnp.stack(lses, axis=0), axis=0)
    o = jnp.einsum('cbhs,cbhse->bhse', wts, jnp.stack(outs, axis=0))
    return o.astype(q.dtype)


def spatial_gating(z, norm_g, w_s, b_s):
    B, S, _ = z.shape
    u, v = jnp.split(z, 2, axis=-1)
    v = group_rmsnorm(v, norm_g, SGU_GROUP_DIM)
    v = v.reshape(B, S // SGU_CHUNK, SGU_CHUNK, N_SGU_GROUPS, SGU_GROUP_DIM)
    w = jnp.tril(w_s)
    mixed = jnp.einsum('gts,bnsgc->bntgc', w, v) + b_s.T[None, None, :, :, None]
    return u * mixed.reshape(B, S, D_SGU)


def mixing_sublayer(h, w_in, sgu_norm_g, w_spatial, b_spatial, mix_norm_g, w_out):
    B, S, _ = h.shape
    z = h @ w_in
    q, k, v, zg = jnp.split(z, [D_ATTN, 2 * D_ATTN, 3 * D_ATTN], axis=-1)

    def heads(t):
        return t.reshape(B, S, N_ATTN_HEADS, HEAD_DIM).transpose(0, 2, 1, 3)

    a = dilated_attention(heads(q), heads(k), heads(v))
    a = a.transpose(0, 2, 1, 3).reshape(B, S, D_ATTN)
    g = spatial_gating(jax.nn.gelu(zg, approximate=False), sgu_norm_g, w_spatial, b_spatial)
    m = jnp.concatenate([a, g], axis=-1)
    m = group_rmsnorm(m, mix_norm_g, NORM_GROUP)
    return m @ w_out


def causal_depthwise_conv(h, w, b):
    S = h.shape[1]
    hp = jnp.pad(h, ((0, 0), (CONV_WIDTH - 1, 0), (0, 0)))
    y = b + w[0] * hp[:, 0:S]
    for j in range(1, CONV_WIDTH):
        y = y + w[j] * hp[:, j:j + S]
    return y


def conv_ffn(h, w_up, conv_w, conv_b, w_down):
    up = causal_depthwise_conv(h @ w_up, conv_w, conv_b)
    gate, val = jnp.split(up, 2, axis=-1)
    return (jax.nn.silu(gate) * val) @ w_down


def setup_inputs(seed: int = 0) -> dict:
    key = jax.random.key(seed)
    ks = jax.random.split(key, 16)
    f32 = jnp.float32
    L = DEPTH
    nrm = lambda k, shp, s: jax.random.normal(k, shp, f32) * s
    return {
        "x": jax.random.normal(ks[0], (BATCH, SEQ, D_MODEL), f32),
        "attn_norm_g": 1.0 + nrm(ks[1], (L, D_MODEL), 0.02),
        "w_in": nrm(ks[2], (L, D_MODEL, N_IN), D_MODEL ** -0.5),
        "sgu_norm_g": 1.0 + nrm(ks[3], (L, D_SGU), 0.02),
        "w_spatial": nrm(ks[4], (L, N_SGU_GROUPS, SGU_CHUNK, SGU_CHUNK), SGU_CHUNK ** -0.5),
        "b_spatial": nrm(ks[5], (L, N_SGU_GROUPS, SGU_CHUNK), 0.02),
        "mix_norm_g": 1.0 + nrm(ks[6], (L, D_MIX), 0.02),
        "w_out": nrm(ks[7], (L, D_MIX, D_MODEL), D_MIX ** -0.5),
        "ffn_norm_g": 1.0 + nrm(ks[8], (L, D_MODEL), 0.02),
        "w_up": nrm(ks[9], (L, D_MODEL, 2 * D_FF), D_MODEL ** -0.5),
        "conv_w": nrm(ks[10], (L, CONV_WIDTH, 2 * D_FF), CONV_WIDTH ** -0.5),
        "conv_b": nrm(ks[11], (L, 2 * D_FF), 0.02),
        "w_down": nrm(ks[12], (L, D_FF, D_MODEL), D_FF ** -0.5),
        "final_norm_g": 1.0 + nrm(ks[13], (D_MODEL,), 0.02),
    }


def reference(x, attn_norm_g, w_in, sgu_norm_g, w_spatial, b_spatial, mix_norm_g, w_out,
              ffn_norm_g, w_up, conv_w, conv_b, w_down, final_norm_g):
    for i in range(DEPTH):
        h = rmsnorm(x, attn_norm_g[i])
        x = x + mixing_sublayer(h, w_in[i], sgu_norm_g[i], w_spatial[i], b_spatial[i],
                                mix_norm_g[i], w_out[i])
        h = rmsnorm(x, ffn_norm_g[i])
        x = x + conv_ffn(h, w_up[i], conv_w[i], conv_b[i], w_down[i])
    return rmsnorm(x, final_norm_g)
```

```cpp
#include <hip/hip_runtime.h>
#include <cstdio>
#include <cstdint>
namespace pg8 {
#define PG8_LAS __attribute__((address_space(3)))
typedef unsigned short bf16_t;
typedef short bf16x8 __attribute__((ext_vector_type(8)));
typedef float f32x4 __attribute__((ext_vector_type(4)));
typedef unsigned u32x4 __attribute__((ext_vector_type(4)));
constexpr int BM = 256, BK = 64, HALF = 128, HTB = HALF * BK * 2  , STAGE_BYTES = 8 * HTB, NXCD = 8, WGM = 8;

__host__ __device__ __forceinline__ int lds_byte(int r, int c) { const int st = (r >> 4) * 2 + (c >> 5), rr = r & 15, cc = c & 31, ob = rr * 64 + cc * 2; return st * 1024 + (ob ^ (((ob >> 9) & 1) << 5)); }
__host__ __device__ __forceinline__ void stage_rc(int b, int& R, int& C) { const int st = b / 1024, sb = b % 1024, swz = sb ^ (((sb >> 9) & 1) << 5); R = (st >> 1) * 16 + swz / 64; C = (st & 1) * 32 + (swz % 64) / 2; }
__host__ __device__ __forceinline__ int perm32(int rho) { const int n = rho >> 4, i = rho & 15; return 8 * (i >> 2) + 4 * n + (i & 3); }

struct Unit { int pm, pn; };
struct Gemm { const bf16_t* A; const bf16_t* Bt; int M, N, K; };

struct StaticOrder {
    int nM, nN, nwg, G, c;
    __host__ __device__ void init(int M, int N, int G_, int c_) { nM = M / BM; nN = N / BM; nwg = nM * nN; G = G_; c = c_; }
    __host__ __device__ bool next(int i, Unit& u) const {
        const long L = (long)i * G + c; if (L >= nwg) return false;
        int wgid = (int)L; { const int q = nwg / NXCD, r = nwg % NXCD, xcd = wgid % NXCD, off = wgid / NXCD; wgid = (xcd < r ? xcd * (q + 1) : r * (q + 1) + (xcd - r) * q) + off; }
        const int nig = WGM * nN, gid = wgid / nig, fm = gid * WGM, gsz = (nM - fm) < WGM ? (nM - fm) : WGM;
        u.pm = fm + ((wgid % nig) % gsz); u.pn = (wgid % nig) / gsz; return true;
    }
    __device__ __forceinline__ void a_ready(const Unit&) const {}
    __device__ __forceinline__ void done(const Unit&) const {}
};
__device__ __forceinline__ unsigned cvt_pk_bf16(float lo, float hi) { unsigned r; asm volatile("v_cvt_pk_bf16_f32 %0, %1, %2" : "=v"(r) : "v"(lo), "v"(hi)); return r; }
typedef float f32x2 __attribute__((ext_vector_type(2)));
__device__ __forceinline__ f32x2 gelu_pk(f32x2 v) {
    const f32x2 av = __builtin_elementwise_abs(v), d = av * 0.2316418882f + 1.0f;
    f32x2 t; t.x = __builtin_amdgcn_rcpf(d.x); t.y = __builtin_amdgcn_rcpf(d.y);
    f32x2 q = t * 0.5307027145f + (-0.7265760135f); q = q * t + 0.7107068705f; q = q * t + (-0.142248368f); q = q * t + 0.127414796f; q = q * t;
    const f32x2 s = (v * v) * (-0.72134752044f);
    f32x2 e; e.x = __builtin_amdgcn_exp2f(s.x); e.y = __builtin_amdgcn_exp2f(s.y);
    const f32x2 m = v * (q * e), r = v - m;
    f32x2 o; o.x = v.x < 0.f ? m.x : r.x; o.y = v.y < 0.f ? m.y : r.y; return o;
}

struct EpiIn {
    static constexpr bool PERM = true, AFTER_DRAIN = false;
    bf16_t* O; long ldc; long gelu_from_pn;
    __device__ __forceinline__ void operator()(const f32x4 (&acc)[2][2][4][2], const Unit& u, int wr, int wc, int fr, int fq) const {
        const int row0 = u.pm * BM + wr * 64 + fr; const int col0 = u.pn * BM + wc * 32 + 8 * fq;
        const bool act = u.pn >= (int)gelu_from_pn;
#pragma unroll
        for (int ai = 0; ai < 2; ++ai)
#pragma unroll
            for (int m = 0; m < 4; ++m) { bf16_t* rowp = O + (size_t)(row0 + ai * HALF + m * 16) * (size_t)ldc + col0;
#pragma unroll
                for (int bj = 0; bj < 2; ++bj) { f32x4 v0 = acc[ai][bj][m][0], v1 = acc[ai][bj][m][1];
                    if (act) { f32x2 a = gelu_pk((f32x2){v0[0], v0[1]}), b = gelu_pk((f32x2){v0[2], v0[3]}), c = gelu_pk((f32x2){v1[0], v1[1]}), d = gelu_pk((f32x2){v1[2], v1[3]});
                        v0 = (f32x4){a.x, a.y, b.x, b.y}; v1 = (f32x4){c.x, c.y, d.x, d.y}; }
                    u32x4 w; w.x = cvt_pk_bf16(v0[0], v0[1]); w.y = cvt_pk_bf16(v0[2], v0[3]); w.z = cvt_pk_bf16(v1[0], v1[1]); w.w = cvt_pk_bf16(v1[2], v1[3]);
                    *(u32x4*)(rowp + bj * HALF) = w; } }
    }
};
struct EpiBf {
    static constexpr bool PERM = true, AFTER_DRAIN = false;
    bf16_t* O; long ldc;
    __device__ __forceinline__ void operator()(const f32x4 (&acc)[2][2][4][2], const Unit& u, int wr, int wc, int fr, int fq) const {
        const int row0 = u.pm * BM + wr * 64 + fr; const int col0 = u.pn * BM + wc * 32 + 8 * fq;
#pragma unroll
        for (int ai = 0; ai < 2; ++ai)
#pragma unroll
            for (int m = 0; m < 4; ++m) { bf16_t* rowp = O + (size_t)(row0 + ai * HALF + m * 16) * (size_t)ldc + col0;
#pragma unroll
                for (int bj = 0; bj < 2; ++bj) { const f32x4 v0 = acc[ai][bj][m][0], v1 = acc[ai][bj][m][1];
                    u32x4 w; w.x = cvt_pk_bf16(v0[0], v0[1]); w.y = cvt_pk_bf16(v0[2], v0[3]); w.z = cvt_pk_bf16(v1[0], v1[1]); w.w = cvt_pk_bf16(v1[2], v1[3]);
                    *(u32x4*)(rowp + bj * HALF) = w; } }
    }
};
struct EpiRes {
    static constexpr bool PERM = false, AFTER_DRAIN = false;
    const float* base; float* out; long ldc;
    __device__ __forceinline__ void operator()(const f32x4 (&acc)[2][2][4][2], const Unit& u, int wr, int wc, int fr, int fq) const {
        const int row0 = u.pm * BM + wr * 64 + fr, col0 = u.pn * BM + wc * 32 + 4 * fq;
#pragma unroll
        for (int ai = 0; ai < 2; ++ai)
#pragma unroll
            for (int m = 0; m < 4; ++m) { const size_t off = (size_t)(row0 + ai * HALF + m * 16) * (size_t)ldc + col0;
#pragma unroll
                for (int bj = 0; bj < 2; ++bj)
#pragma unroll
                    for (int n = 0; n < 2; ++n) { const f32x4 bs = *(const f32x4*)(base + off + bj * HALF + n * 16); *(f32x4*)(out + off + bj * HALF + n * 16) = bs + acc[ai][bj][m][n]; } }
    }
};
template <class Epi, class Sched, bool ALIGN_EPI = false, bool SP2 = false>
__device__ __forceinline__ void gemm_phase(PG8_LAS unsigned char* lds, const Gemm g, const Sched& S, const Epi& E) {
    const int tid = threadIdx.x, wid = __builtin_amdgcn_readfirstlane(tid >> 6), lane = tid & 63, wr = wid >> 2, wc = wid & 3, fr = lane & 15, fq = lane >> 4;
    const int K = g.K, nt = K / BK;
    unsigned voffA[2], voffB[2];
#pragma unroll
    for (int i = 0; i < 2; ++i) { int R, C; stage_rc(tid * 16 + i * 8192, R, C); const int Rb = Epi::PERM ? ((R & ~31) + perm32(R & 31)) : R;
        voffA[i] = (unsigned)(R * K + C) * 2u; voffB[i] = (unsigned)(Rb * K + C) * 2u; }
    const size_t kstep = (size_t)(BK * 2);
    const size_t hstep = (size_t)HALF * K * 2;
    const size_t tstep = 2 * hstep;
    const unsigned ldsw = (unsigned)wid * 1024u;
    const int aoff = lds_byte(wr * 64 + fr, fq * 8), boff = lds_byte(wc * 32 + fr, fq * 8);
#define PG8_SA(b, h) (((b) * 2 + (h)) * HTB)
#define PG8_SB(b, h) ((4 + (b) * 2 + (h)) * HTB)
#define PG8_STAGE(bufoff, gbase, voff) do { _Pragma("unroll") for (int _i = 0; _i < 2; ++_i) \
        __builtin_amdgcn_global_load_lds((const unsigned*)((const char*)(gbase) + (voff)[_i]), (PG8_LAS unsigned*)(lds + (bufoff) + ldsw + _i * 8192), 16, 0, 0); } while (0)
#define PG8_LDA(dst, b, h) do { _Pragma("unroll") for (int m = 0; m < 4; ++m) _Pragma("unroll") for (int k = 0; k < 2; ++k) dst[m][k] = *(const PG8_LAS bf16x8*)(lds + PG8_SA(b, h) + aoff + m * 2048 + k * 1024); } while (0)
#define PG8_LDB(dst, b, h) do { _Pragma("unroll") for (int n = 0; n < 2; ++n) _Pragma("unroll") for (int k = 0; k < 2; ++k) dst[n][k] = *(const PG8_LAS bf16x8*)(lds + PG8_SB(b, h) + boff + n * 2048 + k * 1024); } while (0)
#define PG8_MMA(ai, bj, At, Bt) do { __builtin_amdgcn_s_setprio(1); _Pragma("unroll") for (int m = 0; m < 4; ++m) _Pragma("unroll") for (int n = 0; n < 2; ++n) _Pragma("unroll") for (int k = 0; k < 2; ++k) \
        acc[ai][bj][m][n] = __builtin_amdgcn_mfma_f32_16x16x32_bf16(Bt[n][k], At[m][k], acc[ai][bj][m][n], 0, 0, 0); __builtin_amdgcn_s_setprio(0); } while (0)
#define PG8_WAIT_V(n) asm volatile("s_waitcnt vmcnt(" #n ")" ::: "memory")
#define PG8_WAIT_L(n) asm volatile("s_waitcnt lgkmcnt(" #n ")" ::: "memory")
#define PG8_BAR __builtin_amdgcn_s_barrier()
#define PG8_SCHED __builtin_amdgcn_sched_barrier(0)
    Unit cur, nxt; int ui = 0;
    if (!S.next(0, cur)) return;
    f32x4 acc[2][2][4][2];
#pragma unroll
    for (int a = 0; a < 2; ++a)
#pragma unroll
        for (int b = 0; b < 2; ++b)
#pragma unroll
            for (int m = 0; m < 4; ++m)
#pragma unroll
                for (int n = 0; n < 2; ++n) acc[a][b][m][n] = (f32x4){0.f, 0.f, 0.f, 0.f};
    bf16x8 At[4][2], B0[2][2], B1[2][2];
    const char* cA = (const char*)g.A + (size_t)cur.pm * tstep; const char* cB = (const char*)g.Bt + (size_t)cur.pn * tstep;
    S.a_ready(cur);
    if constexpr (SP2) {
        PG8_STAGE(PG8_SB(0, 0), cB, voffB); PG8_STAGE(PG8_SB(0, 1), cB + hstep, voffB); PG8_STAGE(PG8_SA(0, 0), cA, voffA); PG8_STAGE(PG8_SA(0, 1), cA + hstep, voffA);
        if (wr == 1) PG8_BAR;
        PG8_WAIT_V(2); PG8_BAR;
        PG8_STAGE(PG8_SB(1, 0), cB + kstep, voffB); PG8_STAGE(PG8_SA(1, 0), cA + kstep, voffA); PG8_STAGE(PG8_SB(1, 1), cB + hstep + kstep, voffB);
        PG8_WAIT_V(6); PG8_BAR;
    } else {
        PG8_STAGE(PG8_SB(0, 0), cB, voffB); PG8_STAGE(PG8_SA(0, 0), cA, voffA); PG8_STAGE(PG8_SB(0, 1), cB + hstep, voffB); PG8_STAGE(PG8_SA(0, 1), cA + hstep, voffA);
        if (wr == 1) PG8_BAR;
        PG8_WAIT_V(4); PG8_BAR;
        PG8_STAGE(PG8_SB(1, 0), cB + kstep, voffB); PG8_STAGE(PG8_SA(1, 0), cA + kstep, voffA); PG8_STAGE(PG8_SB(1, 1), cB + hstep + kstep, voffB);
        PG8_WAIT_V(6); PG8_BAR;
    }
    for (;;) {
        const bool has_next = S.next(ui + 1, nxt);
        const char* nA = has_next ? (const char*)g.A + (size_t)nxt.pm * tstep : cA; const char* nB = has_next ? (const char*)g.Bt + (size_t)nxt.pn * tstep : cB;
        for (int t = 0; t < nt; t += 2) {
            const bool last = (t == nt - 2);
            const char* a1 = cA + (size_t)(t + 1) * kstep;
            const char* a2 = last ? nA : cA + (size_t)(t + 2) * kstep; const char* b2 = last ? nB : cB + (size_t)(t + 2) * kstep;
            const char* a3 = a2 + kstep; const char* b3 = b2 + kstep;
            if (last && has_next) S.a_ready(nxt);
            if constexpr (SP2) {
            PG8_LDB(B0, 0, 0); PG8_LDB(B1, 0, 1); PG8_SCHED; PG8_LDA(At, 0, 0); PG8_STAGE(PG8_SA(1, 1), a1 + hstep, voffA);
            PG8_WAIT_V(8); PG8_WAIT_L(0); PG8_BAR; PG8_MMA(0, 0, At, B0); PG8_MMA(0, 1, At, B1); PG8_BAR; PG8_SCHED;
            PG8_LDA(At, 0, 1); PG8_STAGE(PG8_SB(0, 0), b2, voffB); PG8_STAGE(PG8_SB(0, 1), b2 + hstep, voffB); PG8_STAGE(PG8_SA(0, 0), a2, voffA);
            PG8_WAIT_V(8); PG8_WAIT_L(0); PG8_BAR; PG8_MMA(1, 0, At, B0); PG8_MMA(1, 1, At, B1); PG8_BAR; PG8_SCHED;
            PG8_LDB(B0, 1, 0); PG8_LDB(B1, 1, 1); PG8_SCHED; PG8_LDA(At, 1, 0); PG8_STAGE(PG8_SA(0, 1), a2 + hstep, voffA);
            PG8_WAIT_V(8); PG8_WAIT_L(0); PG8_BAR; PG8_MMA(0, 0, At, B0); PG8_MMA(0, 1, At, B1); PG8_BAR; PG8_SCHED;
            PG8_LDA(At, 1, 1); PG8_STAGE(PG8_SB(1, 0), b3, voffB); PG8_STAGE(PG8_SB(1, 1), b3 + hstep, voffB); PG8_STAGE(PG8_SA(1, 0), a3, voffA);
            PG8_WAIT_V(8); PG8_WAIT_L(0); PG8_BAR; PG8_MMA(1, 0, At, B0); PG8_MMA(1, 1, At, B1); PG8_BAR; PG8_SCHED;
            } else {
            PG8_LDB(B0, 0, 0); PG8_SCHED; PG8_LDA(At, 0, 0); PG8_STAGE(PG8_SA(1, 1), a1 + hstep, voffA);
            PG8_WAIT_L(8); PG8_BAR; PG8_WAIT_L(0); PG8_MMA(0, 0, At, B0); PG8_BAR; PG8_SCHED;
            PG8_LDB(B1, 0, 1); PG8_STAGE(PG8_SB(0, 0), b2, voffB);
            PG8_BAR; PG8_WAIT_L(0); PG8_MMA(0, 1, At, B1); PG8_BAR;
            PG8_LDA(At, 0, 1); PG8_STAGE(PG8_SA(0, 0), a2, voffA);
            PG8_BAR; PG8_WAIT_L(0); PG8_MMA(1, 0, At, B0); PG8_BAR; PG8_SCHED;
            PG8_STAGE(PG8_SB(0, 1), b2 + hstep, voffB);
            PG8_WAIT_V(6); PG8_BAR; PG8_MMA(1, 1, At, B1); PG8_BAR;
            PG8_LDB(B0, 1, 0); PG8_SCHED; PG8_LDA(At, 1, 0); PG8_STAGE(PG8_SA(0, 1), a2 + hstep, voffA);
            PG8_WAIT_L(8); PG8_BAR; PG8_WAIT_L(0); PG8_MMA(0, 0, At, B0); PG8_BAR; PG8_SCHED;
            PG8_LDB(B1, 1, 1); PG8_STAGE(PG8_SB(1, 0), b3, voffB);
            PG8_BAR; PG8_WAIT_L(0); PG8_MMA(0, 1, At, B1); PG8_BAR;
            PG8_LDA(At, 1, 1); PG8_STAGE(PG8_SA(1, 0), a3, voffA);
            PG8_BAR; PG8_WAIT_L(0); PG8_MMA(1, 0, At, B0); PG8_BAR; PG8_SCHED;
            PG8_STAGE(PG8_SB(1, 1), b3 + hstep, voffB);
            PG8_WAIT_V(6); PG8_BAR; PG8_MMA(1, 1, At, B1); PG8_BAR;
            }
        }
        if constexpr (ALIGN_EPI) { if (wr == 0) PG8_BAR; }
        if constexpr (!Epi::AFTER_DRAIN) { E(acc, cur, wr, wc, fr, fq); S.done(cur); }
        if (!has_next) break;
#pragma unroll
        for (int a = 0; a < 2; ++a)
#pragma unroll
            for (int b = 0; b < 2; ++b)
#pragma unroll
                for (int m = 0; m < 4; ++m)
#pragma unroll
                    for (int n = 0; n < 2; ++n) acc[a][b][m][n] = (f32x4){0.f, 0.f, 0.f, 0.f};
        cur = nxt; cA = nA; cB = nB; ++ui;
        if constexpr (ALIGN_EPI) { if (wr == 1) PG8_BAR; }
    }
    PG8_WAIT_V(0);
    if constexpr (!ALIGN_EPI) { if (wr == 0) PG8_BAR; }
    PG8_BAR;
    if constexpr (Epi::AFTER_DRAIN) { E.fused(acc, cur, wr, wc, fr, fq, lds, wid, lane); S.done(cur); }
#undef PG8_SA
#undef PG8_SB
#undef PG8_STAGE
#undef PG8_LDA
#undef PG8_LDB
#undef PG8_MMA
#undef PG8_WAIT_V
#undef PG8_WAIT_L
#undef PG8_BAR
#undef PG8_SCHED
}
}

typedef unsigned short bf16;
typedef unsigned v4u __attribute__((ext_vector_type(4)));
typedef float f32x4 __attribute__((ext_vector_type(4)));
constexpr int D_MODEL = 4096, BATCH = 2, SEQ = 4096, DEPTH = 2, HEAD_DIM = 128, D_ATTN = 2048, D_SGU = 2048, NH = 16, NG = 16, CHUNK = 128;
constexpr int N_IN = 10240, D_FF = 11008, N_UP = 2 * D_FF, M_TOK = BATCH * SEQ;
constexpr float NORM_EPS = 1e-6f;
constexpr int ZQ = 0, ZK = 2048, ZV = 4096, ZU = 6144, ZV2 = 8192;

__device__ __forceinline__ unsigned f2bf(float f) { unsigned u = __builtin_bit_cast(unsigned, f); return (u + 0x7fffu + ((u >> 16) & 1u)) >> 16; }
__device__ __forceinline__ unsigned pk2(float lo, float hi) { return f2bf(lo) | (f2bf(hi) << 16); }
__device__ __forceinline__ float bf2f(unsigned short b) { return __builtin_bit_cast(float, (unsigned)b << 16); }
__device__ __forceinline__ float bflo(unsigned w) { return __builtin_bit_cast(float, w << 16); }
__device__ __forceinline__ float bfhi(unsigned w) { return __builtin_bit_cast(float, w & 0xffff0000u); }
__device__ __forceinline__ float wave_sum(float v) {
#pragma unroll
    for (int o = 1; o < 64; o <<= 1) v += __shfl_xor(v, o);
    return v;
}
__device__ __forceinline__ float wave_max(float v) {
#pragma unroll
    for (int o = 1; o < 64; o <<= 1) v = fmaxf(v, __shfl_xor(v, o));
    return v;
}

struct CvtJob { const float* W; bf16* WT; int K, N; };
struct CvtArgs { CvtJob j[8]; int first[9]; int pad; };
__global__ __launch_bounds__(256) void k_convert(CvtArgs a) {
    __shared__ float scr_all[4][64 * 33];
    const int wave = threadIdx.x >> 6, lane = threadIdx.x & 63;
    float* scr = scr_all[wave];
    const int total = a.first[8];
    for (int it = blockIdx.x * 4 + wave; it < total; it += gridDim.x * 4) {
        int ji = 0;
#pragma unroll
        for (int q = 1; q < 8; ++q) if (it >= a.first[q]) ji = q;
        const float* W = a.j[ji].W; bf16* WT = a.j[ji].WT; const int K = a.j[ji].K, N = a.j[ji].N; const int item = it - a.first[ji];
        const int nblk = N / 32, kb = item / nblk, nb = item % nblk, k0 = 64 * kb, n0 = 32 * nb;
#pragma unroll 8
        for (int i = 0; i < 32; ++i) { const int kk = 2 * i + (lane >> 5); scr[kk * 33 + (lane & 31)] = W[(size_t)(k0 + kk) * N + n0 + (lane & 31)]; }
        __builtin_amdgcn_wave_barrier(); asm volatile("s_waitcnt lgkmcnt(0)" ::: "memory");
        const int c = lane & 7;
#pragma unroll
        for (int j = 0; j < 4; ++j) { const int n = (lane >> 3) + 8 * j; const float* s = scr + (8 * c) * 33 + n;
            v4u o; o.x = pk2(s[0 * 33], s[1 * 33]); o.y = pk2(s[2 * 33], s[3 * 33]); o.z = pk2(s[4 * 33], s[5 * 33]); o.w = pk2(s[6 * 33], s[7 * 33]);
            *(v4u*)(WT + (size_t)(n0 + n) * K + k0 + 8 * c) = o; }
        __builtin_amdgcn_wave_barrier(); asm volatile("s_waitcnt lgkmcnt(0)" ::: "memory");
    }
}

template <bool OUT_BF16> __global__ __launch_bounds__(256) void k_rmsnorm(const float* x, const float* g, void* out) {
    const int row = blockIdx.x * 4 + (threadIdx.x >> 6), lane = threadIdx.x & 63;
    const f32x4* xr = (const f32x4*)(x + (size_t)row * D_MODEL) + lane;
    f32x4 v[16]; float s = 0.f;
#pragma unroll
    for (int j = 0; j < 16; ++j) { v[j] = xr[64 * j]; s += (v[j].x * v[j].x + v[j].y * v[j].y) + (v[j].z * v[j].z + v[j].w * v[j].w); }
    const float rstd = rsqrtf(wave_sum(s) * (1.f / D_MODEL) + NORM_EPS);
    const f32x4* gr = (const f32x4*)g + lane;
#pragma unroll
    for (int j = 0; j < 16; ++j) { const f32x4 gg = gr[64 * j]; f32x4 y = v[j] * rstd * gg;
        if (OUT_BF16) { unsigned long long* o8 = (unsigned long long*)((bf16*)out + (size_t)row * D_MODEL) + lane + 64 * j; *o8 = (unsigned long long)pk2(y.x, y.y) | ((unsigned long long)pk2(y.z, y.w) << 32); }
        else { ((f32x4*)((float*)out + (size_t)row * D_MODEL))[lane + 64 * j] = y; } }
}

__global__ __launch_bounds__(256) void k_attn_naive(const bf16* Z, const float* mixg, bf16* Mx) {
    __shared__ float qs[4][HEAD_DIM];
    const int w = threadIdx.x >> 6, lane = threadIdx.x & 63;
    const int gw = blockIdx.x * 4 + w; const int h = gw & 15, row = gw >> 4, t = row & (SEQ - 1);
    { const unsigned qq = *(const unsigned*)(Z + (size_t)row * N_IN + ZQ + h * HEAD_DIM + 2 * lane); qs[w][2 * lane] = bflo(qq); qs[w][2 * lane + 1] = bfhi(qq); }
    __builtin_amdgcn_wave_barrier(); asm volatile("s_waitcnt lgkmcnt(0)" ::: "memory");
    const float slope = exp2f(-0.5f * (float)(h + 1)), scale = 0.08838834764831845f;
    float sc[7];
#pragma unroll
    for (int i = 0; i < 7; ++i) {
        const int p = i * 64 + lane; const int c = p / 129, j = p - c * 129; const int d = (c == 0) ? 1 : ((c == 1) ? 4 : 16);
        const int pos = t - d * j; const bool valid = (p < 387) && (pos >= 0);
        float s = -INFINITY;
        if (valid) {
            const v4u* kp = (const v4u*)(Z + (size_t)(row - d * j) * N_IN + ZK + h * HEAD_DIM); float dot = 0.f;
#pragma unroll
            for (int e = 0; e < 16; ++e) { const v4u kv = kp[e]; const float* q = &qs[w][8 * e];
                dot += q[0] * bflo(kv.x) + q[1] * bfhi(kv.x) + q[2] * bflo(kv.y) + q[3] * bfhi(kv.y) + q[4] * bflo(kv.z) + q[5] * bfhi(kv.z) + q[6] * bflo(kv.w) + q[7] * bfhi(kv.w); }
            s = dot * scale - slope * (float)(d * j);
        }
        sc[i] = s;
    }
    float mx = sc[0];
#pragma unroll
    for (int i = 1; i < 7; ++i) mx = fmaxf(mx, sc[i]);
    mx = wave_max(mx);
    float l = 0.f;
#pragma unroll
    for (int i = 0; i < 7; ++i) { sc[i] = (sc[i] == -INFINITY) ? 0.f : __expf(sc[i] - mx); l += sc[i]; }
    l = wave_sum(l);
    float o0 = 0.f, o1 = 0.f;
#pragma unroll
    for (int i = 0; i < 7; ++i) {
        for (int src = 0; src < 64; ++src) {
            const float pp = __shfl(sc[i], src);
            if (pp != 0.f) {
                const int p = i * 64 + src; const int c = p / 129, j = p - c * 129; const int d = (c == 0) ? 1 : ((c == 1) ? 4 : 16);
                const unsigned vv = *(const unsigned*)(Z + (size_t)(row - d * j) * N_IN + ZV + h * HEAD_DIM + 2 * lane);
                o0 += pp * bflo(vv); o1 += pp * bfhi(vv);
            }
        }
    }
    const float inv = 1.f / l; o0 *= inv; o1 *= inv;
    const float rstd = rsqrtf(wave_sum(o0 * o0 + o1 * o1) * (1.f / HEAD_DIM) + NORM_EPS);
    const int col = h * HEAD_DIM + 2 * lane;
    *(unsigned*)(Mx + (size_t)row * D_MODEL + col) = pk2(o0 * rstd * mixg[col], o1 * rstd * mixg[col + 1]);
}

constexpr int SGU_LDS = (CHUNK * 129 + CHUNK) * 4;
__global__ __launch_bounds__(256) void k_sgu_naive(const bf16* Z, const float* sgug, const float* Ws, const float* bs, const float* mixg, bf16* Mx) {
    extern __shared__ __attribute__((aligned(16))) float sl[];
    float* vn = sl; float* rs = sl + CHUNK * 129;
    const int g = blockIdx.x & 15, bn = blockIdx.x >> 4; const int row0 = bn * CHUNK;
    const int tid = threadIdx.x, tt = tid >> 1, hf = tid & 1;
    { const bf16* vp = Z + (size_t)(row0 + tt) * N_IN + ZV2 + g * 128 + hf * 64; float ss = 0.f;
      for (int c = 0; c < 64; ++c) { const float x = bf2f(vp[c]); ss += x * x; }
      ss += __shfl_xor(ss, 1);
      if (hf == 0) rs[tt] = rsqrtf(ss * (1.f / 128.f) + NORM_EPS); }
    __syncthreads();
    { const bf16* vp = Z + (size_t)(row0 + tt) * N_IN + ZV2 + g * 128 + hf * 64; const float r = rs[tt];
      for (int c = 0; c < 64; ++c) vn[tt * 129 + hf * 64 + c] = bf2f(vp[c]) * r * sgug[g * 128 + hf * 64 + c]; }
    __syncthreads();
    float acc[64];
#pragma unroll
    for (int c = 0; c < 64; ++c) acc[c] = 0.f;
    const float* wrow = Ws + ((size_t)g * CHUNK + tt) * CHUNK;
    for (int s = 0; s <= tt; ++s) { const float wv = wrow[s]; const float* vr = vn + s * 129 + hf * 64;
#pragma unroll
        for (int c = 0; c < 64; ++c) acc[c] += wv * vr[c]; }
    const float bb = bs[g * CHUNK + tt];
    const bf16* up = Z + (size_t)(row0 + tt) * N_IN + ZU + g * 128 + hf * 64; float ss = 0.f;
#pragma unroll
    for (int c = 0; c < 64; ++c) { acc[c] = bf2f(up[c]) * (acc[c] + bb); ss += acc[c] * acc[c]; }
    ss += __shfl_xor(ss, 1);
    const float rstd = rsqrtf(ss * (1.f / 128.f) + NORM_EPS);
    bf16* op = Mx + (size_t)(row0 + tt) * D_MODEL + D_ATTN + g * 128 + hf * 64; const float* mg = mixg + D_ATTN + g * 128 + hf * 64;
#pragma unroll
    for (int c = 0; c < 64; c += 2) *(unsigned*)(op + c) = pk2(acc[c] * rstd * mg[c], acc[c + 1] * rstd * mg[c + 1]);
}

__global__ __launch_bounds__(256) void k_convgate(const bf16* UP, const float* cw, const float* cb, bf16* ACT) {
    const int per_row = D_FF / 8; const size_t total = (size_t)M_TOK * per_row;
    for (size_t i = (size_t)blockIdx.x * 256 + threadIdx.x; i < total; i += (size_t)gridDim.x * 256) {
        const int row = (int)(i / per_row), c = (int)(i % per_row) * 8; const int t = row & (SEQ - 1);
        float yg[8], yv[8];
#pragma unroll
        for (int e = 0; e < 8; ++e) { yg[e] = cb[c + e]; yv[e] = cb[D_FF + c + e]; }
#pragma unroll
        for (int j = 0; j < 3; ++j) { const int dt = 2 - j; if (t - dt < 0) continue;
            const v4u a = *(const v4u*)(UP + (size_t)(row - dt) * N_UP + c), b = *(const v4u*)(UP + (size_t)(row - dt) * N_UP + D_FF + c);
            const float* wg = cw + (size_t)j * N_UP + c; const float* wv = wg + D_FF;
            const unsigned aw[4] = {a.x, a.y, a.z, a.w}, bw[4] = {b.x, b.y, b.z, b.w};
#pragma unroll
            for (int e = 0; e < 4; ++e) { yg[2 * e] += wg[2 * e] * bflo(aw[e]); yg[2 * e + 1] += wg[2 * e + 1] * bfhi(aw[e]); yv[2 * e] += wv[2 * e] * bflo(bw[e]); yv[2 * e + 1] += wv[2 * e + 1] * bfhi(bw[e]); } }
        float r[8];
#pragma unroll
        for (int e = 0; e < 8; ++e) { const float gg = yg[e]; r[e] = gg / (1.f + __expf(-gg)) * yv[e]; }
        v4u o; o.x = pk2(r[0], r[1]); o.y = pk2(r[2], r[3]); o.z = pk2(r[4], r[5]); o.w = pk2(r[6], r[7]);
        *(v4u*)(ACT + (size_t)row * D_FF + c) = o;
    }
}

struct GemmArgs { const bf16* A; const bf16* Bt; int M, N, K, pad; };
template <class Epi> __global__ __launch_bounds__(512, 2) void k_gemm(GemmArgs ga, Epi E) {
    extern __shared__ __attribute__((aligned(16))) unsigned char shm[];
    pg8::Gemm g{ga.A, ga.Bt, ga.M, ga.N, ga.K};
    pg8::StaticOrder S; S.init(ga.M, ga.N, (int)gridDim.x, (int)blockIdx.x);
    pg8::gemm_phase<Epi, pg8::StaticOrder, true, true>((PG8_LAS unsigned char*)shm, g, S, E);
}
template <class Epi> static void launch_gemm(const bf16* A, const bf16* Bt, int M, int N, int K, const Epi& E, int grid, hipStream_t st) {
    static bool attr = false;
    if (!attr) { (void)hipFuncSetAttribute((const void*)k_gemm<Epi>, hipFuncAttributeMaxDynamicSharedMemorySize, pg8::STAGE_BYTES); attr = true; }
    GemmArgs ga{A, Bt, M, N, K, 0};
    hipLaunchKernelGGL((k_gemm<Epi>), dim3(grid), dim3(512), pg8::STAGE_BYTES, st, ga, E);
}

extern "C" void kernel_launch(void* const* d_in, const int* in_sizes, int n_in, void* d_out, int out_size, void* d_ws, size_t ws_size, hipStream_t stream) {
    const float* x = (const float*)d_in[0]; const float* attn_g = (const float*)d_in[1]; const float* w_in = (const float*)d_in[2]; const float* sgu_g = (const float*)d_in[3];
    const float* w_sp = (const float*)d_in[4]; const float* b_sp = (const float*)d_in[5]; const float* mix_g = (const float*)d_in[6]; const float* w_out = (const float*)d_in[7];
    const float* ffn_g = (const float*)d_in[8]; const float* w_up = (const float*)d_in[9]; const float* conv_w = (const float*)d_in[10]; const float* conv_b = (const float*)d_in[11];
    const float* w_down = (const float*)d_in[12]; const float* fin_g = (const float*)d_in[13];
    float* X = (float*)d_out;
    constexpr size_t MiB = 1u << 20;
    constexpr size_t SZ_WIN = (size_t)N_IN * D_MODEL * 2, SZ_WOUT = (size_t)D_MODEL * D_MODEL * 2, SZ_WUP = (size_t)N_UP * D_MODEL * 2, SZ_WDN = (size_t)D_MODEL * D_FF * 2;
    constexpr size_t OFF_WIN = 1 * MiB, OFF_WOUT = OFF_WIN + 2 * SZ_WIN, OFF_WUP = OFF_WOUT + 2 * SZ_WOUT, OFF_WDN = OFF_WUP + 2 * SZ_WUP, OFF_H = OFF_WDN + 2 * SZ_WDN;
    constexpr size_t OFF_Z = OFF_H + (size_t)M_TOK * D_MODEL * 2, OFF_MX = OFF_Z + (size_t)M_TOK * N_IN * 2, OFF_UP = OFF_MX + (size_t)M_TOK * D_MODEL * 2;
    constexpr size_t OFF_ACT = OFF_UP + (size_t)M_TOK * N_UP * 2, WS_END = OFF_ACT + (size_t)M_TOK * D_FF * 2;
    static int grid = 0;
    if (grid == 0) {
        if (n_in != 14 || out_size != M_TOK * D_MODEL || ws_size < WS_END) { fprintf(stderr, "kernel_launch: unexpected shapes (n_in %d out %d ws %zu need %zu)\n", n_in, out_size, ws_size, (size_t)WS_END); grid = -1; return; }
        int dev = 0, cus = 0; if (hipGetDevice(&dev) != hipSuccess || hipDeviceGetAttribute(&cus, hipDeviceAttributeMultiprocessorCount, dev) != hipSuccess) { grid = -1; return; }
        (void)hipFuncSetAttribute((const void*)k_sgu_naive, hipFuncAttributeMaxDynamicSharedMemorySize, SGU_LDS);
        grid = cus;
    }
    if (grid < 0) return;
    unsigned char* ws = (unsigned char*)d_ws;
    bf16* Win_t = (bf16*)(ws + OFF_WIN); bf16* Wout_t = (bf16*)(ws + OFF_WOUT); bf16* Wup_t = (bf16*)(ws + OFF_WUP); bf16* Wdn_t = (bf16*)(ws + OFF_WDN);
    bf16* H = (bf16*)(ws + OFF_H); bf16* Z = (bf16*)(ws + OFF_Z); bf16* Mx = (bf16*)(ws + OFF_MX); bf16* UP = (bf16*)(ws + OFF_UP); bf16* ACT = (bf16*)(ws + OFF_ACT);
    { CvtArgs a{}; int acc = 0;
      for (int l = 0; l < DEPTH; ++l) {
          a.j[4 * l + 0] = CvtJob{w_in + (size_t)l * D_MODEL * N_IN, Win_t + (size_t)l * N_IN * D_MODEL, D_MODEL, N_IN};
          a.j[4 * l + 1] = CvtJob{w_out + (size_t)l * D_MODEL * D_MODEL, Wout_t + (size_t)l * D_MODEL * D_MODEL, D_MODEL, D_MODEL};
          a.j[4 * l + 2] = CvtJob{w_up + (size_t)l * D_MODEL * N_UP, Wup_t + (size_t)l * N_UP * D_MODEL, D_MODEL, N_UP};
          a.j[4 * l + 3] = CvtJob{w_down + (size_t)l * D_FF * D_MODEL, Wdn_t + (size_t)l * D_MODEL * D_FF, D_FF, D_MODEL}; }
      for (int q = 0; q < 8; ++q) { a.first[q] = acc; acc += (a.j[q].K / 64) * (a.j[q].N / 32); }
      a.first[8] = acc; a.pad = 0;
      hipLaunchKernelGGL(k_convert, dim3(4096), dim3(256), 0, stream, a); }
    const float* xin = x;
    for (int l = 0; l < DEPTH; ++l) {
        hipLaunchKernelGGL((k_rmsnorm<true>), dim3(M_TOK / 4), dim3(256), 0, stream, xin, attn_g + (size_t)l * D_MODEL, (void*)H);
        { pg8::EpiIn E{Z, (long)N_IN, 24}; launch_gemm(H, Win_t + (size_t)l * N_IN * D_MODEL, M_TOK, N_IN, D_MODEL, E, grid, stream); }
        hipLaunchKernelGGL(k_attn_naive, dim3(M_TOK * NH / 4), dim3(256), 0, stream, (const bf16*)Z, mix_g + (size_t)l * D_MODEL, Mx);
        hipLaunchKernelGGL(k_sgu_naive, dim3(BATCH * (SEQ / CHUNK) * NG), dim3(256), SGU_LDS, stream, (const bf16*)Z, sgu_g + (size_t)l * D_SGU, w_sp + (size_t)l * NG * CHUNK * CHUNK, b_sp + (size_t)l * NG * CHUNK, mix_g + (size_t)l * D_MODEL, Mx);
        { pg8::EpiRes E{xin, X, (long)D_MODEL}; launch_gemm(Mx, Wout_t + (size_t)l * D_MODEL * D_MODEL, M_TOK, D_MODEL, D_MODEL, E, grid, stream); }
        xin = X;
        hipLaunchKernelGGL((k_rmsnorm<true>), dim3(M_TOK / 4), dim3(256), 0, stream, (const float*)X, ffn_g + (size_t)l * D_MODEL, (void*)H);
        { pg8::EpiBf E{UP, (long)N_UP}; launch_gemm(H, Wup_t + (size_t)l * N_UP * D_MODEL, M_TOK, N_UP, D_MODEL, E, grid, stream); }
        hipLaunchKernelGGL(k_convgate, dim3(8192), dim3(256), 0, stream, (const bf16*)UP, conv_w + (size_t)l * 3 * N_UP, conv_b + (size_t)l * N_UP, ACT);
        { pg8::EpiRes E{X, X, (long)D_MODEL}; launch_gemm(ACT, Wdn_t + (size_t)l * D_MODEL * D_FF, M_TOK, D_MODEL, D_FF, E, grid, stream); }
    }
    hipLaunchKernelGGL((k_rmsnorm<false>), dim3(M_TOK / 4), dim3(256), 0, stream, (const float*)X, fin_g, (void*)X);
}
```

```cpp
#include <hip/hip_runtime.h>
#include <cstdio>
#include <cstdint>
__device__ __forceinline__ int tid_of(int wv) { int t; asm volatile("v_mbcnt_lo_u32_b32 %0, -1, 0\n\tv_mbcnt_hi_u32_b32 %0, -1, %0\n\tv_lshl_add_u32 %0, %1, 6, %0" : "=&v"(t) : "s"(wv)); return t; }
__device__ __forceinline__ void half_swap(float& a, float& b) { asm("s_nop 1\n\tv_permlane32_swap_b32 %0, %1" : "+v"(a), "+v"(b)); }
template <int K> __device__ __forceinline__ float lane_xor(float v) { static_assert(K >= 1 && K <= 16, "lane_xor: within 32 lanes"); return __builtin_bit_cast(float, __builtin_amdgcn_ds_swizzle(__builtin_bit_cast(int, v), (K << 10) | 0x1f)); }
__device__ __forceinline__ float wave_sum(float v) {
    v += lane_xor<1>(v); v += lane_xor<2>(v); v += lane_xor<4>(v); v += lane_xor<8>(v); v += lane_xor<16>(v);
    float a = v, b = v; half_swap(a, b);
    return a + b;
}
namespace pg8 {
#define PG8_LAS __attribute__((address_space(3)))
typedef unsigned short bf16_t;
typedef short bf16x8 __attribute__((ext_vector_type(8)));
typedef float f32x4 __attribute__((ext_vector_type(4)));
typedef unsigned u32x4 __attribute__((ext_vector_type(4)));
constexpr int BM = 256, BK = 64, HALF = 128, HTB = HALF * BK * 2  , STAGE_BYTES = 8 * HTB, NXCD = 8, WGM = 8;

__host__ __device__ __forceinline__ int lds_byte(int r, int c) { const int st = (r >> 4) * 2 + (c >> 5), rr = r & 15, cc = c & 31, ob = rr * 64 + cc * 2; return st * 1024 + (ob ^ (((ob >> 9) & 1) << 5)); }
__host__ __device__ __forceinline__ void stage_rc(int b, int& R, int& C) { const int st = b / 1024, sb = b % 1024, swz = sb ^ (((sb >> 9) & 1) << 5); R = (st >> 1) * 16 + swz / 64; C = (st & 1) * 32 + (swz % 64) / 2; }
__host__ __device__ __forceinline__ int perm32(int rho) { const int n = rho >> 4, i = rho & 15; return 8 * (i >> 2) + 4 * n + (i & 3); }

struct Unit { int pm, pn; };
struct Gemm { const bf16_t* A; const bf16_t* Bt; int M, N, K; };

struct StaticOrder {
    int nM, nN, nwg, G, c;
    __host__ __device__ void init(int M, int N, int G_, int c_) { nM = M / BM; nN = N / BM; nwg = nM * nN; G = G_; c = c_; }
    __host__ __device__ bool next(int i, Unit& u) const {
        const long L = (long)i * G + c; if (L >= nwg) return false;
        int wgid = (int)L; { const int q = nwg / NXCD, r = nwg % NXCD, xcd = wgid % NXCD, off = wgid / NXCD; wgid = (xcd < r ? xcd * (q + 1) : r * (q + 1) + (xcd - r) * q) + off; }
        const int nig = WGM * nN, gid = wgid / nig, fm = gid * WGM, gsz = (nM - fm) < WGM ? (nM - fm) : WGM;
        u.pm = fm + ((wgid % nig) % gsz); u.pn = (wgid % nig) / gsz; return true;
    }
    __device__ __forceinline__ void a_ready(const Unit&) const {}
    __device__ __forceinline__ void done(const Unit&) const {}
};
__device__ __forceinline__ unsigned cvt_pk_bf16(float lo, float hi) { unsigned r; asm volatile("v_cvt_pk_bf16_f32 %0, %1, %2" : "=v"(r) : "v"(lo), "v"(hi)); return r; }
typedef float f32x2 __attribute__((ext_vector_type(2)));
__device__ __forceinline__ f32x2 gelu_pk(f32x2 v) {
    const f32x2 av = __builtin_elementwise_abs(v), d = av * 0.2316418882f + 1.0f;
    f32x2 t; t.x = __builtin_amdgcn_rcpf(d.x); t.y = __builtin_amdgcn_rcpf(d.y);
    f32x2 q = t * 0.5307027145f + (-0.7265760135f); q = q * t + 0.7107068705f; q = q * t + (-0.142248368f); q = q * t + 0.127414796f; q = q * t;
    const f32x2 s = (v * v) * (-0.72134752044f);
    f32x2 e; e.x = __builtin_amdgcn_exp2f(s.x); e.y = __builtin_amdgcn_exp2f(s.y);
    const f32x2 m = v * (q * e), r = v - m;
    f32x2 o; o.x = v.x < 0.f ? m.x : r.x; o.y = v.y < 0.f ? m.y : r.y; return o;
}

struct EpiIn {
    static constexpr bool PERM = true, AFTER_DRAIN = false;
    bf16_t* O; long ldc; long gelu_from_pn; const unsigned long long* rowss; float inv_k, eps;
    __device__ __forceinline__ void operator()(const f32x4 (&acc)[2][2][4][2], const Unit& u, int wr, int wc, int fr, int fq) const {
        const int row0 = u.pm * BM + wr * 64 + fr; const int col0 = u.pn * BM + wc * 32 + 8 * fq;
        const bool act = u.pn >= (int)gelu_from_pn;
#pragma unroll
        for (int ai = 0; ai < 2; ++ai)
#pragma unroll
            for (int m = 0; m < 4; ++m) { bf16_t* rowp = O + (size_t)(row0 + ai * HALF + m * 16) * (size_t)ldc + col0;
                const float rs = __builtin_amdgcn_rsqf((float)rowss[row0 + ai * HALF + m * 16] * inv_k + eps);
#pragma unroll
                for (int bj = 0; bj < 2; ++bj) { f32x4 v0 = acc[ai][bj][m][0] * rs, v1 = acc[ai][bj][m][1] * rs;
                    if (act) { f32x2 a = gelu_pk((f32x2){v0[0], v0[1]}), b = gelu_pk((f32x2){v0[2], v0[3]}), c = gelu_pk((f32x2){v1[0], v1[1]}), d = gelu_pk((f32x2){v1[2], v1[3]});
                        v0 = (f32x4){a.x, a.y, b.x, b.y}; v1 = (f32x4){c.x, c.y, d.x, d.y}; }
                    u32x4 w; w.x = cvt_pk_bf16(v0[0], v0[1]); w.y = cvt_pk_bf16(v0[2], v0[3]); w.z = cvt_pk_bf16(v1[0], v1[1]); w.w = cvt_pk_bf16(v1[2], v1[3]);
                    *(u32x4*)(rowp + bj * HALF) = w; } }
    }
};
struct EpiBf {
    static constexpr bool PERM = true, AFTER_DRAIN = false;
    bf16_t* O; long ldc;
    __device__ __forceinline__ void operator()(const f32x4 (&acc)[2][2][4][2], const Unit& u, int wr, int wc, int fr, int fq) const {
        const int row0 = u.pm * BM + wr * 64 + fr; const int col0 = u.pn * BM + wc * 32 + 8 * fq;
#pragma unroll
        for (int ai = 0; ai < 2; ++ai)
#pragma unroll
            for (int m = 0; m < 4; ++m) { bf16_t* rowp = O + (size_t)(row0 + ai * HALF + m * 16) * (size_t)ldc + col0;
#pragma unroll
                for (int bj = 0; bj < 2; ++bj) { const f32x4 v0 = acc[ai][bj][m][0], v1 = acc[ai][bj][m][1];
                    u32x4 w; w.x = cvt_pk_bf16(v0[0], v0[1]); w.y = cvt_pk_bf16(v0[2], v0[3]); w.z = cvt_pk_bf16(v1[0], v1[1]); w.w = cvt_pk_bf16(v1[2], v1[3]);
                    *(u32x4*)(rowp + bj * HALF) = w; } }
    }
};
typedef int i32x4 __attribute__((ext_vector_type(4)));
__device__ __forceinline__ f32x4 mma1(bf16x8 w, bf16x8 a, f32x4 c) { return __builtin_amdgcn_mfma_f32_16x16x32_bf16(w, a, c, 0, 0, 0); }
__device__ __forceinline__ i32x4 mma1(bf16x8 w, bf16x8 a, i32x4 c) { return __builtin_amdgcn_mfma_i32_16x16x64_i8(__builtin_bit_cast(i32x4, w), __builtin_bit_cast(i32x4, a), c, 0, 0, 0); }
template <class E, class = void> struct AccOf { typedef f32x4 type; };
template <class E> struct AccOf<E, decltype((void)sizeof(typename E::AccT))> { typedef typename E::AccT type; };
template <int CTRL> __device__ __forceinline__ float dpp_f(float oldv, float src) { return __builtin_bit_cast(float, __builtin_amdgcn_update_dpp(__builtin_bit_cast(int, oldv), __builtin_bit_cast(int, src), CTRL, 0xf, 0xf, false)); }
struct EpiConv {
    static constexpr bool PERM = true, AFTER_DRAIN = false;
    bf16_t* ACT; float* U4; const float* cw; const float* cb; long dff; const unsigned long long* rowss; float inv_k, eps;
    __device__ __forceinline__ void operator()(f32x4 (&acc)[2][2][4][2], const Unit& u, int wr, int wc, int fr, int fq) const {
#pragma unroll
        for (int ai = 0; ai < 2; ++ai)
#pragma unroll
            for (int m = 0; m < 4; ++m) { const float rs = __builtin_amdgcn_rsqf((float)rowss[u.pm * BM + ai * HALF + wr * 64 + m * 16 + fr] * inv_k + eps);
#pragma unroll
                for (int bj = 0; bj < 2; ++bj)
#pragma unroll
                    for (int n = 0; n < 2; ++n) acc[ai][bj][m][n] = acc[ai][bj][m][n] * rs; }
        body(acc, u, wr, wc, fr, fq);
    }
    __device__ __forceinline__ void body(f32x4 (&acc)[2][2][4][2], const Unit& u, int wr, int wc, int fr, int fq) const {
        const int ch0 = u.pn * 128 + wc * 32 + 8 * fq;
        const int n2 = 2 * (int)dff;
        { const int slot = (fr < 2) ? fr : fr - 12;
          if (fr < 2 || fr >= 14) {
#pragma unroll
              for (int ai = 0; ai < 2; ++ai) { float* p = U4 + ((size_t)(u.pm * 4 + ai * 2 + wr) * 4 + slot) * (size_t)n2 + ch0;
#pragma unroll
                  for (int bj = 0; bj < 2; ++bj)
#pragma unroll
                      for (int n = 0; n < 2; ++n) *(f32x4*)(p + bj * dff + 4 * n) = (fr < 2) ? acc[ai][bj][0][n] : acc[ai][bj][3][n]; } } }
#pragma unroll
        for (int bj = 0; bj < 2; ++bj) {
            const float* wp = cw + bj * dff + ch0; const float* bp = cb + bj * dff + ch0;
            f32x4 w0[2], w1[2], w2[2], bb[2];
#pragma unroll
            for (int n = 0; n < 2; ++n) { w0[n] = *(const f32x4*)(wp + 4 * n); w1[n] = *(const f32x4*)(wp + n2 + 4 * n); w2[n] = *(const f32x4*)(wp + 2 * (size_t)n2 + 4 * n); bb[n] = *(const f32x4*)(bp + 4 * n); }
#pragma unroll
            for (int ai = 0; ai < 2; ++ai)
#pragma unroll
                for (int m = 3; m >= 0; --m)
#pragma unroll
                    for (int n = 0; n < 2; ++n) { f32x4 y;
#pragma unroll
                        for (int e = 0; e < 4; ++e) { const float x = acc[ai][bj][m][n][e]; const float xp = (m > 0) ? acc[ai][bj][m - 1][n][e] : 0.f;
                            const float p1 = dpp_f<0x111>(dpp_f<0x121>(0.f, xp), x);
                            const float p2 = dpp_f<0x112>(dpp_f<0x122>(0.f, xp), x);
                            y[e] = fmaf(w0[n][e], p2, fmaf(w1[n][e], p1, fmaf(w2[n][e], x, bb[n][e]))); }
                        acc[ai][bj][m][n] = y; }
        }
        const int row0 = u.pm * BM + wr * 64 + fr;
#pragma unroll
        for (int ai = 0; ai < 2; ++ai)
#pragma unroll
            for (int m = 0; m < 4; ++m) { float r[8];
#pragma unroll
                for (int n = 0; n < 2; ++n)
#pragma unroll
                    for (int e = 0; e < 4; ++e) { const float g = acc[ai][0][m][n][e]; r[4 * n + e] = g * __builtin_amdgcn_rcpf(1.f + __builtin_amdgcn_exp2f(-1.4426950408889634f * g)) * acc[ai][1][m][n][e]; }
                u32x4 w; w.x = cvt_pk_bf16(r[0], r[1]); w.y = cvt_pk_bf16(r[2], r[3]); w.z = cvt_pk_bf16(r[4], r[5]); w.w = cvt_pk_bf16(r[6], r[7]);
                *(u32x4*)(ACT + (size_t)(row0 + ai * HALF + m * 16) * (size_t)dff + ch0) = w; }
    }
};
struct EpiIn8 {
    static constexpr bool PERM = true, AFTER_DRAIN = false; typedef i32x4 AccT;
    EpiIn core; const float* sA; const float* sB;
    __device__ __forceinline__ void operator()(i32x4 (&acc)[2][2][4][2], const Unit& u, int wr, int wc, int fr, int fq) const {
        f32x4 cs[2][2];
#pragma unroll
        for (int bj = 0; bj < 2; ++bj)
#pragma unroll
            for (int n = 0; n < 2; ++n) cs[bj][n] = *(const f32x4*)(sB + u.pn * BM + bj * HALF + wc * 32 + 8 * fq + 4 * n);
        f32x4 af[2][2][4][2];
#pragma unroll
        for (int ai = 0; ai < 2; ++ai)
#pragma unroll
            for (int m = 0; m < 4; ++m) { const float rf = sA[u.pm * BM + ai * HALF + wr * 64 + m * 16 + fr];
#pragma unroll
                for (int bj = 0; bj < 2; ++bj)
#pragma unroll
                    for (int n = 0; n < 2; ++n) af[ai][bj][m][n] = __builtin_convertvector(acc[ai][bj][m][n], f32x4) * rf * cs[bj][n]; }
        core(af, u, wr, wc, fr, fq);
    }
};
struct EpiConv8 {
    static constexpr bool PERM = true, AFTER_DRAIN = false; typedef i32x4 AccT;
    EpiConv core; const float* sA; const float* sB;
    __device__ __forceinline__ void operator()(i32x4 (&acc)[2][2][4][2], const Unit& u, int wr, int wc, int fr, int fq) const {
        f32x4 cs[2][2];
#pragma unroll
        for (int bj = 0; bj < 2; ++bj)
#pragma unroll
            for (int n = 0; n < 2; ++n) cs[bj][n] = *(const f32x4*)(sB + u.pn * BM + bj * HALF + wc * 32 + 8 * fq + 4 * n);
        f32x4 af[2][2][4][2];
#pragma unroll
        for (int ai = 0; ai < 2; ++ai)
#pragma unroll
            for (int m = 0; m < 4; ++m) { const int row = u.pm * BM + ai * HALF + wr * 64 + m * 16 + fr;
                const float rf = sA[row] * __builtin_amdgcn_rsqf((float)core.rowss[row] * core.inv_k + core.eps);
#pragma unroll
                for (int bj = 0; bj < 2; ++bj)
#pragma unroll
                    for (int n = 0; n < 2; ++n) af[ai][bj][m][n] = __builtin_convertvector(acc[ai][bj][m][n], f32x4) * rf * cs[bj][n]; }
        core.body(af, u, wr, wc, fr, fq);
    }
};
struct EpiRes {
    static constexpr bool PERM = true, AFTER_DRAIN = false;
    bf16_t* xb; unsigned long long* rowss; long ldc;
    __device__ __forceinline__ void operator()(const f32x4 (&acc)[2][2][4][2], const Unit& u, int wr, int wc, int fr, int fq) const {
        const int row0 = u.pm * BM + wr * 64 + fr, col0 = u.pn * BM + wc * 32 + 8 * fq;
#pragma unroll
        for (int ai = 0; ai < 2; ++ai) {
            u32x4 bs[4][2];
#pragma unroll
            for (int m = 0; m < 4; ++m)
#pragma unroll
                for (int bj = 0; bj < 2; ++bj) bs[m][bj] = *(const u32x4*)(xb + (size_t)(row0 + ai * HALF + m * 16) * (size_t)ldc + col0 + bj * HALF);
#pragma unroll
            for (int m = 0; m < 4; ++m) { const int row = row0 + ai * HALF + m * 16; float ss = 0.f;
#pragma unroll
                for (int bj = 0; bj < 2; ++bj) { const u32x4 b = bs[m][bj]; const f32x4 a0 = acc[ai][bj][m][0], a1 = acc[ai][bj][m][1];
                    const float v0 = __builtin_bit_cast(float, b.x << 16) + a0[0], v1 = __builtin_bit_cast(float, b.x & 0xffff0000u) + a0[1], v2 = __builtin_bit_cast(float, b.y << 16) + a0[2], v3 = __builtin_bit_cast(float, b.y & 0xffff0000u) + a0[3];
                    const float v4 = __builtin_bit_cast(float, b.z << 16) + a1[0], v5 = __builtin_bit_cast(float, b.z & 0xffff0000u) + a1[1], v6 = __builtin_bit_cast(float, b.w << 16) + a1[2], v7 = __builtin_bit_cast(float, b.w & 0xffff0000u) + a1[3];
                    ss += ((v0 * v0 + v1 * v1) + (v2 * v2 + v3 * v3)) + ((v4 * v4 + v5 * v5) + (v6 * v6 + v7 * v7));
                    u32x4 w; w.x = cvt_pk_bf16(v0, v1); w.y = cvt_pk_bf16(v2, v3); w.z = cvt_pk_bf16(v4, v5); w.w = cvt_pk_bf16(v6, v7);
                    *(u32x4*)(xb + (size_t)row * (size_t)ldc + col0 + bj * HALF) = w; }
                ss += __builtin_bit_cast(float, __builtin_amdgcn_ds_swizzle(__builtin_bit_cast(int, ss), (16 << 10) | 0x1f));
                { float sa = ss, sb = ss; asm("s_nop 1\n\tv_permlane32_swap_b32 %0, %1" : "+v"(sa), "+v"(sb)); ss = sa + sb; }
                if (fq == 0) __hip_atomic_fetch_add(rowss + row, (unsigned long long)(long long)__builtin_rintf(ss * 16777216.f), __ATOMIC_RELAXED, __HIP_MEMORY_SCOPE_AGENT); }
        }
    }
};

template <class Epi, class Sched, bool ALIGN_EPI = false, bool SP2 = false>
__device__ __forceinline__ void gemm_phase(PG8_LAS unsigned char* lds, const Gemm g, const Sched& S, const Epi& E, const int wv) {
    const int tid_o = tid_of(wv);
    const int tid = tid_o, wid = __builtin_amdgcn_readfirstlane(tid >> 6), lane = tid & 63, wr = wid >> 2, wc = wid & 3, fr = lane & 15, fq = lane >> 4;
    const int K = g.K, nt = K / BK;
    unsigned voffA[2], voffB[2];
#pragma unroll
    for (int i = 0; i < 2; ++i) { int R, C; stage_rc(tid * 16 + i * 8192, R, C); const int Rb = Epi::PERM ? ((R & ~31) + perm32(R & 31)) : R;
        voffA[i] = (unsigned)(R * K + C) * 2u; voffB[i] = (unsigned)(Rb * K + C) * 2u; }
    const size_t kstep = (size_t)(BK * 2);
    const size_t hstep = (size_t)HALF * K * 2;
    const size_t tstep = 2 * hstep;
    const unsigned ldsw = (unsigned)wid * 1024u;
    const int aoff = lds_byte(wr * 64 + fr, fq * 8), boff = lds_byte(wc * 32 + fr, fq * 8);
#define PG8_SA(b, h) (((b) * 2 + (h)) * HTB)
#define PG8_SB(b, h) ((4 + (b) * 2 + (h)) * HTB)
#define PG8_STAGE(bufoff, gbase, voff) do { _Pragma("unroll") for (int _i = 0; _i < 2; ++_i) \
        __builtin_amdgcn_global_load_lds((const unsigned*)((const char*)(gbase) + (voff)[_i]), (PG8_LAS unsigned*)(lds + (bufoff) + ldsw + _i * 8192), 16, 0, 0); } while (0)
#define PG8_LDA(dst, b, h) do { _Pragma("unroll") for (int m = 0; m < 4; ++m) _Pragma("unroll") for (int k = 0; k < 2; ++k) dst[m][k] = *(const PG8_LAS bf16x8*)(lds + PG8_SA(b, h) + aoff + m * 2048 + k * 1024); } while (0)
#define PG8_LDB(dst, b, h) do { _Pragma("unroll") for (int n = 0; n < 2; ++n) _Pragma("unroll") for (int k = 0; k < 2; ++k) dst[n][k] = *(const PG8_LAS bf16x8*)(lds + PG8_SB(b, h) + boff + n * 2048 + k * 1024); } while (0)
#define PG8_MMA(ai, bj, At, Bt) do { __builtin_amdgcn_s_setprio(1); _Pragma("unroll") for (int m = 0; m < 4; ++m) _Pragma("unroll") for (int n = 0; n < 2; ++n) _Pragma("unroll") for (int k = 0; k < 2; ++k) \
        acc[ai][bj][m][n] = mma1(Bt[n][k], At[m][k], acc[ai][bj][m][n]); __builtin_amdgcn_s_setprio(0); } while (0)
#define PG8_WAIT_V(n) asm volatile("s_waitcnt vmcnt(" #n ")" ::: "memory")
#define PG8_WAIT_L(n) asm volatile("s_waitcnt lgkmcnt(" #n ")" ::: "memory")
#define PG8_BAR __builtin_amdgcn_s_barrier()
#define PG8_SCHED __builtin_amdgcn_sched_barrier(0)
    Unit cur, nxt; int ui = 0;
    if (!S.next(0, cur)) return;
    typedef typename AccOf<Epi>::type AccT;
    AccT acc[2][2][4][2];
#pragma unroll
    for (int a = 0; a < 2; ++a)
#pragma unroll
        for (int b = 0; b < 2; ++b)
#pragma unroll
            for (int m = 0; m < 4; ++m)
#pragma unroll
                for (int n = 0; n < 2; ++n) acc[a][b][m][n] = (AccT){0, 0, 0, 0};
    bf16x8 At[4][2], B0[2][2], B1[2][2];
    const char* cA = (const char*)g.A + (size_t)cur.pm * tstep; const char* cB = (const char*)g.Bt + (size_t)cur.pn * tstep;
    S.a_ready(cur);
    if constexpr (SP2) {
        PG8_STAGE(PG8_SB(0, 0), cB, voffB); PG8_STAGE(PG8_SB(0, 1), cB + hstep, voffB); PG8_STAGE(PG8_SA(0, 0), cA, voffA); PG8_STAGE(PG8_SA(0, 1), cA + hstep, voffA);
        if (wr == 1) PG8_BAR;
        PG8_WAIT_V(2); PG8_BAR;
        PG8_STAGE(PG8_SB(1, 0), cB + kstep, voffB); PG8_STAGE(PG8_SA(1, 0), cA + kstep, voffA); PG8_STAGE(PG8_SB(1, 1), cB + hstep + kstep, voffB);
        PG8_WAIT_V(6); PG8_BAR;
    } else {
        PG8_STAGE(PG8_SB(0, 0), cB, voffB); PG8_STAGE(PG8_SA(0, 0), cA, voffA); PG8_STAGE(PG8_SB(0, 1), cB + hstep, voffB); PG8_STAGE(PG8_SA(0, 1), cA + hstep, voffA);
        if (wr == 1) PG8_BAR;
        PG8_WAIT_V(4); PG8_BAR;
        PG8_STAGE(PG8_SB(1, 0), cB + kstep, voffB); PG8_STAGE(PG8_SA(1, 0), cA + kstep, voffA); PG8_STAGE(PG8_SB(1, 1), cB + hstep + kstep, voffB);
        PG8_WAIT_V(6); PG8_BAR;
    }
    for (;;) {
        const bool has_next = S.next(ui + 1, nxt);
        const char* nA = has_next ? (const char*)g.A + (size_t)nxt.pm * tstep : cA; const char* nB = has_next ? (const char*)g.Bt + (size_t)nxt.pn * tstep : cB;
        for (int t = 0; t < nt; t += 2) {
            const bool last = (t == nt - 2);
            const char* a1 = cA + (size_t)(t + 1) * kstep;
            const char* a2 = last ? nA : cA + (size_t)(t + 2) * kstep; const char* b2 = last ? nB : cB + (size_t)(t + 2) * kstep;
            const char* a3 = a2 + kstep; const char* b3 = b2 + kstep;
            if (last && has_next) S.a_ready(nxt);
            if constexpr (SP2) {
            PG8_LDB(B0, 0, 0); PG8_LDB(B1, 0, 1); PG8_SCHED; PG8_LDA(At, 0, 0); PG8_STAGE(PG8_SA(1, 1), a1 + hstep, voffA);
            PG8_WAIT_V(8); PG8_WAIT_L(0); PG8_BAR; PG8_MMA(0, 0, At, B0); PG8_MMA(0, 1, At, B1); PG8_BAR; PG8_SCHED;
            PG8_LDA(At, 0, 1); PG8_STAGE(PG8_SB(0, 0), b2, voffB); PG8_STAGE(PG8_SB(0, 1), b2 + hstep, voffB); PG8_STAGE(PG8_SA(0, 0), a2, voffA);
            PG8_WAIT_V(8); PG8_WAIT_L(0); PG8_BAR; PG8_MMA(1, 0, At, B0); PG8_MMA(1, 1, At, B1); PG8_BAR; PG8_SCHED;
            PG8_LDB(B0, 1, 0); PG8_LDB(B1, 1, 1); PG8_SCHED; PG8_LDA(At, 1, 0); PG8_STAGE(PG8_SA(0, 1), a2 + hstep, voffA);
            PG8_WAIT_V(8); PG8_WAIT_L(0); PG8_BAR; PG8_MMA(0, 0, At, B0); PG8_MMA(0, 1, At, B1); PG8_BAR; PG8_SCHED;
            PG8_LDA(At, 1, 1); PG8_STAGE(PG8_SB(1, 0), b3, voffB); PG8_STAGE(PG8_SB(1, 1), b3 + hstep, voffB); PG8_STAGE(PG8_SA(1, 0), a3, voffA);
            PG8_WAIT_V(8); PG8_WAIT_L(0); PG8_BAR; PG8_MMA(1, 0, At, B0); PG8_MMA(1, 1, At, B1); PG8_BAR; PG8_SCHED;
            } else {
            PG8_LDB(B0, 0, 0); PG8_SCHED; PG8_LDA(At, 0, 0); PG8_STAGE(PG8_SA(1, 1), a1 + hstep, voffA);
            PG8_WAIT_L(8); PG8_BAR; PG8_WAIT_L(0); PG8_MMA(0, 0, At, B0); PG8_BAR; PG8_SCHED;
            PG8_LDB(B1, 0, 1); PG8_STAGE(PG8_SB(0, 0), b2, voffB);
            PG8_BAR; PG8_WAIT_L(0); PG8_MMA(0, 1, At, B1); PG8_BAR;
            PG8_LDA(At, 0, 1); PG8_STAGE(PG8_SA(0, 0), a2, voffA);
            PG8_BAR; PG8_WAIT_L(0); PG8_MMA(1, 0, At, B0); PG8_BAR; PG8_SCHED;
            PG8_STAGE(PG8_SB(0, 1), b2 + hstep, voffB);
            PG8_WAIT_V(6); PG8_BAR; PG8_MMA(1, 1, At, B1); PG8_BAR;
            PG8_LDB(B0, 1, 0); PG8_SCHED; PG8_LDA(At, 1, 0); PG8_STAGE(PG8_SA(0, 1), a2 + hstep, voffA);
            PG8_WAIT_L(8); PG8_BAR; PG8_WAIT_L(0); PG8_MMA(0, 0, At, B0); PG8_BAR; PG8_SCHED;
            PG8_LDB(B1, 1, 1); PG8_STAGE(PG8_SB(1, 0), b3, voffB);
            PG8_BAR; PG8_WAIT_L(0); PG8_MMA(0, 1, At, B1); PG8_BAR;
            PG8_LDA(At, 1, 1); PG8_STAGE(PG8_SA(1, 0), a3, voffA);
            PG8_BAR; PG8_WAIT_L(0); PG8_MMA(1, 0, At, B0); PG8_BAR; PG8_SCHED;
            PG8_STAGE(PG8_SB(1, 1), b3 + hstep, voffB);
            PG8_WAIT_V(6); PG8_BAR; PG8_MMA(1, 1, At, B1); PG8_BAR;
            }
        }
        if constexpr (ALIGN_EPI) { if (wr == 0) PG8_BAR; }
        if constexpr (!Epi::AFTER_DRAIN) { E(acc, cur, wr, wc, fr, fq); S.done(cur); }
        if (!has_next) break;
#pragma unroll
        for (int a = 0; a < 2; ++a)
#pragma unroll
            for (int b = 0; b < 2; ++b)
#pragma unroll
                for (int m = 0; m < 4; ++m)
#pragma unroll
                    for (int n = 0; n < 2; ++n) acc[a][b][m][n] = (AccT){0, 0, 0, 0};
        cur = nxt; cA = nA; cB = nB; ++ui;
        if constexpr (ALIGN_EPI) { if (wr == 1) PG8_BAR; }
    }
    PG8_WAIT_V(0);
    if constexpr (!ALIGN_EPI) { if (wr == 0) PG8_BAR; }
    PG8_BAR;
    if constexpr (Epi::AFTER_DRAIN) { E.fused(acc, cur, wr, wc, fr, fq, lds, wid, lane); S.done(cur); }
#undef PG8_SA
#undef PG8_SB
#undef PG8_STAGE
#undef PG8_LDA
#undef PG8_LDB
#undef PG8_MMA
#undef PG8_WAIT_V
#undef PG8_WAIT_L
#undef PG8_BAR
#undef PG8_SCHED
}
}
#define LAS __attribute__((address_space(3)))
#define XB_TMO      128
#define XB_XCNT(j)  (256  + 64 * (j))
#define XB_XSUB(j)  (1280 + 64 * (j))
#define XB_XGEN(j)  (2304 + 64 * (j))
#define XB_TOP      3328
#define XB_TOPGEN   3392
#define XCD_BAR_WORDS 3456
#define XB_SPIN_CAP (1u << 18)

__device__ __forceinline__ unsigned xb_ld(unsigned* p)              { return __hip_atomic_load(p, __ATOMIC_RELAXED, __HIP_MEMORY_SCOPE_AGENT); }
__device__ __forceinline__ unsigned xb_add(unsigned* p, unsigned v) { return __hip_atomic_fetch_add(p, v, __ATOMIC_RELAXED, __HIP_MEMORY_SCOPE_AGENT); }
__device__ __forceinline__ unsigned xb_xcc_id() { return (unsigned)__builtin_amdgcn_s_getreg((3 << 11) | 20) & 0xFu; }
#define XB_SPIN(cond, bar) do { unsigned _sp = 0; while (cond) { __builtin_amdgcn_s_sleep(1); \
    if ((++_sp & 255u) == 0u) { if (xb_ld(&(bar)[XB_TMO])) break; if (_sp > XB_SPIN_CAP) { atomicAdd(&(bar)[XB_TMO], 1u); break; } } } } while (0)

struct XcdBarrier {
    unsigned* bar; unsigned x;
    volatile LAS unsigned* st;
};

__device__ __forceinline__ XcdBarrier xcd_barrier_post(unsigned* bar, volatile LAS unsigned* st, const int wv) {
    XcdBarrier b; b.bar = bar; b.x = (unsigned)__builtin_amdgcn_readfirstlane((int)xb_xcc_id()); b.st = st;
    if (tid_of(wv) == 0) (void)xb_add(&bar[XB_XCNT(b.x)], 1u);
    return b;
}
__device__ __forceinline__ void xcd_barrier_complete(unsigned* bar, unsigned x, unsigned& nloc, unsigned& nx) {
    const unsigned G = gridDim.x * gridDim.y * gridDim.z;
    unsigned sum, cnt, mine, sp = 0u;
    for (;;) {
        sum = 0u; cnt = 0u; mine = 0u;
#pragma unroll
        for (unsigned j = 0; j < 16; ++j) { const unsigned c = xb_ld(&bar[XB_XCNT(j)]); sum += c; cnt += (c > 0u) ? 1u : 0u; mine = (j == x) ? c : mine; }
        if (sum == G) break;
        __builtin_amdgcn_s_sleep(1);
        if ((++sp & 255u) == 0u) { if (xb_ld(&bar[XB_TMO])) break; if (sp > XB_SPIN_CAP) { atomicAdd(&bar[XB_TMO], 1u); break; } }
    }
    nloc = mine > 0u ? mine : 1u; nx = cnt > 0u ? cnt : 1u;
}

__device__ __forceinline__ void xcd_barrier(const XcdBarrier& b, const int wv) {
    asm volatile("s_waitcnt vmcnt(0)" ::: "memory");
    __syncthreads();
    if (tid_of(wv) == 0) {
        unsigned* bar = b.bar; unsigned bx = b.x; asm volatile("" : "+s"(bx));
        __builtin_amdgcn_s_waitcnt(0);
        unsigned nloc = b.st[0], nx = b.st[1];
        if (nloc == 0u) { xcd_barrier_complete(bar, bx, nloc, nx); b.st[0] = nloc; b.st[1] = nx; }
        const unsigned old = xb_add(&bar[XB_XSUB(bx)], 1u);
        const unsigned gen = old / nloc;
        if (old + 1u == (gen + 1u) * nloc) {
            __builtin_amdgcn_fence(__ATOMIC_RELEASE, "agent");
            asm volatile("s_waitcnt vmcnt(0)" ::: "memory");
            const unsigned og = xb_add(&bar[XB_TOP], 1u);
            const unsigned tg = og / nx;
            if (og + 1u == (tg + 1u) * nx) xb_add(&bar[XB_TOPGEN], 1u);
            else XB_SPIN(xb_ld(&bar[XB_TOPGEN]) == tg, bar);
            __builtin_amdgcn_fence(__ATOMIC_ACQUIRE, "agent");
            xb_add(&bar[XB_XGEN(bx)], 1u);
            asm volatile("s_waitcnt vmcnt(0)" ::: "memory");
        } else {
            XB_SPIN(xb_ld(&bar[XB_XGEN(bx)]) == gen, bar);
            __builtin_amdgcn_fence(__ATOMIC_ACQUIRE, "agent");
            asm volatile("s_waitcnt vmcnt(0)" ::: "memory");
        }
    }
    __syncthreads();
}

namespace attn {
constexpr int D = 128;
constexpr float THR = 8.f;
constexpr bool WSKIP = true;
constexpr float SCALE = 0.08838834764831845f;
constexpr int NW = 8, QBLK = 32, KVBLK = 64, QB = NW * QBLK;
constexpr int SHM_V = KVBLK * D * 2, SHM_K = KVBLK * D * 2;
constexpr int LDS_BYTES = 2 * SHM_V + 2 * SHM_K + NW * 64 * 4;
typedef short bf16x8 __attribute__((ext_vector_type(8)));
typedef short s16x4 __attribute__((ext_vector_type(4)));
typedef float f32x16 __attribute__((ext_vector_type(16)));
typedef float f32x4 __attribute__((ext_vector_type(4)));
typedef unsigned u32x4 __attribute__((ext_vector_type(4)));
template <class A, class Bt> struct same_t { static constexpr bool v = false; };
template <class A> struct same_t<A, A> { static constexpr bool v = true; };

#define KSWZ(row, colB) ((row) * 256 + ((colB) ^ (((row) & 7) << 4)))
#define SBAR() __builtin_amdgcn_sched_barrier(0)
__device__ __forceinline__ int v_st(int k, int c) { const int kk = (k & ~0xC) | ((k & 4) << 1) | ((k & 8) >> 1); return ((kk >> 3) * 4 + (c >> 5)) * 512 + ((kk & 7) * 32 + (c & 31)) * 2; }
__device__ __forceinline__ int v_rd_base(int lane) { return ((lane & 3) << 3) | (((lane >> 2) & 3) << 6) | (((lane >> 4) & 1) << 5) | (((lane >> 5) & 1) << 8); }
constexpr int v_rd_off(int d0, int ks, int half) { return d0 * 512 + ks * 4096 + half * 2048; }
__device__ __forceinline__ int crow(int r, int hi) { return (r & 3) + 8 * (r >> 2) + 4 * hi; }
__device__ __forceinline__ unsigned cvtpk(float lo, float hi) {
    unsigned r; asm volatile("v_cvt_pk_bf16_f32 %0, %1, %2" : "=v"(r) : "v"(lo), "v"(hi)); return r;
}
__device__ __forceinline__ bf16x8 pack8(f32x4 a, f32x4 b) {
    u32x4 w = {cvtpk(a[0], a[1]), cvtpk(a[2], a[3]), cvtpk(b[0], b[1]), cvtpk(b[2], b[3])};
    return *reinterpret_cast<bf16x8*>(&w);
}
template <class T> __device__ __forceinline__ bf16x8 load8(const T* p) {
    if constexpr (same_t<T, float>::v) { return pack8(*(const f32x4*)p, *(const f32x4*)(p + 4)); }
    else { return *reinterpret_cast<const bf16x8*>(p); }
}
__device__ __forceinline__ void mask_tile(f32x16& p0, f32x16& p1, int dq, unsigned W) {
    const float NEG = -__builtin_inff();
#pragma unroll
    for (int r = 0; r < 16; ++r) {
        const int c = (r & 3) + 8 * (r >> 2);
        if ((unsigned)(dq - c) >= W) p0[r] = NEG;
        if ((unsigned)(dq - c - 32) >= W) p1[r] = NEG;
    }
}
__device__ __forceinline__ void partialSM(f32x16& p0, f32x16& p1, float& m_reg, float& mn, float& alpha) {
    float pmax = p0[0]; for (int r = 1; r < 16; ++r) pmax = fmaxf(pmax, p0[r]); for (int r = 0; r < 16; ++r) pmax = fmaxf(pmax, p1[r]);
    { float pa_ = pmax, pb_ = pmax; half_swap(pa_, pb_); pmax = fmaxf(pa_, pb_); }
    constexpr float C2 = 1.4426950408889634f * SCALE;
    if (__builtin_expect(__all((pmax - m_reg) * SCALE <= THR), 1)) { mn = m_reg; alpha = 1.f; }
    else { mn = fmaxf(m_reg, pmax); alpha = __builtin_amdgcn_exp2f((m_reg - mn) * C2); m_reg = mn; }
    const float mnL = -mn * C2;
    for (int r = 0; r < 16; ++r) p0[r] = fmaf(p0[r], C2, mnL); for (int r = 0; r < 16; ++r) p1[r] = fmaf(p1[r], C2, mnL);
    for (int r = 0; r < 16; ++r) p0[r] = __builtin_amdgcn_exp2f(p0[r]);
}
__device__ __forceinline__ void finishSM(f32x16& p0, f32x16& p1, float alpha, float& l_reg, bf16x8& pa0, bf16x8& pa1, bf16x8& pa2, bf16x8& pa3) {
    for (int r = 0; r < 16; ++r) p1[r] = __builtin_amdgcn_exp2f(p1[r]);
    float ps = 0; for (int r = 0; r < 16; ++r) ps += p0[r]; for (int r = 0; r < 16; ++r) ps += p1[r];
    { float pa_ = ps, pb_ = ps; half_swap(pa_, pb_); ps = pa_ + pb_; }
    l_reg = l_reg * alpha + ps;
#define PK4(P, B_, OUT) do { unsigned a0 = cvtpk(P[B_+0], P[B_+1]), a1 = cvtpk(P[B_+2], P[B_+3]);                          \
        unsigned b0 = cvtpk(P[B_+4], P[B_+5]), b1 = cvtpk(P[B_+6], P[B_+7]);                                             \
        auto r0 = __builtin_amdgcn_permlane32_swap(a0, b0, false, false); auto r1 = __builtin_amdgcn_permlane32_swap(a1, b1, false, false); \
        u32x4 w = {r0[0], r1[0], r0[1], r1[1]}; OUT = *reinterpret_cast<bf16x8*>(&w); } while (0)
    PK4(p0, 0, pa0); PK4(p0, 8, pa1); PK4(p1, 0, pa2); PK4(p1, 8, pa3);
#undef PK4
}
template <int KB, bool SK>
__device__ __forceinline__ void qkt(f32x16& p0, f32x16& p1, const char* K_lds, int r32, int hi, const bf16x8* qr, bool act, float e0, float beta) {
    if (SK && !act) { const float NEG = -__builtin_inff();
#pragma unroll
        for (int r = 0; r < 16; ++r) { p0[r] = NEG; p1[r] = NEG; } return; }
    { const float b8 = 8.f * beta, b32 = 32.f * beta;
      p0[0] = e0; p0[1] = p0[0] + beta; p0[2] = p0[1] + beta; p0[3] = p0[2] + beta;
#pragma unroll
      for (int r = 4; r < 16; ++r) p0[r] = p0[r - 4] + b8;
#pragma unroll
      for (int r = 0; r < 16; ++r) p1[r] = p0[r] + b32; }
    const char* kb[4];
#pragma unroll
    for (int dd = 0; dd < 4; ++dd) kb[dd] = K_lds + KB * SHM_K + KSWZ(r32, (dd * 16 + hi * 8) * 2);
#pragma unroll
    for (int d0 = 0; d0 < 8; ++d0) { const char* a = kb[d0 & 3] + (d0 >> 2) * 128;
        bf16x8 b0 = *reinterpret_cast<const bf16x8*>(a);
        bf16x8 b1 = *reinterpret_cast<const bf16x8*>(a + 32 * 256);
        p0 = __builtin_amdgcn_mfma_f32_32x32x16_bf16(b0, qr[d0], p0, 0, 0, 0);
        p1 = __builtin_amdgcn_mfma_f32_32x32x16_bf16(b1, qr[d0], p1, 0, 0, 0); }
}
template <int VB, bool SK>
__device__ __forceinline__ void pv_tile(f32x16* o, int vb0, bf16x8 pa0, bf16x8 pa1, bf16x8 pa2, bf16x8 pa3, bool act) {
    if (SK && !act) return;
#define TRRD(dst, off) asm volatile("ds_read_b64_tr_b16 %0, %1 offset:%2" : "=&v"(dst) : "v"(vb0), "i"(off) : "memory")
#define PV_D0(d0) do { s16x4 l0, l1, l2, l3, h0, h1, h2, h3; constexpr int b_ = VB * SHM_V + v_rd_off(d0, 0, 0);     \
        TRRD(l0, b_); TRRD(h0, b_ + 2048); TRRD(l1, b_ + 4096); TRRD(h1, b_ + 6144); TRRD(l2, b_ + 8192); TRRD(h2, b_ + 10240); TRRD(l3, b_ + 12288); TRRD(h3, b_ + 14336); \
        asm volatile("s_waitcnt lgkmcnt(0)" ::: "memory"); SBAR();                 \
        o[d0] = __builtin_amdgcn_mfma_f32_32x32x16_bf16(pa0, (bf16x8){l0[0], l0[1], l0[2], l0[3], h0[0], h0[1], h0[2], h0[3]}, o[d0], 0, 0, 0);   \
        o[d0] = __builtin_amdgcn_mfma_f32_32x32x16_bf16(pa1, (bf16x8){l1[0], l1[1], l1[2], l1[3], h1[0], h1[1], h1[2], h1[3]}, o[d0], 0, 0, 0);   \
        o[d0] = __builtin_amdgcn_mfma_f32_32x32x16_bf16(pa2, (bf16x8){l2[0], l2[1], l2[2], l2[3], h2[0], h2[1], h2[2], h2[3]}, o[d0], 0, 0, 0);   \
        o[d0] = __builtin_amdgcn_mfma_f32_32x32x16_bf16(pa3, (bf16x8){l3[0], l3[1], l3[2], l3[3], h3[0], h3[1], h3[2], h3[3]}, o[d0], 0, 0, 0); } while (0)
    PV_D0(0); PV_D0(1); PV_D0(2); PV_D0(3);
#undef PV_D0
#undef TRRD
}

template <class TIn, class TOut> struct BlockRef { const TIn* Q; const TIn* K; const TIn* V; TOut* O; float* L; int P0; int pitch; int opitch; int lpitch; float beta; };
template <class TIn> struct Seam {
    bf16x8 qr[8];
    bf16x8 st_v0, st_v1, st_k0, st_k1; f32x4 sf0, sf1, sf2, sf3;
    f32x4 tq[16];
};
__device__ __forceinline__ int swa_jlo(int P0, int W) { const int lowk = P0 - W + 1; return lowk > 0 ? lowk / KVBLK : 0; }
#define ROW(p, pt, k0, rr) ((p) + (size_t)((k0) + (rr)) * (size_t)(pt) + sc)
#define VMW() asm volatile("s_waitcnt vmcnt(0)" ::: "memory")
#define VMWN(n) asm volatile("s_waitcnt vmcnt(%0)" :: "i"(n) : "memory")
#define SLOAD_H(Kp, Vp, pt, k0) do { S.st_v0 = load8<TIn>(ROW(Vp, pt, k0, sr)); S.st_v1 = load8<TIn>(ROW(Vp, pt, k0, 32 + sr));              \
                         S.st_k0 = load8<TIn>(ROW(Kp, pt, k0, sr)); S.st_k1 = load8<TIn>(ROW(Kp, pt, k0, 32 + sr)); } while (0)
#define SWRITE_HK(bf) do { *(bf16x8*)(K_lds + (bf) * SHM_K + kws) = S.st_k0; *(bf16x8*)(K_lds + (bf) * SHM_K + kws + 32 * 256) = S.st_k1; } while (0)
#define SWRITE_HV(bf) do { *(bf16x8*)(V_lds + (bf) * SHM_V + vst0) = S.st_v0; *(bf16x8*)(V_lds + (bf) * SHM_V + vst1) = S.st_v1; } while (0)
#define SWRITE_H(bf) do { SWRITE_HV(bf); SWRITE_HK(bf); } while (0)
#define SLOAD_F(p, k0) do { S.sf0 = *(const f32x4*)ROW(p, D, k0, sr); S.sf1 = *(const f32x4*)(ROW(p, D, k0, sr) + 4);                \
                            S.sf2 = *(const f32x4*)ROW(p, D, k0, 32 + sr); S.sf3 = *(const f32x4*)(ROW(p, D, k0, 32 + sr) + 4); } while (0)
#define SWRITE_KF(bf) do { *(bf16x8*)(K_lds + (bf) * SHM_K + kws) = pack8(S.sf0, S.sf1); *(bf16x8*)(K_lds + (bf) * SHM_K + kws + 32 * 256) = pack8(S.sf2, S.sf3); } while (0)
#define SWRITE_VF(bf) do { *(bf16x8*)(V_lds + (bf) * SHM_V + vst0) = pack8(S.sf0, S.sf1); *(bf16x8*)(V_lds + (bf) * SHM_V + vst1) = pack8(S.sf2, S.sf3); } while (0)
template <class TIn, class TOut>
__device__ __forceinline__ void causal_swa_prime(const BlockRef<TIn, TOut>& cur, int W, char* lds, Seam<TIn>& S, const int wv) {
    constexpr bool F32 = same_t<TIn, float>::v;
    const int tid = tid_of(wv), wid = __builtin_amdgcn_readfirstlane(tid >> 6), lane = tid & 63, r32 = lane & 31, hi = lane >> 5;
    const int sr = tid >> 4, sc = (tid & 15) * 8, kws = KSWZ(sr, sc * 2); char* K_lds = lds + 2 * SHM_V;
    const int kb0 = swa_jlo(cur.P0, W) * KVBLK;
    for (int d0 = 0; d0 < 8; ++d0) S.qr[d0] = load8<TIn>(cur.Q + (size_t)(wid * QBLK + r32) * (size_t)cur.pitch + d0 * 16 + hi * 8);
    if constexpr (F32) { SLOAD_F((const float*)cur.K, kb0); VMW(); SWRITE_KF(0); SBAR(); SLOAD_F((const float*)cur.V, kb0); }
    else { SLOAD_H(cur.K, cur.V, cur.pitch, kb0); VMW(); SWRITE_HK(0); }
    __syncthreads();
}
template <class TIn, class TOut>
__device__ __forceinline__ void causal_swa_block(const BlockRef<TIn, TOut>& cur, const BlockRef<TIn, TOut>& nxt, int skv, int W, char* lds, Seam<TIn>& S, const int wv) {
    constexpr bool F32 = same_t<TIn, float>::v;
    const int tid = tid_of(wv), wid = __builtin_amdgcn_readfirstlane(tid >> 6), lane = tid & 63, r32 = lane & 31, hi = lane >> 5;
    const int j_lo = swa_jlo(cur.P0, W);
    int j_hi = (cur.P0 + QB - 1) / KVBLK + 1; if (j_hi > skv / KVBLK) j_hi = skv / KVBLK;
    const int NT = j_hi - j_lo;
    const int kbn = swa_jlo(nxt.P0, W) * KVBLK;
    const int qlo = cur.P0 + wid * QBLK, qm = qlo + r32 - 4 * hi;
    char* V_lds = lds; char* K_lds = lds + 2 * SHM_V;
    float* ws = (float*)(lds + 2 * SHM_V + 2 * SHM_K) + wid * 64; float* li_l = ws, * al_l = ws + 32;
    float m_reg = -1e30f, l_reg = 0; f32x16 o[4] = {};
    const int sr = tid >> 4, sc = (tid & 15) * 8, vst0 = v_st(sr, sc), vst1 = v_st(32 + sr, sc), kws = KSWZ(sr, sc * 2);
    const int vb0 = (int)(uintptr_t)V_lds + v_rd_base(lane);
    const TIn* Kh = cur.K; const TIn* Vh = cur.V; const int pch = cur.pitch; const float beta = cur.beta;
#define RESC(a) do { if (__any((a) < 1.f)) { if (hi == 0) al_l[r32] = (a); asm volatile("s_waitcnt lgkmcnt(0)" ::: "memory");              \
                     for (int d_ = 0; d_ < 4; ++d_) for (int r = 0; r < 16; ++r) o[d_][r] *= al_l[crow(r, hi)]; } } while (0)
#define KBASE(t) ((j_lo + (t)) * KVBLK)
#define ACT(t) (KBASE(t) <= qlo + QBLK - 1 && KBASE(t) + KVBLK - 1 >= qlo - W + 1)
#define MASKT(P0_, P1_, t) do { const int kb_ = KBASE(t); if ((!SK || ACT(t)) && (kb_ + KVBLK - 1 > qlo || kb_ <= qlo + QBLK - 1 - W)) mask_tile(P0_, P1_, qm - kb_, (unsigned)W); } while (0)
    constexpr int NQL = F32 ? 16 : 8;
    constexpr bool SK = WSKIP && !F32;
#define SEAM_K0() do { VMWN(NQL); if constexpr (F32) { SWRITE_KF(0); SBAR(); SLOAD_F((const float*)nxt.V, kbn); } else { SWRITE_HK(0); } SBAR(); } while (0)
    f32x16 pA0, pA1, pB0, pB1; float mnA, mnB, alA, alB; bf16x8 pa0, pa1, pa2, pa3;
    if constexpr (F32) { VMW(); SWRITE_VF(0); SBAR(); } else { SWRITE_HV(0); SBAR(); }
    if (NT > 1) { if constexpr (F32) SLOAD_F((const float*)Kh, KBASE(1)); else SLOAD_H(Kh, Vh, pch, KBASE(1)); }
    SBAR(); qkt<0, SK>(pA0, pA1, K_lds, r32, hi, S.qr, ACT(0), -beta * (float)(qm - KBASE(0)), beta);
    if constexpr (F32) { if (NT > 1) { VMW(); SWRITE_KF(1); SBAR(); SLOAD_F((const float*)Vh, KBASE(1)); } }
    MASKT(pA0, pA1, 0); partialSM(pA0, pA1, m_reg, mnA, alA);
    if (NT > 1) { VMW(); if constexpr (F32) { SWRITE_VF(1); SBAR(); if (NT > 2) SLOAD_F((const float*)Kh, KBASE(2)); } else SWRITE_H(1); }
    __syncthreads();
#define HALF_STEP(PX0, PX1, mnX, alX, PY0, PY1, alY, t, KB, VB, SB) do {                                                      \
        SBAR(); qkt<KB, SK>(PX0, PX1, K_lds, r32, hi, S.qr, ACT(t), -beta * (float)(qm - KBASE(t)), beta);                                             \
        finishSM(PY0, PY1, alY, l_reg, pa0, pa1, pa2, pa3); SBAR();                                                           \
        if ((t) + 1 < NT) { if constexpr (F32) { VMW(); SWRITE_KF(SB); SBAR(); SLOAD_F((const float*)Vh, KBASE((t) + 1)); }  \
                            else { SLOAD_H(Kh, Vh, pch, KBASE((t) + 1)); } SBAR(); }                                               \
        pv_tile<VB, SK>(o, vb0, pa0, pa1, pa2, pa3, ACT((t) - 1)); MASKT(PX0, PX1, (t)); partialSM(PX0, PX1, m_reg, mnX, alX);                                        \
        __syncthreads();                                                                                                      \
        if ((t) + 1 < NT) { VMW(); if constexpr (F32) { SWRITE_VF(SB); SBAR(); if ((t) + 2 < NT) SLOAD_F((const float*)Kh, KBASE((t) + 2)); } \
                            else { SWRITE_H(SB); } }                                                                          \
        RESC(alX); __syncthreads(); } while (0)
    for (int t = 1; t + 1 < NT; t += 2) {
        HALF_STEP(pB0, pB1, mnB, alB, pA0, pA1, alA, t, 1, 0, 0);
        HALF_STEP(pA0, pA1, mnA, alA, pB0, pB1, alB, t + 1, 0, 1, 1);
    }
    const bool even = (NT & 1) == 0;
    if (even) { SBAR(); qkt<1, SK>(pB0, pB1, K_lds, r32, hi, S.qr, ACT(NT - 1), -beta * (float)(qm - KBASE(NT - 1)), beta); SBAR(); }
#define QROW(e) (nxt.Q + (size_t)(wid * QBLK + r32) * D + ((e) >> 1) * 16 + hi * 8 + ((e) & 1) * 4)
    if constexpr (F32) { SLOAD_F((const float*)nxt.K, kbn); SBAR();
#pragma unroll
        for (int e = 0; e < 8; ++e) S.tq[e] = *(const f32x4*)QROW(e); }
    else { SLOAD_H(nxt.K, nxt.V, nxt.pitch, kbn); SBAR();
#pragma unroll
        for (int d0 = 0; d0 < 8; ++d0) S.qr[d0] = load8<TIn>(nxt.Q + (size_t)(wid * QBLK + r32) * (size_t)nxt.pitch + d0 * 16 + hi * 8); }
    SBAR();
    finishSM(pA0, pA1, alA, l_reg, pa0, pa1, pa2, pa3); SBAR();
    if constexpr (F32) {
#pragma unroll
        for (int e = 8; e < 16; ++e) S.tq[e] = *(const f32x4*)QROW(e); SBAR(); }
#undef QROW
    pv_tile<0, SK>(o, vb0, pa0, pa1, pa2, pa3, ACT(even ? NT - 2 : NT - 1));
    if (even) { MASKT(pB0, pB1, NT - 1); partialSM(pB0, pB1, m_reg, mnB, alB); __syncthreads(); RESC(alB);
        finishSM(pB0, pB1, alB, l_reg, pa0, pa1, pa2, pa3); SBAR(); pv_tile<1, SK>(o, vb0, pa0, pa1, pa2, pa3, ACT(NT - 1)); }
    SBAR(); SEAM_K0();
    if (hi == 0) { li_l[r32] = l_reg; cur.L[(size_t)(wid * QBLK + r32) * (size_t)cur.lpitch] = m_reg * SCALE + __logf(l_reg); }
    asm volatile("s_waitcnt lgkmcnt(0)" ::: "memory");
    float rli[16];
#pragma unroll
    for (int r = 0; r < 16; ++r) rli[r] = __builtin_amdgcn_rcpf(li_l[crow(r, hi)]);
    TOut* Ow = cur.O + (size_t)(wid * QBLK) * (size_t)cur.opitch; const size_t opch = (size_t)cur.opitch;
#pragma unroll
    for (int r = 0; r < 16; ++r) { const int orow = crow(r, hi);
#pragma unroll
        for (int d0 = 0; d0 < 4; ++d0) { const float v = o[d0][r] * rli[r];
            if constexpr (same_t<TOut, float>::v) { Ow[(size_t)orow * opch + d0 * 32 + r32] = v; }
            else { const float vn = lane_xor<1>(v);
                   if ((r32 & 1) == 0) *(unsigned*)(Ow + (size_t)orow * opch + d0 * 32 + r32) = cvtpk(v, vn); } } }
    if constexpr (F32) {
#pragma unroll
        for (int d0 = 0; d0 < 8; ++d0) S.qr[d0] = pack8(S.tq[2 * d0], S.tq[2 * d0 + 1]); }
    __syncthreads();
#undef RESC
#undef KBASE
#undef ACT
#undef MASKT
#undef SEAM_K0
#undef HALF_STEP
}
#undef ROW
#undef VMW
#undef VMWN
#undef SLOAD_H
#undef SWRITE_HK
#undef SWRITE_HV
#undef SWRITE_H
#undef SLOAD_F
#undef SWRITE_KF
#undef SWRITE_VF

#undef KSWZ
#undef SBAR
}

typedef unsigned short bf16;
typedef unsigned v4u __attribute__((ext_vector_type(4)));
typedef float f32x4 __attribute__((ext_vector_type(4)));
constexpr int D_MODEL = 4096, BATCH = 2, SEQ = 4096, DEPTH = 2, HEAD_DIM = 128, D_ATTN = 2048, D_SGU = 2048, NH = 16, NG = 16, CHUNK = 128;
constexpr int N_IN = 10240, D_FF = 11008, N_UP = 2 * D_FF, M_TOK = BATCH * SEQ;
constexpr float NORM_EPS = 1e-6f;
constexpr int ZQ = 0, ZK = 2048, ZV = 4096, ZU = 6144, ZV2 = 8192;
constexpr int NWAVES = 8, NTHREADS = 512;
constexpr int NQ8 = 6144;
constexpr int RING_BYTES = 131072, MISC_OFF = 140 * 1024, LDS_BYTES = 147456;
constexpr size_t MiB = 1u << 20;
constexpr size_t SZ_WIN = (size_t)N_IN * D_MODEL * 2, SZ_WOUT = (size_t)D_MODEL * D_MODEL * 2, SZ_WUP = (size_t)N_UP * D_MODEL * 2, SZ_WDN = (size_t)D_MODEL * D_FF * 2;
constexpr size_t OFF_CTL = 0, OFF_RS = 16384, RS_BYTES = (size_t)M_TOK * 8, OFF_CMAX = OFF_RS + 5 * RS_BYTES, CTL_BYTES = OFF_CMAX + (size_t)DEPTH * N_UP * 4;
constexpr size_t OFF_WIN = 1 * MiB, OFF_WOUT = OFF_WIN + 2 * SZ_WIN, OFF_WUP = OFF_WOUT + 2 * SZ_WOUT, OFF_WDN = OFF_WUP + 2 * SZ_WUP, OFF_H = OFF_WDN + 2 * SZ_WDN;
constexpr size_t OFF_Z = OFF_H + (size_t)M_TOK * D_MODEL * 2, OFF_MX = OFF_Z + (size_t)M_TOK * N_IN * 2, OFF_UP = OFF_MX + (size_t)M_TOK * D_MODEL * 2;
constexpr size_t OFF_ACT = OFF_UP + (size_t)M_TOK * N_UP * 2, OFF_OC = OFF_ACT + (size_t)M_TOK * D_FF * 2, OFF_LSE = OFF_OC + (size_t)3 * M_TOK * D_ATTN * 2, OFF_U4 = OFF_LSE + (size_t)3 * M_TOK * NH * 4, OFF_SB = OFF_U4 + (size_t)(M_TOK / 64) * 4 * N_UP * 4, OFF_SA = OFF_SB + (size_t)DEPTH * N_UP * 4, OFF_XQ = OFF_SA + (size_t)M_TOK * 4, WS_END = OFF_XQ + (size_t)M_TOK * D_MODEL;
constexpr size_t OFF_WINQ = OFF_UP, OFF_SBIN = OFF_WINQ + (size_t)DEPTH * NQ8 * D_MODEL;
static_assert(OFF_SBIN + (size_t)DEPTH * NQ8 * 4 <= OFF_ACT, "int8 input-projection weights fit");
static_assert(CTL_BYTES <= OFF_WIN && XCD_BAR_WORDS * 4 <= OFF_RS, "barrier words inside the memset region");

__device__ __forceinline__ unsigned f2bf(float f) { unsigned u = __builtin_bit_cast(unsigned, f); return (u + 0x7fffu + ((u >> 16) & 1u)) >> 16; }
__device__ __forceinline__ unsigned pk2(float lo, float hi) { unsigned r; asm("v_cvt_pk_bf16_f32 %0, %1, %2" : "=v"(r) : "v"(lo), "v"(hi)); return r; }
__device__ __forceinline__ float bf2f(unsigned short b) { return __builtin_bit_cast(float, (unsigned)b << 16); }
__device__ __forceinline__ float bflo(unsigned w) { return __builtin_bit_cast(float, w << 16); }
__device__ __forceinline__ float bfhi(unsigned w) { return __builtin_bit_cast(float, w & 0xffff0000u); }
#define LDS_WAIT() asm volatile("s_waitcnt lgkmcnt(0)" ::: "memory")

constexpr int CVT_STRIDE = 192, CVT_TILE = 64 * CVT_STRIDE;
struct CvtRegs { f32x4 v[16]; };
__device__ __forceinline__ void cvt_item_kn(int item, int nblk, int& kb, int& nb) { const int st = item >> 5, w = item & 31, nst = nblk >> 3; const int sk = st / nst, sn = st - sk * nst; kb = 4 * sk + (w >> 3); nb = 8 * sn + (w & 7); }
__device__ __forceinline__ void cvt_load(CvtRegs& R, const float* W, int N, int item, int lane, int nblk) {
    int kb, nb; cvt_item_kn(item, nblk, kb, nb); const float* p = W + (size_t)(64 * kb + (lane >> 4)) * N + 64 * nb + 4 * (lane & 15);
#pragma unroll
    for (int i = 0; i < 16; ++i) R.v[i] = *(const f32x4*)(p + (size_t)(4 * i) * N);
}
__device__ __forceinline__ void cvt_store(const CvtRegs& R, int K, int N, bf16* WT, LAS unsigned char* tile, int item, int lane, int nblk, bool glu, const float* gk) {
    int kb, nb; cvt_item_kn(item, nblk, kb, nb); const int k0 = 64 * kb, n0 = 64 * nb;
    const int half = N / 2, r0 = glu ? ((n0 < half) ? 256 * (n0 >> 7) + (n0 & 127) : 256 * ((n0 - half) >> 7) + 128 + ((n0 - half) & 127)) : n0;
    { LAS unsigned char* wp = tile + (lane >> 4) * CVT_STRIDE + 8 * (lane & 15);
#pragma unroll
      for (int i = 0; i < 16; ++i) { const float gg = gk ? gk[k0 + 4 * i + (lane >> 4)] : 1.f; const f32x4 x = R.v[i] * gg;
          typedef unsigned u32x2 __attribute__((ext_vector_type(2))); u32x2 w; w.x = pk2(x.x, x.y); w.y = pk2(x.z, x.w); *(LAS u32x2*)(wp + 4 * i * CVT_STRIDE) = w; } }
    LDS_WAIT();
    { const int hh = lane >> 5, g = (lane >> 4) & 1, i16 = lane & 15, q = i16 >> 2, p = i16 & 3;
      const int abase = (int)(uintptr_t)tile + (8 * hh + q) * CVT_STRIDE + (16 * g + 4 * p) * 2;
      bf16* orow = WT + (size_t)(r0 + 16 * g + i16) * K + k0 + 8 * hh;
#pragma unroll
      for (int nb2 = 0; nb2 < 2; ++nb2)
#pragma unroll
          for (int t = 0; t < 4; ++t) { typedef short s16x4 __attribute__((ext_vector_type(4))); s16x4 lo, hi;
              asm volatile("ds_read_b64_tr_b16 %0, %1 offset:%2" : "=&v"(lo) : "v"(abase), "i"(16 * t * CVT_STRIDE + 64 * nb2) : "memory");
              asm volatile("ds_read_b64_tr_b16 %0, %1 offset:%2" : "=&v"(hi) : "v"(abase), "i"(16 * t * CVT_STRIDE + 4 * CVT_STRIDE + 64 * nb2) : "memory");
              asm volatile("s_waitcnt lgkmcnt(0)" : "+v"(lo), "+v"(hi) :: "memory");
              typedef short s16x8 __attribute__((ext_vector_type(8))); const s16x8 o = {lo[0], lo[1], lo[2], lo[3], hi[0], hi[1], hi[2], hi[3]};
              *(s16x8*)(orow + (size_t)(32 * nb2) * K + 16 * t) = o; } }
    LDS_WAIT();
}
__device__ __forceinline__ void phase_convert(const float* W, int K, int N, bf16* WT, LAS unsigned char* lds, int gw, int NGW, int wave, int lane, const float* gk, bool glu = false, int ld = 0) {
    LAS unsigned char* tile = lds + wave * CVT_TILE;
    const int nblk = N / 64, items = (K / 64) * nblk; if (ld == 0) ld = N;
    int it = gw; if (it >= items) return;
    CvtRegs A, B; cvt_load(A, W, ld, it, lane, nblk);
    for (;;) {
        const int it1 = it + NGW; const bool h1 = it1 < items; if (h1) cvt_load(B, W, ld, it1, lane, nblk);
        cvt_store(A, K, N, WT, tile, it, lane, nblk, glu, gk);
        if (!h1) break;
        const int it2 = it1 + NGW; const bool h2 = it2 < items; if (h2) cvt_load(A, W, ld, it2, lane, nblk);
        cvt_store(B, K, N, WT, tile, it1, lane, nblk, glu, gk);
        if (!h2) break;
        it = it2;
    }
}
__device__ __forceinline__ int glu_row(int n, int N) { const int half = N / 2; return (n < half) ? 256 * (n >> 7) + (n & 127) : 256 * ((n - half) >> 7) + 128 + ((n - half) & 127); }
__device__ __forceinline__ void cvt8_load(CvtRegs& R, const float* W, int N, int item, int lane, int nblk, int nb_lo) {
    int kb, nb; cvt_item_kn(item, nblk, kb, nb); nb += nb_lo; const float* p = W + (size_t)(64 * kb + 2 * (lane >> 4)) * N + 64 * nb + 4 * (lane & 15);
#pragma unroll
    for (int i = 0; i < 16; ++i) R.v[i] = *(const f32x4*)(p + (size_t)(8 * (i >> 1) + (i & 1)) * N);
}
__device__ __forceinline__ void cvt8_colmax(const CvtRegs& R, int N, unsigned* colmax, int item, int lane, int nblk, int nb_lo, const float* gk) {
    int kb, nb; cvt_item_kn(item, nblk, kb, nb); nb += nb_lo; const int k0 = 64 * kb, n0 = 64 * nb, b = lane >> 4;
    f32x4 m = {0.f, 0.f, 0.f, 0.f};
#pragma unroll
    for (int i = 0; i < 16; ++i) { const float gg = gk[k0 + 8 * (i >> 1) + 2 * b + (i & 1)]; const f32x4 x = R.v[i] * gg;
        m.x = fmaxf(m.x, fabsf(x.x)); m.y = fmaxf(m.y, fabsf(x.y)); m.z = fmaxf(m.z, fabsf(x.z)); m.w = fmaxf(m.w, fabsf(x.w)); }
#pragma unroll
    for (int e = 0; e < 4; ++e) { float v = m[e]; v = fmaxf(v, lane_xor<16>(v)); float va = v, vb = v; half_swap(va, vb); m[e] = fmaxf(va, vb); }
    if (lane < 16) { unsigned* p = colmax + glu_row(n0, N) + 4 * lane;
#pragma unroll
        for (int e = 0; e < 4; ++e) __hip_atomic_fetch_max(p + e, __builtin_bit_cast(unsigned, m[e]), __ATOMIC_RELAXED, __HIP_MEMORY_SCOPE_AGENT); }
}
__device__ __forceinline__ void cvt8_store(const CvtRegs& R, int K, int N, signed char* WQ, float* sB, const unsigned* colmax, LAS unsigned char* tile, int item, int lane, int nblk, int nb_lo, const float* gk) {
    int kb, nb; cvt_item_kn(item, nblk, kb, nb); nb += nb_lo; const int k0 = 64 * kb, n0 = 64 * nb, r0 = glu_row(n0, N), b = lane >> 4, a = lane & 15;
    const f32x4 cm = __builtin_bit_cast(f32x4, *(const v4u*)(colmax + r0 + 4 * a));
    f32x4 inv;
#pragma unroll
    for (int e = 0; e < 4; ++e) inv[e] = cm[e] > 0.f ? 127.f / cm[e] : 0.f;
    if (kb == 0 && lane < 16) *(f32x4*)(sB + r0 + 4 * a) = cm * (1.f / 127.f);
    { LAS unsigned char* wp = tile + b * CVT_STRIDE + 8 * a;
#pragma unroll
      for (int i = 0; i < 8; ++i) { const float g0 = gk[k0 + 8 * i + 2 * b], g1 = gk[k0 + 8 * i + 2 * b + 1]; const f32x4 x0 = R.v[2 * i] * g0 * inv, x1 = R.v[2 * i + 1] * g1 * inv;
          unsigned h[4];
#pragma unroll
          for (int e = 0; e < 4; ++e) { const int q0 = (int)__builtin_rintf(fminf(fmaxf(x0[e], -127.f), 127.f)), q1 = (int)__builtin_rintf(fminf(fmaxf(x1[e], -127.f), 127.f)); h[e] = ((unsigned)q0 & 0xffu) | (((unsigned)q1 & 0xffu) << 8); }
          typedef unsigned u32x2 __attribute__((ext_vector_type(2))); u32x2 w; w.x = h[0] | (h[1] << 16); w.y = h[2] | (h[3] << 16); *(LAS u32x2*)(wp + 4 * i * CVT_STRIDE) = w; } }
    LDS_WAIT();
    { const int hh = lane >> 5, g = (lane >> 4) & 1, i16 = lane & 15, q = i16 >> 2, p = i16 & 3;
      const int abase = (int)(uintptr_t)tile + (8 * hh + q) * CVT_STRIDE + (16 * g + 4 * p) * 2;
      signed char* orow = WQ + (size_t)(r0 + 16 * g + i16) * K + k0 + 16 * hh;
#pragma unroll
      for (int nb2 = 0; nb2 < 2; ++nb2)
#pragma unroll
          for (int t = 0; t < 2; ++t) { typedef short s16x4 __attribute__((ext_vector_type(4))); s16x4 lo, hi;
              asm volatile("ds_read_b64_tr_b16 %0, %1 offset:%2" : "=&v"(lo) : "v"(abase), "i"(16 * t * CVT_STRIDE + 64 * nb2) : "memory");
              asm volatile("ds_read_b64_tr_b16 %0, %1 offset:%2" : "=&v"(hi) : "v"(abase), "i"(16 * t * CVT_STRIDE + 4 * CVT_STRIDE + 64 * nb2) : "memory");
              asm volatile("s_waitcnt lgkmcnt(0)" : "+v"(lo), "+v"(hi) :: "memory");
              typedef short s16x8 __attribute__((ext_vector_type(8))); const s16x8 o = {lo[0], lo[1], lo[2], lo[3], hi[0], hi[1], hi[2], hi[3]};
              *(s16x8*)(orow + (size_t)(32 * nb2) * K + 32 * t) = o; } }
    LDS_WAIT();
}
template <int PASS> __device__ __forceinline__ void phase_convert8(const float* W, int K, int N, signed char* WQ, float* sB, unsigned* colmax, LAS unsigned char* lds, int gw, int NGW, int wave, int lane, const float* gk, int nb_lo, int nb_cnt) {
    LAS unsigned char* tile = lds + wave * CVT_TILE;
    const int nblk = nb_cnt, items = (K / 64) * nblk;
    for (int it = gw; it < items; it += NGW) { CvtRegs A; cvt8_load(A, W, N, it, lane, nblk, nb_lo);
        if (PASS == 0) cvt8_colmax(A, N, colmax, it, lane, nblk, nb_lo, gk); else cvt8_store(A, K, N, WQ, sB, colmax, tile, it, lane, nblk, nb_lo, gk); }
}
constexpr int ST_STRIDE = 528, ST_TILE = 32 * ST_STRIDE, ST_RED = NWAVES * ST_TILE;
static_assert(ST_RED + 2048 <= MISC_OFF, "strip tiles below the control words");
__device__ __forceinline__ unsigned pkbf(float lo, float hi) { unsigned r; asm("v_cvt_pk_bf16_f32 %0, %1, %2" : "=v"(r) : "v"(lo), "v"(hi)); return r; }
__device__ __forceinline__ void strip8(const float* W, int N, int n0, int r0, const float* gk, signed char* WQ, float* sB, LAS unsigned char* lds, int par, int wave, int lane) {
    const int a = lane & 7, b = lane >> 3, kw = 512 * wave;
    const float* p = W + (size_t)(kw + 4 * b) * N + n0 + 4 * a;
    const float* gp = gk + kw + 4 * b;
    unsigned P[16][4][2];
    f32x4 mx = {0.f, 0.f, 0.f, 0.f};
    f32x4 S[2][8], Gn[2][2];
#define ST_LOAD(buf, bi) do { _Pragma("unroll") for (int q = 0; q < 8; ++q) S[buf][q] = *(const f32x4*)(p + (size_t)(32 * (2 * (bi) + (q >> 2)) + (q & 3)) * N); \
        Gn[buf][0] = *(const f32x4*)(gp + 64 * (bi)); Gn[buf][1] = *(const f32x4*)(gp + 64 * (bi) + 32); } while (0)
    ST_LOAD(0, 0);
#pragma unroll
    for (int bi = 0; bi < 8; ++bi) {
        if (bi < 7) { if (bi & 1) ST_LOAD(0, bi + 1); else ST_LOAD(1, bi + 1); }
        __builtin_amdgcn_sched_barrier(0);
#pragma unroll
        for (int mm = 0; mm < 2; ++mm) { const int m = 2 * bi + mm; f32x4 x[4];
#pragma unroll
            for (int c = 0; c < 4; ++c) { x[c] = S[bi & 1][4 * mm + c] * Gn[bi & 1][mm][c];
                mx.x = fmaxf(mx.x, fabsf(x[c].x)); mx.y = fmaxf(mx.y, fabsf(x[c].y)); mx.z = fmaxf(mx.z, fabsf(x[c].z)); mx.w = fmaxf(mx.w, fabsf(x[c].w)); }
#pragma unroll
            for (int e = 0; e < 4; ++e) { P[m][e][0] = pkbf(x[0][e], x[1][e]); P[m][e][1] = pkbf(x[2][e], x[3][e]); } }
        __builtin_amdgcn_sched_barrier(0);
    }
#undef ST_LOAD
    LAS float* red = (LAS float*)(lds + ST_RED + par * 1024);
#pragma unroll
    for (int e = 0; e < 4; ++e) { float v = mx[e]; v = fmaxf(v, lane_xor<8>(v)); v = fmaxf(v, lane_xor<16>(v)); float va = v, vb = v; half_swap(va, vb); mx[e] = fmaxf(va, vb); }
    if (b == 0) *(LAS f32x4*)(red + wave * 32 + 4 * a) = mx;
    __syncthreads();
    f32x4 cm = *(LAS f32x4*)(red + 4 * a);
#pragma unroll
    for (int w2 = 1; w2 < NWAVES; ++w2) { const f32x4 o = *(LAS f32x4*)(red + w2 * 32 + 4 * a); cm.x = fmaxf(cm.x, o.x); cm.y = fmaxf(cm.y, o.y); cm.z = fmaxf(cm.z, o.z); cm.w = fmaxf(cm.w, o.w); }
    f32x4 inv;
#pragma unroll
    for (int e = 0; e < 4; ++e) { cm[e] = bflo(pkbf(cm[e], cm[e])); inv[e] = cm[e] > 0.f ? 127.f / cm[e] : 0.f; }
    if (wave == 0 && b == 0) *(f32x4*)(sB + r0 + 4 * a) = cm * (1.f / 127.f);
    LAS unsigned char* tile = lds + wave * ST_TILE;
    { LAS unsigned char* wp = tile + (4 * a) * ST_STRIDE + 4 * b;
#pragma unroll
      for (int m = 0; m < 16; ++m)
#pragma unroll
          for (int e = 0; e < 4; ++e) { const unsigned w0 = P[m][e][0], w1 = P[m][e][1];
              const unsigned t0 = __builtin_bit_cast(unsigned, __builtin_fmaf(bflo(w0), inv[e], 12582912.f)), t1 = __builtin_bit_cast(unsigned, __builtin_fmaf(bfhi(w0), inv[e], 12582912.f));
              const unsigned t2 = __builtin_bit_cast(unsigned, __builtin_fmaf(bflo(w1), inv[e], 12582912.f)), t3 = __builtin_bit_cast(unsigned, __builtin_fmaf(bfhi(w1), inv[e], 12582912.f));
              *(LAS unsigned*)(wp + e * ST_STRIDE + 32 * m) = __builtin_amdgcn_perm(t1, t0, 0x0c0c0400u) | __builtin_amdgcn_perm(t3, t2, 0x04000c0cu); } }
    LDS_WAIT();
    { signed char* orow = WQ + (size_t)(r0 + (lane >> 5)) * D_MODEL + kw + 16 * (lane & 31); LAS unsigned char* rp = tile + (lane >> 5) * ST_STRIDE + 16 * (lane & 31);
#pragma unroll
      for (int i = 0; i < 16; ++i) { const v4u v = *(LAS v4u*)(rp + 2 * i * ST_STRIDE); *(v4u*)(orow + (size_t)(2 * i) * D_MODEL) = v; } }
    LDS_WAIT();
}
__device__ __forceinline__ void phase_strips8(const float* Wup, const float* gup, signed char* WQup, float* sBup, const float* Win, const float* gin, signed char* WQin, float* sBin, LAS unsigned char* lds, int blk, int G, int wave, int lane) {
    constexpr int SPL = N_UP / 32, SPI = NQ8 / 32;
    int par = 0;
    for (int s = blk; s < DEPTH * (SPL + SPI); s += G, par ^= 1) {
        if (s < DEPTH * SPL) { const int cl = s >= SPL ? 1 : 0, n0 = 32 * (s - cl * SPL);
            strip8(Wup + (size_t)cl * D_MODEL * N_UP, N_UP, n0, glu_row(n0, N_UP), gup + (size_t)cl * D_MODEL, WQup + (size_t)cl * N_UP * D_MODEL, sBup + (size_t)cl * N_UP, lds, par, wave, lane); }
        else { const int s2 = s - DEPTH * SPL, cl = s2 >= SPI ? 1 : 0, n0 = 32 * (s2 - cl * SPI);
            strip8(Win + (size_t)cl * D_MODEL * N_IN, N_IN, n0, n0, gin + (size_t)cl * D_MODEL, WQin + (size_t)cl * NQ8 * D_MODEL, sBin + (size_t)cl * NQ8, lds, par, wave, lane); }
    }
}
__device__ __forceinline__ void phase_quant_rows(const bf16* xb, signed char* xq, float* sA, int gw, int NGW, int lane) {
    for (int row = gw; row < M_TOK; row += NGW) {
        const v4u* xr = (const v4u*)(xb + (size_t)row * D_MODEL) + lane; v4u x[8]; float mx = 0.f;
#pragma unroll
        for (int j = 0; j < 8; ++j) { x[j] = xr[64 * j]; const unsigned* w = (const unsigned*)&x[j];
#pragma unroll
            for (int e = 0; e < 4; ++e) mx = fmaxf(mx, fmaxf(fabsf(bflo(w[e])), fabsf(bfhi(w[e])))); }
        mx = fmaxf(mx, lane_xor<1>(mx)); mx = fmaxf(mx, lane_xor<2>(mx)); mx = fmaxf(mx, lane_xor<4>(mx)); mx = fmaxf(mx, lane_xor<8>(mx)); mx = fmaxf(mx, lane_xor<16>(mx));
        { float ma = mx, mb = mx; half_swap(ma, mb); mx = fmaxf(ma, mb); }
        const float inv = mx > 0.f ? 127.f / mx : 0.f;
        if (lane == 0) sA[row] = mx * (1.f / 127.f);
        unsigned long long* o8 = (unsigned long long*)(xq + (size_t)row * D_MODEL) + lane;
#pragma unroll
        for (int j = 0; j < 8; ++j) { const unsigned* w = (const unsigned*)&x[j]; unsigned long long pk = 0ull;
#pragma unroll
            for (int e = 0; e < 4; ++e) { const int q0 = (int)__builtin_rintf(bflo(w[e]) * inv), q1 = (int)__builtin_rintf(bfhi(w[e]) * inv);
                pk |= (unsigned long long)(((unsigned)q0 & 0xffu) | (((unsigned)q1 & 0xffu) << 8)) << (16 * e); }
            o8[64 * j] = pk; }
    }
}
__device__ __forceinline__ void phase_xprep(const float* x, bf16* xb, unsigned long long* rowss, signed char* xq, float* sA, int gw, int NGW, int lane) {
    for (int row = gw; row < M_TOK; row += NGW) {
        const f32x4* xr = (const f32x4*)(x + (size_t)row * D_MODEL) + lane; float s = 0.f, mx = 0.f; unsigned w[16][2];
#pragma unroll
        for (int j = 0; j < 16; ++j) { const f32x4 v = xr[64 * j]; s += (v.x * v.x + v.y * v.y) + (v.z * v.z + v.w * v.w);
            w[j][0] = pk2(v.x, v.y); w[j][1] = pk2(v.z, v.w);
            mx = fmaxf(fmaxf(mx, fmaxf(fabsf(bflo(w[j][0])), fabsf(bfhi(w[j][0])))), fmaxf(fabsf(bflo(w[j][1])), fabsf(bfhi(w[j][1]))));
            unsigned long long* o8 = (unsigned long long*)(xb + (size_t)row * D_MODEL) + lane + 64 * j; *o8 = (unsigned long long)w[j][0] | ((unsigned long long)w[j][1] << 32); }
        s = wave_sum(s);
        if (lane == 0) rowss[row] = (unsigned long long)(long long)__builtin_rintf(s * 16777216.f);
        mx = fmaxf(mx, lane_xor<1>(mx)); mx = fmaxf(mx, lane_xor<2>(mx)); mx = fmaxf(mx, lane_xor<4>(mx)); mx = fmaxf(mx, lane_xor<8>(mx)); mx = fmaxf(mx, lane_xor<16>(mx));
        { float ma = mx, mb = mx; half_swap(ma, mb); mx = fmaxf(ma, mb); }
        const float inv = mx > 0.f ? 127.f / mx : 0.f;
        if (lane == 0) sA[row] = mx * (1.f / 127.f);
        unsigned* o4 = (unsigned*)(xq + (size_t)row * D_MODEL) + lane;
#pragma unroll
        for (int j = 0; j < 16; ++j) { const int q0 = (int)__builtin_rintf(bflo(w[j][0]) * inv), q1 = (int)__builtin_rintf(bfhi(w[j][0]) * inv), q2 = (int)__builtin_rintf(bflo(w[j][1]) * inv), q3 = (int)__builtin_rintf(bfhi(w[j][1]) * inv);
            o4[64 * j] = ((unsigned)q0 & 0xffu) | (((unsigned)q1 & 0xffu) << 8) | (((unsigned)q2 & 0xffu) << 16) | ((unsigned)q3 << 24); }
    }
}
__device__ __forceinline__ void phase_final(const bf16* xb, float* out, const unsigned long long* rowss, const float* g, int gw, int NGW, int lane) {
    for (int row = gw; row < M_TOK; row += NGW) {
        const float rstd = rsqrtf((float)rowss[row] * (1.f / (16777216.f * D_MODEL)) + NORM_EPS);
        const v4u* xr = (const v4u*)(xb + (size_t)row * D_MODEL) + lane; f32x4* orow = (f32x4*)(out + (size_t)row * D_MODEL); const f32x4* gr = (const f32x4*)g;
        v4u x[8];
#pragma unroll
        for (int j = 0; j < 8; ++j) x[j] = xr[64 * j];
#pragma unroll
        for (int j = 0; j < 8; ++j) { const int c4 = 2 * (lane + 64 * j);
            const f32x4 ga = gr[c4], gb = gr[c4 + 1];
            orow[c4] = (f32x4){bflo(x[j].x) * rstd * ga.x, bfhi(x[j].x) * rstd * ga.y, bflo(x[j].y) * rstd * ga.z, bfhi(x[j].y) * rstd * ga.w};
            orow[c4 + 1] = (f32x4){bflo(x[j].z) * rstd * gb.x, bfhi(x[j].z) * rstd * gb.y, bflo(x[j].w) * rstd * gb.z, bfhi(x[j].w) * rstd * gb.w}; }
    }
}
constexpr int SGU_STRIDE = 320, SGU_SLOT = CHUNK * SGU_STRIDE;
typedef short sg_bf16x8 __attribute__((ext_vector_type(8)));
typedef short sg_s16x4 __attribute__((ext_vector_type(4)));
typedef float sg_f32x16 __attribute__((ext_vector_type(16)));
__device__ __forceinline__ void phase_sgu(const bf16* Z, const float* sgug, const float* Ws, const float* bs, const float* mixg, bf16* Mx, LAS unsigned char* lds, int blk, int G, int tid, int wv) {
    const int lane = tid & 63, h = lane >> 5, l31 = lane & 31;
    const int uh = wv >> 2, tt = wv & 3;
    const int srow = tid >> 2, sq = tid & 3;
    for (int wq = blk; wq < 256; wq += G) {
        const int g = wq & 15, cq = wq >> 4;
        sg_bf16x8 wf[8];
        { const int t = 32 * tt + l31; const float* wrow = Ws + ((size_t)g * CHUNK + t) * CHUNK;
#pragma unroll
          for (int ks = 0; ks < 8; ++ks) { wf[ks] = sg_bf16x8{0, 0, 0, 0, 0, 0, 0, 0};
              if (ks <= 2 * tt + 1) { const int s0 = 16 * ks + 8 * h; const f32x4 a = *(const f32x4*)(wrow + s0), b = *(const f32x4*)(wrow + s0 + 4);
                  float v[8] = {a.x, a.y, a.z, a.w, b.x, b.y, b.z, b.w};
#pragma unroll
                  for (int e = 0; e < 8; ++e) v[e] = (s0 + e <= t) ? v[e] : 0.f;
                  v4u pk; pk.x = pk2(v[0], v[1]); pk.y = pk2(v[2], v[3]); pk.z = pk2(v[4], v[5]); pk.w = pk2(v[6], v[7]); wf[ks] = __builtin_bit_cast(sg_bf16x8, pk); } } }
        const float bias_t = bs[g * CHUNK + 32 * tt + l31];
        f32x4 sgv[8];
#pragma unroll
        for (int e = 0; e < 8; ++e) sgv[e] = *(const f32x4*)(sgug + g * 128 + sq * 32 + 4 * e);
        for (int rnd = 0; rnd < 2; ++rnd) {
            uint2 uu[4][4];
            { const bf16* up0 = Z + (size_t)((4 * cq + 2 * rnd + uh) * CHUNK + 32 * tt + l31) * N_IN + ZU + g * 128 + 4 * h;
#pragma unroll
              for (int ct = 0; ct < 4; ++ct)
#pragma unroll
                  for (int rq = 0; rq < 4; ++rq) uu[ct][rq] = *(const uint2*)(up0 + 32 * ct + 8 * rq); }
#pragma unroll
            for (int ub = 0; ub < 2; ++ub) { const int row0 = (4 * cq + 2 * rnd + ub) * CHUNK;
                const v4u* vp = (const v4u*)(Z + (size_t)(row0 + srow) * N_IN + ZV2 + g * 128 + sq * 32);
                v4u raw[4]; float x[32]; float ss = 0.f;
#pragma unroll
                for (int e = 0; e < 4; ++e) raw[e] = vp[e];
#pragma unroll
                for (int e = 0; e < 4; ++e) { x[8 * e + 0] = bflo(raw[e].x); x[8 * e + 1] = bfhi(raw[e].x); x[8 * e + 2] = bflo(raw[e].y); x[8 * e + 3] = bfhi(raw[e].y);
                    x[8 * e + 4] = bflo(raw[e].z); x[8 * e + 5] = bfhi(raw[e].z); x[8 * e + 6] = bflo(raw[e].w); x[8 * e + 7] = bfhi(raw[e].w); }
#pragma unroll
                for (int e = 0; e < 32; ++e) ss += x[e] * x[e];
                ss += lane_xor<1>(ss); ss += lane_xor<2>(ss);
                const float rstd = rsqrtf(ss * (1.f / 128.f) + NORM_EPS);
                LAS v4u* dst = (LAS v4u*)(lds + ub * SGU_SLOT + srow * SGU_STRIDE + sq * 64);
#pragma unroll
                for (int e = 0; e < 4; ++e) { v4u o; const f32x4 s0 = sgv[2 * e], s1 = sgv[2 * e + 1];
                    o.x = pk2(x[8 * e + 0] * rstd * s0.x, x[8 * e + 1] * rstd * s0.y); o.y = pk2(x[8 * e + 2] * rstd * s0.z, x[8 * e + 3] * rstd * s0.w);
                    o.z = pk2(x[8 * e + 4] * rstd * s1.x, x[8 * e + 5] * rstd * s1.y); o.w = pk2(x[8 * e + 6] * rstd * s1.z, x[8 * e + 7] * rstd * s1.w); dst[e] = o; } }
            __syncthreads();
            sg_f32x16 acc[4];
#pragma unroll
            for (int ct = 0; ct < 4; ++ct) acc[ct] = sg_f32x16{};
            { const int g4 = lane >> 4, i16 = lane & 15, q = i16 >> 2, p = i16 & 3;
              const int abase = (int)(uintptr_t)(lds + uh * SGU_SLOT) + (8 * h + q) * SGU_STRIDE + (16 * (g4 & 1) + 4 * p) * 2;
#pragma unroll
              for (int ks = 0; ks < 8; ++ks) {
                  if (ks <= 2 * tt + 1) {
#pragma unroll
                      for (int ct = 0; ct < 4; ++ct) { sg_s16x4 lo, hi;
                          asm volatile("ds_read_b64_tr_b16 %0, %1 offset:%2" : "=&v"(lo) : "v"(abase), "i"(16 * ks * SGU_STRIDE + ct * 64) : "memory");
                          asm volatile("ds_read_b64_tr_b16 %0, %1 offset:%2" : "=&v"(hi) : "v"(abase), "i"(16 * ks * SGU_STRIDE + 4 * SGU_STRIDE + ct * 64) : "memory");
                          asm volatile("s_waitcnt lgkmcnt(0)" ::: "memory"); __builtin_amdgcn_sched_barrier(0);
                          acc[ct] = __builtin_amdgcn_mfma_f32_32x32x16_bf16((sg_bf16x8){lo[0], lo[1], lo[2], lo[3], hi[0], hi[1], hi[2], hi[3]}, wf[ks], acc[ct], 0, 0, 0); } } } }
            { const int row = (4 * cq + 2 * rnd + uh) * CHUNK + 32 * tt + l31;
              const float* mg = mixg + D_ATTN + g * 128 + 4 * h;
              float ss = 0.f;
#pragma unroll
              for (int ct = 0; ct < 4; ++ct)
#pragma unroll
                  for (int rq = 0; rq < 4; ++rq) { const uint2 uv = uu[ct][rq];
                      const float u0 = bflo(uv.x), u1 = bfhi(uv.x), u2 = bflo(uv.y), u3 = bfhi(uv.y);
                      float o0 = u0 * (acc[ct][4 * rq + 0] + bias_t), o1 = u1 * (acc[ct][4 * rq + 1] + bias_t), o2 = u2 * (acc[ct][4 * rq + 2] + bias_t), o3 = u3 * (acc[ct][4 * rq + 3] + bias_t);
                      acc[ct][4 * rq + 0] = o0; acc[ct][4 * rq + 1] = o1; acc[ct][4 * rq + 2] = o2; acc[ct][4 * rq + 3] = o3; ss += (o0 * o0 + o1 * o1) + (o2 * o2 + o3 * o3); }
              { float sa = ss, sb = ss; half_swap(sa, sb); ss = sa + sb; }
              const float rstd = rsqrtf(ss * (1.f / 128.f) + NORM_EPS);
              bf16* op = Mx + (size_t)row * D_MODEL + D_ATTN + g * 128 + 4 * h;
#pragma unroll
              for (int ct = 0; ct < 4; ++ct)
#pragma unroll
                  for (int rq = 0; rq < 4; ++rq) { const f32x4 mm = *(const f32x4*)(mg + 32 * ct + 8 * rq);
                      uint2 w; w.x = pk2(acc[ct][4 * rq + 0] * rstd * mm.x, acc[ct][4 * rq + 1] * rstd * mm.y); w.y = pk2(acc[ct][4 * rq + 2] * rstd * mm.z, acc[ct][4 * rq + 3] * rstd * mm.w);
                      *(uint2*)(op + 32 * ct + 8 * rq) = w; } }
            __syncthreads();
        }
    }
}
__device__ __forceinline__ void phase_convfix(const float* U4, const float* cw, const float* cb, bf16* ACT, size_t gtid, size_t nthreads) {
    constexpr int per_row = D_FF / 8, NB = M_TOK / 64; const size_t total = (size_t)NB * per_row;
    for (size_t i = gtid; i < total; i += nthreads) {
        const int blk64 = (int)(i / per_row), c = (int)(i % per_row) * 8;
        if ((blk64 & (SEQ / 64 - 1)) == 0) continue;
        const float* um2 = U4 + ((size_t)(blk64 - 1) * 4 + 2) * N_UP; const float* um1 = um2 + N_UP; const float* u0 = U4 + (size_t)blk64 * 4 * N_UP; const float* u1 = u0 + N_UP;
        float y0[2][8], y1[2][8];
#pragma unroll
        for (int hv = 0; hv < 2; ++hv)
#pragma unroll
            for (int q = 0; q < 2; ++q) { const int cc = hv * D_FF + c + 4 * q;
                const f32x4 a = *(const f32x4*)(um2 + cc), b = *(const f32x4*)(um1 + cc), x0 = *(const f32x4*)(u0 + cc), x1 = *(const f32x4*)(u1 + cc);
                const f32x4 w0 = *(const f32x4*)(cw + cc), w1 = *(const f32x4*)(cw + N_UP + cc), w2 = *(const f32x4*)(cw + 2 * N_UP + cc), bb = *(const f32x4*)(cb + cc);
#pragma unroll
                for (int e = 0; e < 4; ++e) { y0[hv][4 * q + e] = fmaf(w0[e], a[e], fmaf(w1[e], b[e], fmaf(w2[e], x0[e], bb[e]))); y1[hv][4 * q + e] = fmaf(w0[e], b[e], fmaf(w1[e], x0[e], fmaf(w2[e], x1[e], bb[e]))); } }
        float r0[8], r1[8];
#pragma unroll
        for (int e = 0; e < 8; ++e) { const float g0 = y0[0][e], g1 = y1[0][e]; r0[e] = g0 / (1.f + __expf(-g0)) * y0[1][e]; r1[e] = g1 / (1.f + __expf(-g1)) * y1[1][e]; }
        v4u o; o.x = pk2(r0[0], r0[1]); o.y = pk2(r0[2], r0[3]); o.z = pk2(r0[4], r0[5]); o.w = pk2(r0[6], r0[7]);
        *(v4u*)(ACT + (size_t)(blk64 * 64) * D_FF + c) = o;
        o.x = pk2(r1[0], r1[1]); o.y = pk2(r1[2], r1[3]); o.z = pk2(r1[4], r1[5]); o.w = pk2(r1[6], r1[7]);
        *(v4u*)(ACT + (size_t)(blk64 * 64 + 1) * D_FF + c) = o;
    }
}
typedef attn::BlockRef<bf16, bf16> ABlock;
__device__ __forceinline__ ABlock attn_ref(int L, const bf16* Z, bf16* OC, float* LSE) {
    const int c = L >> 9, x = L & 511; const int bh = (x & 7) + 8 * ((x >> 3) & 3), bi = x >> 5;
    const int d = (c == 0) ? 1 : ((c == 1) ? 4 : 16);
    const int r = (c == 0) ? 0 : ((c == 1) ? (bi >> 2) : bi), qb = (c == 0) ? bi : ((c == 1) ? (bi & 3) : 0);
    const int b = bh >> 4, h = bh & 15; const int P0 = qb * attn::QB;
    const size_t row0 = (size_t)b * SEQ + r, rowq = row0 + (size_t)P0 * d;
    ABlock R;
    R.Q = Z + rowq * N_IN + ZQ + h * HEAD_DIM; R.K = Z + row0 * N_IN + ZK + h * HEAD_DIM; R.V = Z + row0 * N_IN + ZV + h * HEAD_DIM;
    R.O = OC + (size_t)c * M_TOK * D_ATTN + rowq * D_ATTN + h * HEAD_DIM; R.L = LSE + (size_t)c * M_TOK * NH + rowq * NH + h;
    R.P0 = P0; R.pitch = d * N_IN; R.opitch = d * D_ATTN; R.lpitch = d * NH;
    { const int j2 = 6 - h + ((c == 0) ? 0 : ((c == 1) ? 4 : 8)); const int n = j2 >> 1;
      R.beta = __builtin_bit_cast(float, (unsigned)(((127 + n) << 23) | ((j2 & 1) ? 0x3504F3 : 0))); }
    return R;
}
__device__ __forceinline__ int attn_skv(int L) { return (L < 512) ? SEQ : ((L < 1024) ? SEQ / 4 : SEQ / 16); }
__device__ __forceinline__ void phase_attn(const bf16* Z, bf16* OC, float* LSE, char* lds, int blk, int G, const int wv) {
    constexpr int TOTAL = 3 * 512, W = 129;
    int L = blk; if (L >= TOTAL) return;
    ABlock cur = attn_ref(L, Z, OC, LSE);
    attn::Seam<bf16> S;
    attn::causal_swa_prime<bf16, bf16>(cur, W, lds, S, wv);
    for (;;) {
        const int Ln = L + G; const bool last = Ln >= TOTAL;
        const ABlock nxt = last ? cur : attn_ref(Ln, Z, OC, LSE);
        attn::causal_swa_block<bf16, bf16>(cur, nxt, attn_skv(L), W, lds, S, wv);
        if (last) break;
        cur = nxt; L = Ln;
    }
}
__device__ __forceinline__ void phase_combine(const bf16* OC, const float* LSE, const float* mixg, bf16* Mx, int gw, int NGW, int lane) {
    const int hq = gw & 3, h = hq * 4 + (lane >> 4), col = h * HEAD_DIM + 8 * (lane & 15);
    const f32x4 g0 = *(const f32x4*)(mixg + col), g1 = *(const f32x4*)(mixg + col + 4);
    constexpr size_t SO = (size_t)M_TOK * D_ATTN, SL = (size_t)M_TOK * NH;
    for (int row = gw >> 2; row < M_TOK; row += 2 * (NGW >> 2)) {
        const int row2 = row + (NGW >> 2); const bool two = row2 < M_TOK; const int rb = two ? row2 : row;
        v4u a[2][3]; float ls[2][3];
#pragma unroll
        for (int u = 0; u < 2; ++u) { const int r = u ? rb : row;
#pragma unroll
            for (int c = 0; c < 3; ++c) { a[u][c] = *(const v4u*)(OC + c * SO + (size_t)r * D_ATTN + col); ls[u][c] = LSE[c * SL + (size_t)r * NH + h]; } }
#pragma unroll
        for (int u = 0; u < 2; ++u) { const int r = u ? rb : row;
            const float mx = fmaxf(ls[u][0], fmaxf(ls[u][1], ls[u][2])); float w0 = __expf(ls[u][0] - mx), w1 = __expf(ls[u][1] - mx), w2 = __expf(ls[u][2] - mx); const float inv = 1.f / (w0 + w1 + w2);
            w0 *= inv; w1 *= inv; w2 *= inv;
            float o[8]; const unsigned* pa = (const unsigned*)&a[u][0]; const unsigned* pb = (const unsigned*)&a[u][1]; const unsigned* pc = (const unsigned*)&a[u][2]; float ss = 0.f;
#pragma unroll
            for (int e = 0; e < 4; ++e) { o[2 * e] = w0 * bflo(pa[e]) + w1 * bflo(pb[e]) + w2 * bflo(pc[e]); o[2 * e + 1] = w0 * bfhi(pa[e]) + w1 * bfhi(pb[e]) + w2 * bfhi(pc[e]); ss += o[2 * e] * o[2 * e] + o[2 * e + 1] * o[2 * e + 1]; }
            ss += lane_xor<1>(ss); ss += lane_xor<2>(ss); ss += lane_xor<4>(ss); ss += lane_xor<8>(ss);
            const float rstd = rsqrtf(ss * (1.f / HEAD_DIM) + NORM_EPS);
            v4u w; w.x = pk2(o[0] * rstd * g0.x, o[1] * rstd * g0.y); w.y = pk2(o[2] * rstd * g0.z, o[3] * rstd * g0.w); w.z = pk2(o[4] * rstd * g1.x, o[5] * rstd * g1.y); w.w = pk2(o[6] * rstd * g1.z, o[7] * rstd * g1.w);
            if (u == 0 || two) *(v4u*)(Mx + (size_t)r * D_MODEL + col) = w; }
    }
}

struct Args { const float* in[14]; float* out; unsigned char* ws; };
typedef const __attribute__((address_space(4))) Args* KArgs;
__global__ void __launch_bounds__(NTHREADS, 2) mega_fwd(Args args) {
    extern __shared__ __attribute__((aligned(16))) unsigned char lds_raw[];
    LAS unsigned char* lds = (LAS unsigned char*)lds_raw;
    volatile LAS unsigned* MISC = (volatile LAS unsigned*)(lds + MISC_OFF);
    const int wv = __builtin_amdgcn_readfirstlane((int)(threadIdx.x >> 6));
    { const int t0 = tid_of(wv); if (t0 < 32) MISC[t0] = 0u; }
    __syncthreads();
#define PHASE_BEGIN() KArgs ka = (KArgs)__builtin_amdgcn_kernarg_segment_ptr(); asm volatile("" : "+s"(ka)); unsigned char* const ws = ka->ws; int wvp = wv; asm volatile("" : "+s"(wvp)); \
    const int tid = tid_of(wvp); const int lane = tid & 63, wave = wvp; int blk_o = blockIdx.x; asm volatile("" : "+s"(blk_o)); int lyr = l; asm volatile("" : "+s"(lyr)); \
    const int G = gridDim.x, blk = blk_o, gw = blk * NWAVES + wave, NGW = G * NWAVES; (void)lane; (void)gw; (void)NGW; (void)blk; (void)G; (void)tid; (void)ws; (void)lyr
#define WSP(T, off) ((T*)(ws + (off)))
#define GRID_BARRIER() do { KArgs kb = (KArgs)__builtin_amdgcn_kernarg_segment_ptr(); asm volatile("" : "+s"(kb)); XcdBarrier bar; bar.bar = (unsigned*)(kb->ws + OFF_CTL); bar.x = xcc; bar.st = MISC + 8; xcd_barrier(bar, wv); } while (0)
    const unsigned xcc = xcd_barrier_post((unsigned*)(args.ws + OFF_CTL), MISC + 8, wv).x;

    { const int l = 0; PHASE_BEGIN();
      phase_xprep(ka->in[0], WSP(bf16, OFF_H), WSP(unsigned long long, OFF_RS), WSP(signed char, OFF_XQ), WSP(float, OFF_SA), gw, NGW, lane);
      phase_strips8(ka->in[9], ka->in[8], WSP(signed char, OFF_WUP), WSP(float, OFF_SB), ka->in[2], ka->in[1], WSP(signed char, OFF_WINQ), WSP(float, OFF_SBIN), lds, blk, G, wave, lane); }
    __syncthreads();
    { const int l = 0; PHASE_BEGIN();
      for (int cl = 0; cl < DEPTH; ++cl) {
        phase_convert(ka->in[2] + (size_t)cl * D_MODEL * N_IN + NQ8, D_MODEL, N_IN - NQ8, WSP(bf16, OFF_WIN) + (size_t)cl * N_IN * D_MODEL + (size_t)NQ8 * D_MODEL, lds, gw, NGW, wave, lane, ka->in[1] + (size_t)cl * D_MODEL, false, N_IN);
        phase_convert(ka->in[7] + (size_t)cl * D_MODEL * D_MODEL, D_MODEL, D_MODEL, WSP(bf16, OFF_WOUT) + (size_t)cl * D_MODEL * D_MODEL, lds, gw, NGW, wave, lane, nullptr);
        phase_convert(ka->in[12] + (size_t)cl * D_FF * D_MODEL, D_FF, D_MODEL, WSP(bf16, OFF_WDN) + (size_t)cl * D_MODEL * D_FF, lds, gw, NGW, wave, lane, nullptr);
      } }
    GRID_BARRIER();

    for (int l = 0; l < DEPTH; ++l) {
        { PHASE_BEGIN();
          pg8::Gemm g{(const bf16*)WSP(signed char, OFF_XQ), (const bf16*)(WSP(signed char, OFF_WINQ) + (size_t)lyr * NQ8 * D_MODEL), M_TOK, NQ8, D_MODEL / 2}; pg8::StaticOrder S; S.init(M_TOK, NQ8, G, blk);
          pg8::EpiIn8 E{pg8::EpiIn{WSP(bf16, OFF_Z), (long)N_IN, 1000, WSP(unsigned long long, OFF_RS) + (size_t)(2 * lyr) * M_TOK, 1.f / (16777216.f * D_MODEL), NORM_EPS}, WSP(float, OFF_SA), WSP(float, OFF_SBIN) + (size_t)lyr * NQ8};
          pg8::gemm_phase<pg8::EpiIn8, pg8::StaticOrder, true, true>(lds, g, S, E, wvp); }
        __syncthreads();
        { PHASE_BEGIN();
          pg8::Gemm g{WSP(bf16, OFF_H), WSP(bf16, OFF_WIN) + (size_t)lyr * N_IN * D_MODEL + (size_t)NQ8 * D_MODEL, M_TOK, N_IN - NQ8, D_MODEL}; pg8::StaticOrder S; S.init(M_TOK, N_IN - NQ8, G, blk);
          pg8::EpiIn E{WSP(bf16, OFF_Z) + NQ8, (long)N_IN, 24 - NQ8 / 256, WSP(unsigned long long, OFF_RS) + (size_t)(2 * lyr) * M_TOK, 1.f / (16777216.f * D_MODEL), NORM_EPS};
          pg8::gemm_phase<pg8::EpiIn, pg8::StaticOrder, true, true>(lds, g, S, E, wvp); }
        GRID_BARRIER();
        { PHASE_BEGIN();
          phase_attn(WSP(bf16, OFF_Z), WSP(bf16, OFF_OC), WSP(float, OFF_LSE), (char*)lds_raw, blk, G, wvp); }
        __syncthreads();
        { PHASE_BEGIN();
          phase_sgu(WSP(bf16, OFF_Z), ka->in[3] + (size_t)lyr * D_SGU, ka->in[4] + (size_t)lyr * NG * CHUNK * CHUNK, ka->in[5] + (size_t)lyr * NG * CHUNK, ka->in[6] + (size_t)lyr * D_MODEL, WSP(bf16, OFF_MX), lds, blk, G, tid, wvp); }
        GRID_BARRIER();
        { PHASE_BEGIN(); phase_combine(WSP(bf16, OFF_OC), WSP(float, OFF_LSE), ka->in[6] + (size_t)lyr * D_MODEL, WSP(bf16, OFF_MX), gw, NGW, lane); }
        GRID_BARRIER();
        { PHASE_BEGIN();
          pg8::Gemm g{WSP(bf16, OFF_MX), WSP(bf16, OFF_WOUT) + (size_t)lyr * D_MODEL * D_MODEL, M_TOK, D_MODEL, D_MODEL}; pg8::StaticOrder S; S.init(M_TOK, D_MODEL, G, blk);
          pg8::EpiRes E{WSP(bf16, OFF_H), WSP(unsigned long long, OFF_RS) + (size_t)(2 * lyr + 1) * M_TOK, (long)D_MODEL};
          pg8::gemm_phase<pg8::EpiRes, pg8::StaticOrder, true, true>(lds, g, S, E, wvp); }
        GRID_BARRIER();
        { PHASE_BEGIN(); phase_quant_rows(WSP(bf16, OFF_H), WSP(signed char, OFF_XQ), WSP(float, OFF_SA), gw, NGW, lane); }
        GRID_BARRIER();
        { PHASE_BEGIN();
          pg8::Gemm g{(const bf16*)WSP(signed char, OFF_XQ), (const bf16*)(WSP(signed char, OFF_WUP) + (size_t)lyr * N_UP * D_MODEL), M_TOK, N_UP, D_MODEL / 2}; pg8::StaticOrder S; S.init(M_TOK, N_UP, G, blk);
          pg8::EpiConv8 E{pg8::EpiConv{WSP(bf16, OFF_ACT), WSP(float, OFF_U4), ka->in[10] + (size_t)lyr * 3 * N_UP, ka->in[11] + (size_t)lyr * N_UP, (long)D_FF, WSP(unsigned long long, OFF_RS) + (size_t)(2 * lyr + 1) * M_TOK, 1.f / (16777216.f * D_MODEL), NORM_EPS},
                            WSP(float, OFF_SA), WSP(float, OFF_SB) + (size_t)lyr * N_UP};
          pg8::gemm_phase<pg8::EpiConv8, pg8::StaticOrder, true, true>(lds, g, S, E, wvp); }
        GRID_BARRIER();
        { PHASE_BEGIN(); phase_convfix(WSP(float, OFF_U4), ka->in[10] + (size_t)lyr * 3 * N_UP, ka->in[11] + (size_t)lyr * N_UP, WSP(bf16, OFF_ACT), (size_t)blk * NTHREADS + tid, (size_t)G * NTHREADS); }
        GRID_BARRIER();
        { PHASE_BEGIN();
          pg8::Gemm g{WSP(bf16, OFF_ACT), WSP(bf16, OFF_WDN) + (size_t)lyr * D_MODEL * D_FF, M_TOK, D_MODEL, D_FF}; pg8::StaticOrder S; S.init(M_TOK, D_MODEL, G, blk);
          pg8::EpiRes E{WSP(bf16, OFF_H), WSP(unsigned long long, OFF_RS) + (size_t)(2 * lyr + 2) * M_TOK, (long)D_MODEL};
          pg8::gemm_phase<pg8::EpiRes, pg8::StaticOrder, true, true>(lds, g, S, E, wvp); }
        GRID_BARRIER();
        if (l + 1 < DEPTH) {
            { PHASE_BEGIN(); phase_quant_rows(WSP(bf16, OFF_H), WSP(signed char, OFF_XQ), WSP(float, OFF_SA), gw, NGW, lane); }
            GRID_BARRIER();
        }
    }
    { const int l = 0; PHASE_BEGIN(); phase_final(WSP(bf16, OFF_H), ka->out, WSP(unsigned long long, OFF_RS) + (size_t)(2 * DEPTH) * M_TOK, ka->in[13], gw, NGW, lane); }
#undef PHASE_BEGIN
#undef WSP
#undef GRID_BARRIER
}

extern "C" void kernel_launch(void* const* d_in, const int* in_sizes, int n_in, void* d_out, int out_size, void* d_ws, size_t ws_size, hipStream_t stream) {
    static int grid = 0;
    if (grid == 0) {
        if (n_in != 14 || out_size != M_TOK * D_MODEL || ws_size < WS_END) { fprintf(stderr, "kernel_launch: unexpected shapes (n_in %d out %d ws %zu need %zu)\n", n_in, out_size, ws_size, (size_t)WS_END); grid = -1; return; }
        int dev = 0, cus = 0, per_cu = 0;
        if (hipGetDevice(&dev) != hipSuccess || hipDeviceGetAttribute(&cus, hipDeviceAttributeMultiprocessorCount, dev) != hipSuccess) { grid = -1; return; }
        if (hipFuncSetAttribute((const void*)mega_fwd, hipFuncAttributeMaxDynamicSharedMemorySize, LDS_BYTES) != hipSuccess) { fprintf(stderr, "kernel_launch: hipFuncSetAttribute failed\n"); grid = -1; return; }
        if (hipOccupancyMaxActiveBlocksPerMultiprocessor(&per_cu, (const void*)mega_fwd, NTHREADS, LDS_BYTES) != hipSuccess || per_cu < 1) { fprintf(stderr, "kernel_launch: occupancy query says %d blocks per CU\n", per_cu); grid = -1; (void)hipGetLastError(); return; }
        grid = cus;
    }
    if (grid < 0) return;
    (void)hipMemsetAsync((char*)d_ws + OFF_CTL, 0, CTL_BYTES, stream);
    Args a{};
    for (int i = 0; i < 14; ++i) a.in[i] = (const float*)d_in[i];
    a.out = (float*)d_out; a.ws = (unsigned char*)d_ws;
    hipLaunchKernelGGL(mega_fwd, dim3(grid), dim3(NTHREADS), LDS_BYTES, stream, a);
}
```

```cpp
#include <hip/hip_runtime.h>
#include <cstdio>
#include <cstdint>
__device__ __forceinline__ int tid_of(int wv) { int t; asm volatile("v_mbcnt_lo_u32_b32 %0, -1, 0\n\tv_mbcnt_hi_u32_b32 %0, -1, %0\n\tv_lshl_add_u32 %0, %1, 6, %0" : "=&v"(t) : "s"(wv)); return t; }
__device__ __forceinline__ void half_swap(float& a, float& b) { asm("s_nop 1\n\tv_permlane32_swap_b32 %0, %1" : "+v"(a), "+v"(b)); }
template <int K> __device__ __forceinline__ float lane_xor(float v) { static_assert(K >= 1 && K <= 16, "lane_xor: within 32 lanes"); return __builtin_bit_cast(float, __builtin_amdgcn_ds_swizzle(__builtin_bit_cast(int, v), (K << 10) | 0x1f)); }
__device__ __forceinline__ float wave_sum(float v) {
    v += lane_xor<1>(v); v += lane_xor<2>(v); v += lane_xor<4>(v); v += lane_xor<8>(v); v += lane_xor<16>(v);
    float a = v, b = v; half_swap(a, b);
    return a + b;
}
namespace pg8 {
#define PG8_LAS __attribute__((address_space(3)))
typedef unsigned short bf16_t;
typedef short bf16x8 __attribute__((ext_vector_type(8)));
typedef float f32x4 __attribute__((ext_vector_type(4)));
typedef unsigned u32x4 __attribute__((ext_vector_type(4)));
constexpr int BM = 256, BK = 64, HALF = 128, HTB = HALF * BK * 2  , STAGE_BYTES = 8 * HTB, NXCD = 8, WGM = 8;

__host__ __device__ __forceinline__ int lds_byte(int r, int c) { const int st = (r >> 4) * 2 + (c >> 5), rr = r & 15, cc = c & 31, ob = rr * 64 + cc * 2; return st * 1024 + (ob ^ (((ob >> 9) & 1) << 5)); }
__host__ __device__ __forceinline__ void stage_rc(int b, int& R, int& C) { const int st = b / 1024, sb = b % 1024, swz = sb ^ (((sb >> 9) & 1) << 5); R = (st >> 1) * 16 + swz / 64; C = (st & 1) * 32 + (swz % 64) / 2; }
__host__ __device__ __forceinline__ int perm32(int rho) { const int n = rho >> 4, i = rho & 15; return 8 * (i >> 2) + 4 * n + (i & 3); }

struct Unit { int pm, pn; };
struct Gemm { const bf16_t* A; const bf16_t* Bt; int M, N, K; };

struct StaticOrder {
    int nM, nN, nwg, G, c;
    __host__ __device__ void init(int M, int N, int G_, int c_) { nM = M / BM; nN = N / BM; nwg = nM * nN; G = G_; c = c_; }
    __host__ __device__ bool next(int i, Unit& u) const {
        const long L = (long)i * G + c; if (L >= nwg) return false;
        int wgid = (int)L; { const int q = nwg / NXCD, r = nwg % NXCD, xcd = wgid % NXCD, off = wgid / NXCD; wgid = (xcd < r ? xcd * (q + 1) : r * (q + 1) + (xcd - r) * q) + off; }
        const int nig = WGM * nN, gid = wgid / nig, fm = gid * WGM, gsz = (nM - fm) < WGM ? (nM - fm) : WGM;
        u.pm = fm + ((wgid % nig) % gsz); u.pn = (wgid % nig) / gsz; return true;
    }
    __device__ __forceinline__ void a_ready(const Unit&) const {}
    __device__ __forceinline__ void done(const Unit&) const {}
};
__device__ __forceinline__ unsigned cvt_pk_bf16(float lo, float hi) { unsigned r; asm volatile("v_cvt_pk_bf16_f32 %0, %1, %2" : "=v"(r) : "v"(lo), "v"(hi)); return r; }
typedef float f32x2 __attribute__((ext_vector_type(2)));
__device__ __forceinline__ f32x2 gelu_pk(f32x2 v) {
    const f32x2 av = __builtin_elementwise_abs(v), d = av * 0.2316418882f + 1.0f;
    f32x2 t; t.x = __builtin_amdgcn_rcpf(d.x); t.y = __builtin_amdgcn_rcpf(d.y);
    f32x2 q = t * 0.5307027145f + (-0.7265760135f); q = q * t + 0.7107068705f; q = q * t + (-0.142248368f); q = q * t + 0.127414796f; q = q * t;
    const f32x2 s = (v * v) * (-0.72134752044f);
    f32x2 e; e.x = __builtin_amdgcn_exp2f(s.x); e.y = __builtin_amdgcn_exp2f(s.y);
    const f32x2 m = v * (q * e), r = v - m;
    f32x2 o; o.x = v.x < 0.f ? m.x : r.x; o.y = v.y < 0.f ? m.y : r.y; return o;
}

struct EpiIn {
    static constexpr bool PERM = true, AFTER_DRAIN = false;
    bf16_t* O; long ldc; long gelu_from_pn; const unsigned long long* rowss; float inv_k, eps;
    __device__ __forceinline__ void operator()(const f32x4 (&acc)[2][2][4][2], const Unit& u, int wr, int wc, int fr, int fq) const {
        const int row0 = u.pm * BM + wr * 64 + fr; const int col0 = u.pn * BM + wc * 32 + 8 * fq;
        const bool act = u.pn >= (int)gelu_from_pn;
#pragma unroll
        for (int ai = 0; ai < 2; ++ai)
#pragma unroll
            for (int m = 0; m < 4; ++m) { bf16_t* rowp = O + (size_t)(row0 + ai * HALF + m * 16) * (size_t)ldc + col0;
                const float rs = __builtin_amdgcn_rsqf((float)rowss[row0 + ai * HALF + m * 16] * inv_k + eps);
#pragma unroll
                for (int bj = 0; bj < 2; ++bj) { f32x4 v0 = acc[ai][bj][m][0] * rs, v1 = acc[ai][bj][m][1] * rs;
                    if (act) { f32x2 a = gelu_pk((f32x2){v0[0], v0[1]}), b = gelu_pk((f32x2){v0[2], v0[3]}), c = gelu_pk((f32x2){v1[0], v1[1]}), d = gelu_pk((f32x2){v1[2], v1[3]});
                        v0 = (f32x4){a.x, a.y, b.x, b.y}; v1 = (f32x4){c.x, c.y, d.x, d.y}; }
                    u32x4 w; w.x = cvt_pk_bf16(v0[0], v0[1]); w.y = cvt_pk_bf16(v0[2], v0[3]); w.z = cvt_pk_bf16(v1[0], v1[1]); w.w = cvt_pk_bf16(v1[2], v1[3]);
                    *(u32x4*)(rowp + bj * HALF) = w; } }
    }
};
struct EpiBf {
    static constexpr bool PERM = true, AFTER_DRAIN = false;
    bf16_t* O; long ldc;
    __device__ __forceinline__ void operator()(const f32x4 (&acc)[2][2][4][2], const Unit& u, int wr, int wc, int fr, int fq) const {
        const int row0 = u.pm * BM + wr * 64 + fr; const int col0 = u.pn * BM + wc * 32 + 8 * fq;
#pragma unroll
        for (int ai = 0; ai < 2; ++ai)
#pragma unroll
            for (int m = 0; m < 4; ++m) { bf16_t* rowp = O + (size_t)(row0 + ai * HALF + m * 16) * (size_t)ldc + col0;
#pragma unroll
                for (int bj = 0; bj < 2; ++bj) { const f32x4 v0 = acc[ai][bj][m][0], v1 = acc[ai][bj][m][1];
                    u32x4 w; w.x = cvt_pk_bf16(v0[0], v0[1]); w.y = cvt_pk_bf16(v0[2], v0[3]); w.z = cvt_pk_bf16(v1[0], v1[1]); w.w = cvt_pk_bf16(v1[2], v1[3]);
                    *(u32x4*)(rowp + bj * HALF) = w; } }
    }
};
typedef int i32x4 __attribute__((ext_vector_type(4)));
__device__ __forceinline__ f32x4 mma1(bf16x8 w, bf16x8 a, f32x4 c) { return __builtin_amdgcn_mfma_f32_16x16x32_bf16(w, a, c, 0, 0, 0); }
__device__ __forceinline__ i32x4 mma1(bf16x8 w, bf16x8 a, i32x4 c) { return __builtin_amdgcn_mfma_i32_16x16x64_i8(__builtin_bit_cast(i32x4, w), __builtin_bit_cast(i32x4, a), c, 0, 0, 0); }
template <class E, class = void> struct AccOf { typedef f32x4 type; };
template <class E> struct AccOf<E, decltype((void)sizeof(typename E::AccT))> { typedef typename E::AccT type; };
template <int CTRL> __device__ __forceinline__ float dpp_z(float src) { return __builtin_bit_cast(float, __builtin_amdgcn_update_dpp(0, __builtin_bit_cast(int, src), CTRL, 0xf, 0xf, true)); }
template <int CTRL> __device__ __forceinline__ float dpp_f(float oldv, float src) { return __builtin_bit_cast(float, __builtin_amdgcn_update_dpp(__builtin_bit_cast(int, oldv), __builtin_bit_cast(int, src), CTRL, 0xf, 0xf, false)); }
struct EpiConv {
    static constexpr bool PERM = true, AFTER_DRAIN = false;
    bf16_t* ACT; float* U4; const float* cw; const float* cb; long dff; const unsigned long long* rowss; float inv_k, eps;
    __device__ __forceinline__ void operator()(f32x4 (&acc)[2][2][4][2], const Unit& u, int wr, int wc, int fr, int fq) const {
#pragma unroll
        for (int ai = 0; ai < 2; ++ai)
#pragma unroll
            for (int m = 0; m < 4; ++m) { const float rs = __builtin_amdgcn_rsqf((float)rowss[u.pm * BM + ai * HALF + wr * 64 + m * 16 + fr] * inv_k + eps);
#pragma unroll
                for (int bj = 0; bj < 2; ++bj)
#pragma unroll
                    for (int n = 0; n < 2; ++n) acc[ai][bj][m][n] = acc[ai][bj][m][n] * rs; }
        body(acc, u, wr, wc, fr, fq);
    }
    __device__ __forceinline__ void body(f32x4 (&acc)[2][2][4][2], const Unit& u, int wr, int wc, int fr, int fq) const {
        const int ch0 = u.pn * 128 + wc * 32 + 8 * fq;
        const int n2 = 2 * (int)dff;
        { const int slot = (fr < 2) ? fr : fr - 12;
          if (fr < 2 || fr >= 14) {
#pragma unroll
              for (int ai = 0; ai < 2; ++ai) { float* p = U4 + ((size_t)(u.pm * 4 + ai * 2 + wr) * 4 + slot) * (size_t)n2 + ch0;
#pragma unroll
                  for (int bj = 0; bj < 2; ++bj)
#pragma unroll
                      for (int n = 0; n < 2; ++n) *(f32x4*)(p + bj * dff + 4 * n) = (fr < 2) ? acc[ai][bj][0][n] : acc[ai][bj][3][n]; } } }
#pragma unroll
        for (int bj = 0; bj < 2; ++bj) {
            const float* wp = cw + bj * dff + ch0; const float* bp = cb + bj * dff + ch0;
            f32x4 w0[2], w1[2], w2[2], bb[2], w0z[2], w1z[2];
#pragma unroll
            for (int n = 0; n < 2; ++n) { w0[n] = *(const f32x4*)(wp + 4 * n); w1[n] = *(const f32x4*)(wp + n2 + 4 * n); w2[n] = *(const f32x4*)(wp + 2 * (size_t)n2 + 4 * n); bb[n] = *(const f32x4*)(bp + 4 * n);
                w0z[n] = fr < 2 ? w0[n] : (f32x4){0.f, 0.f, 0.f, 0.f}; w1z[n] = fr == 0 ? w1[n] : (f32x4){0.f, 0.f, 0.f, 0.f}; }
#pragma unroll
            for (int ai = 0; ai < 2; ++ai)
#pragma unroll
                for (int m = 3; m >= 0; --m)
#pragma unroll
                    for (int n = 0; n < 2; ++n) { const f32x4 x = acc[ai][bj][m][n]; f32x4 y;
#pragma unroll
                        for (int e = 0; e < 4; ++e) y[e] = fmaf(w2[n][e], x[e], bb[n][e]);
                        if (m > 0) { const f32x4 xp = acc[ai][bj][m - 1][n];
                            asm volatile("s_nop 1\n\t"
                                "v_fmac_f32_dpp %0, %4, %12 row_shr:1 row_mask:0xf bank_mask:0xf\n\tv_fmac_f32_dpp %1, %5, %13 row_shr:1 row_mask:0xf bank_mask:0xf\n\tv_fmac_f32_dpp %2, %6, %14 row_shr:1 row_mask:0xf bank_mask:0xf\n\tv_fmac_f32_dpp %3, %7, %15 row_shr:1 row_mask:0xf bank_mask:0xf\n\t"
                                "v_fmac_f32_dpp %0, %4, %16 row_shr:2 row_mask:0xf bank_mask:0xf\n\tv_fmac_f32_dpp %1, %5, %17 row_shr:2 row_mask:0xf bank_mask:0xf\n\tv_fmac_f32_dpp %2, %6, %18 row_shr:2 row_mask:0xf bank_mask:0xf\n\tv_fmac_f32_dpp %3, %7, %19 row_shr:2 row_mask:0xf bank_mask:0xf\n\t"
                                "v_fmac_f32_dpp %0, %8, %20 row_ror:1 row_mask:0xf bank_mask:0xf\n\tv_fmac_f32_dpp %1, %9, %21 row_ror:1 row_mask:0xf bank_mask:0xf\n\tv_fmac_f32_dpp %2, %10, %22 row_ror:1 row_mask:0xf bank_mask:0xf\n\tv_fmac_f32_dpp %3, %11, %23 row_ror:1 row_mask:0xf bank_mask:0xf\n\t"
                                "v_fmac_f32_dpp %0, %8, %24 row_ror:2 row_mask:0xf bank_mask:0xf\n\tv_fmac_f32_dpp %1, %9, %25 row_ror:2 row_mask:0xf bank_mask:0xf\n\tv_fmac_f32_dpp %2, %10, %26 row_ror:2 row_mask:0xf bank_mask:0xf\n\tv_fmac_f32_dpp %3, %11, %27 row_ror:2 row_mask:0xf bank_mask:0xf"
                                : "+v"(y[0]), "+v"(y[1]), "+v"(y[2]), "+v"(y[3])
                                : "v"(x[0]), "v"(x[1]), "v"(x[2]), "v"(x[3]), "v"(xp[0]), "v"(xp[1]), "v"(xp[2]), "v"(xp[3]),
                                  "v"(w1[n][0]), "v"(w1[n][1]), "v"(w1[n][2]), "v"(w1[n][3]), "v"(w0[n][0]), "v"(w0[n][1]), "v"(w0[n][2]), "v"(w0[n][3]),
                                  "v"(w1z[n][0]), "v"(w1z[n][1]), "v"(w1z[n][2]), "v"(w1z[n][3]), "v"(w0z[n][0]), "v"(w0z[n][1]), "v"(w0z[n][2]), "v"(w0z[n][3])); }
                        else {
                            asm volatile("s_nop 1\n\t"
                                "v_fmac_f32_dpp %0, %4, %8 row_shr:1 row_mask:0xf bank_mask:0xf\n\tv_fmac_f32_dpp %1, %5, %9 row_shr:1 row_mask:0xf bank_mask:0xf\n\tv_fmac_f32_dpp %2, %6, %10 row_shr:1 row_mask:0xf bank_mask:0xf\n\tv_fmac_f32_dpp %3, %7, %11 row_shr:1 row_mask:0xf bank_mask:0xf\n\t"
                                "v_fmac_f32_dpp %0, %4, %12 row_shr:2 row_mask:0xf bank_mask:0xf\n\tv_fmac_f32_dpp %1, %5, %13 row_shr:2 row_mask:0xf bank_mask:0xf\n\tv_fmac_f32_dpp %2, %6, %14 row_shr:2 row_mask:0xf bank_mask:0xf\n\tv_fmac_f32_dpp %3, %7, %15 row_shr:2 row_mask:0xf bank_mask:0xf"
                                : "+v"(y[0]), "+v"(y[1]), "+v"(y[2]), "+v"(y[3])
                                : "v"(x[0]), "v"(x[1]), "v"(x[2]), "v"(x[3]),
                                  "v"(w1[n][0]), "v"(w1[n][1]), "v"(w1[n][2]), "v"(w1[n][3]), "v"(w0[n][0]), "v"(w0[n][1]), "v"(w0[n][2]), "v"(w0[n][3])); }
                        acc[ai][bj][m][n] = y; }
        }
        const int row0 = u.pm * BM + wr * 64 + fr;
#pragma unroll
        for (int ai = 0; ai < 2; ++ai)
#pragma unroll
            for (int m = 0; m < 4; ++m) { float r[8];
#pragma unroll
                for (int n = 0; n < 2; ++n)
#pragma unroll
                    for (int e = 0; e < 4; ++e) { const float g = acc[ai][0][m][n][e]; r[4 * n + e] = g * __builtin_amdgcn_rcpf(1.f + __builtin_amdgcn_exp2f(-1.4426950408889634f * g)) * acc[ai][1][m][n][e]; }
                u32x4 w; w.x = cvt_pk_bf16(r[0], r[1]); w.y = cvt_pk_bf16(r[2], r[3]); w.z = cvt_pk_bf16(r[4], r[5]); w.w = cvt_pk_bf16(r[6], r[7]);
                *(u32x4*)(ACT + (size_t)(row0 + ai * HALF + m * 16) * (size_t)dff + ch0) = w; }
    }
};
struct EpiIn8 {
    static constexpr bool PERM = true, AFTER_DRAIN = false; typedef i32x4 AccT;
    EpiIn core; const float* sA; const float* sB;
    __device__ __forceinline__ void operator()(i32x4 (&acc)[2][2][4][2], const Unit& u, int wr, int wc, int fr, int fq) const {
        f32x4 cs[2][2];
#pragma unroll
        for (int bj = 0; bj < 2; ++bj)
#pragma unroll
            for (int n = 0; n < 2; ++n) cs[bj][n] = *(const f32x4*)(sB + u.pn * BM + bj * HALF + wc * 32 + 8 * fq + 4 * n);
        f32x4 af[2][2][4][2];
#pragma unroll
        for (int ai = 0; ai < 2; ++ai)
#pragma unroll
            for (int m = 0; m < 4; ++m) { const float rf = sA[u.pm * BM + ai * HALF + wr * 64 + m * 16 + fr];
#pragma unroll
                for (int bj = 0; bj < 2; ++bj)
#pragma unroll
                    for (int n = 0; n < 2; ++n) af[ai][bj][m][n] = __builtin_convertvector(acc[ai][bj][m][n], f32x4) * rf * cs[bj][n]; }
        core(af, u, wr, wc, fr, fq);
    }
};
struct EpiConv8 {
    static constexpr bool PERM = true, AFTER_DRAIN = false; typedef i32x4 AccT;
    EpiConv core; const float* sA; const float* sB;
    __device__ __forceinline__ void operator()(i32x4 (&acc)[2][2][4][2], const Unit& u, int wr, int wc, int fr, int fq) const {
        f32x4 cs[2][2];
#pragma unroll
        for (int bj = 0; bj < 2; ++bj)
#pragma unroll
            for (int n = 0; n < 2; ++n) cs[bj][n] = *(const f32x4*)(sB + u.pn * BM + bj * HALF + wc * 32 + 8 * fq + 4 * n);
        f32x4 af[2][2][4][2];
#pragma unroll
        for (int ai = 0; ai < 2; ++ai)
#pragma unroll
            for (int m = 0; m < 4; ++m) { const int row = u.pm * BM + ai * HALF + wr * 64 + m * 16 + fr;
                const float rf = sA[row] * __builtin_amdgcn_rsqf((float)core.rowss[row] * core.inv_k + core.eps);
#pragma unroll
                for (int bj = 0; bj < 2; ++bj)
#pragma unroll
                    for (int n = 0; n < 2; ++n) af[ai][bj][m][n] = __builtin_convertvector(acc[ai][bj][m][n], f32x4) * rf * cs[bj][n]; }
        core.body(af, u, wr, wc, fr, fq);
    }
};
struct EpiRes {
    static constexpr bool PERM = true, AFTER_DRAIN = false;
    bf16_t* xb; unsigned long long* rowss; long ldc;
    __device__ __forceinline__ void operator()(const f32x4 (&acc)[2][2][4][2], const Unit& u, int wr, int wc, int fr, int fq) const {
        const int row0 = u.pm * BM + wr * 64 + fr, col0 = u.pn * BM + wc * 32 + 8 * fq;
#pragma unroll
        for (int ai = 0; ai < 2; ++ai) {
            u32x4 bs[4][2];
#pragma unroll
            for (int m = 0; m < 4; ++m)
#pragma unroll
                for (int bj = 0; bj < 2; ++bj) bs[m][bj] = *(const u32x4*)(xb + (size_t)(row0 + ai * HALF + m * 16) * (size_t)ldc + col0 + bj * HALF);
#pragma unroll
            for (int m = 0; m < 4; ++m) { const int row = row0 + ai * HALF + m * 16; float ss = 0.f;
#pragma unroll
                for (int bj = 0; bj < 2; ++bj) { const u32x4 b = bs[m][bj]; const f32x4 a0 = acc[ai][bj][m][0], a1 = acc[ai][bj][m][1];
                    const float v0 = __builtin_bit_cast(float, b.x << 16) + a0[0], v1 = __builtin_bit_cast(float, b.x & 0xffff0000u) + a0[1], v2 = __builtin_bit_cast(float, b.y << 16) + a0[2], v3 = __builtin_bit_cast(float, b.y & 0xffff0000u) + a0[3];
                    const float v4 = __builtin_bit_cast(float, b.z << 16) + a1[0], v5 = __builtin_bit_cast(float, b.z & 0xffff0000u) + a1[1], v6 = __builtin_bit_cast(float, b.w << 16) + a1[2], v7 = __builtin_bit_cast(float, b.w & 0xffff0000u) + a1[3];
                    ss += ((v0 * v0 + v1 * v1) + (v2 * v2 + v3 * v3)) + ((v4 * v4 + v5 * v5) + (v6 * v6 + v7 * v7));
                    u32x4 w; w.x = cvt_pk_bf16(v0, v1); w.y = cvt_pk_bf16(v2, v3); w.z = cvt_pk_bf16(v4, v5); w.w = cvt_pk_bf16(v6, v7);
                    *(u32x4*)(xb + (size_t)row * (size_t)ldc + col0 + bj * HALF) = w; }
                ss += __builtin_bit_cast(float, __builtin_amdgcn_ds_swizzle(__builtin_bit_cast(int, ss), (16 << 10) | 0x1f));
                { float sa = ss, sb = ss; asm("s_nop 1\n\tv_permlane32_swap_b32 %0, %1" : "+v"(sa), "+v"(sb)); ss = sa + sb; }
                if (fq == 0) __hip_atomic_fetch_add(rowss + row, (unsigned long long)(long long)__builtin_rintf(ss * 16777216.f), __ATOMIC_RELAXED, __HIP_MEMORY_SCOPE_AGENT); }
        }
    }
};

template <class Epi, class Sched, bool ALIGN_EPI = false, bool SP2 = false>
__device__ __forceinline__ void gemm_phase(PG8_LAS unsigned char* lds, const Gemm g, const Sched& S, const Epi& E, const int wv) {
    const int tid_o = tid_of(wv);
    const int tid = tid_o, wid = __builtin_amdgcn_readfirstlane(tid >> 6), lane = tid & 63, wr = wid >> 2, wc = wid & 3, fr = lane & 15, fq = lane >> 4;
    const int K = g.K, nt = K / BK;
    unsigned voffA[2], voffB[2];
#pragma unroll
    for (int i = 0; i < 2; ++i) { int R, C; stage_rc(tid * 16 + i * 8192, R, C); const int Rb = Epi::PERM ? ((R & ~31) + perm32(R & 31)) : R;
        voffA[i] = (unsigned)(R * K + C) * 2u; voffB[i] = (unsigned)(Rb * K + C) * 2u; }
    const size_t kstep = (size_t)(BK * 2);
    const size_t hstep = (size_t)HALF * K * 2;
    const size_t tstep = 2 * hstep;
    const unsigned ldsw = (unsigned)wid * 1024u;
    const int aoff = lds_byte(wr * 64 + fr, fq * 8), boff = lds_byte(wc * 32 + fr, fq * 8);
#define PG8_SA(b, h) (((b) * 2 + (h)) * HTB)
#define PG8_SB(b, h) ((4 + (b) * 2 + (h)) * HTB)
#define PG8_STAGE(bufoff, gbase, voff) do { _Pragma("unroll") for (int _i = 0; _i < 2; ++_i) \
        __builtin_amdgcn_global_load_lds((const unsigned*)((const char*)(gbase) + (voff)[_i]), (PG8_LAS unsigned*)(lds + (bufoff) + ldsw + _i * 8192), 16, 0, 0); } while (0)
#define PG8_LDA(dst, b, h) do { _Pragma("unroll") for (int m = 0; m < 4; ++m) _Pragma("unroll") for (int k = 0; k < 2; ++k) dst[m][k] = *(const PG8_LAS bf16x8*)(lds + PG8_SA(b, h) + aoff + m * 2048 + k * 1024); } while (0)
#define PG8_LDB(dst, b, h) do { _Pragma("unroll") for (int n = 0; n < 2; ++n) _Pragma("unroll") for (int k = 0; k < 2; ++k) dst[n][k] = *(const PG8_LAS bf16x8*)(lds + PG8_SB(b, h) + boff + n * 2048 + k * 1024); } while (0)
#define PG8_MMA(ai, bj, At, Bt) do { __builtin_amdgcn_s_setprio(1); _Pragma("unroll") for (int m = 0; m < 4; ++m) _Pragma("unroll") for (int n = 0; n < 2; ++n) _Pragma("unroll") for (int k = 0; k < 2; ++k) \
        acc[ai][bj][m][n] = mma1(Bt[n][k], At[m][k], acc[ai][bj][m][n]); __builtin_amdgcn_s_setprio(0); } while (0)
#define PG8_WAIT_V(n) asm volatile("s_waitcnt vmcnt(" #n ")" ::: "memory")
#define PG8_WAIT_L(n) asm volatile("s_waitcnt lgkmcnt(" #n ")" ::: "memory")
#define PG8_BAR __builtin_amdgcn_s_barrier()
#define PG8_SCHED __builtin_amdgcn_sched_barrier(0)
    Unit cur, nxt; int ui = 0;
    if (!S.next(0, cur)) return;
    typedef typename AccOf<Epi>::type AccT;
    AccT acc[2][2][4][2];
#pragma unroll
    for (int a = 0; a < 2; ++a)
#pragma unroll
        for (int b = 0; b < 2; ++b)
#pragma unroll
            for (int m = 0; m < 4; ++m)
#pragma unroll
                for (int n = 0; n < 2; ++n) acc[a][b][m][n] = (AccT){0, 0, 0, 0};
    bf16x8 At[4][2], B0[2][2], B1[2][2];
    const char* cA = (const char*)g.A + (size_t)cur.pm * tstep; const char* cB = (const char*)g.Bt + (size_t)cur.pn * tstep;
    S.a_ready(cur);
    if constexpr (SP2) {
        PG8_STAGE(PG8_SB(0, 0), cB, voffB); PG8_STAGE(PG8_SB(0, 1), cB + hstep, voffB); PG8_STAGE(PG8_SA(0, 0), cA, voffA); PG8_STAGE(PG8_SA(0, 1), cA + hstep, voffA);
        if (wr == 1) PG8_BAR;
        PG8_WAIT_V(2); PG8_BAR;
        PG8_STAGE(PG8_SB(1, 0), cB + kstep, voffB); PG8_STAGE(PG8_SA(1, 0), cA + kstep, voffA); PG8_STAGE(PG8_SB(1, 1), cB + hstep + kstep, voffB);
        PG8_WAIT_V(6); PG8_BAR;
    } else {
        PG8_STAGE(PG8_SB(0, 0), cB, voffB); PG8_STAGE(PG8_SA(0, 0), cA, voffA); PG8_STAGE(PG8_SB(0, 1), cB + hstep, voffB); PG8_STAGE(PG8_SA(0, 1), cA + hstep, voffA);
        if (wr == 1) PG8_BAR;
        PG8_WAIT_V(4); PG8_BAR;
        PG8_STAGE(PG8_SB(1, 0), cB + kstep, voffB); PG8_STAGE(PG8_SA(1, 0), cA + kstep, voffA); PG8_STAGE(PG8_SB(1, 1), cB + hstep + kstep, voffB);
        PG8_WAIT_V(6); PG8_BAR;
    }
    for (;;) {
        const bool has_next = S.next(ui + 1, nxt);
        const char* nA = has_next ? (const char*)g.A + (size_t)nxt.pm * tstep : cA; const char* nB = has_next ? (const char*)g.Bt + (size_t)nxt.pn * tstep : cB;
        for (int t = 0; t < nt; t += 2) {
            const bool last = (t == nt - 2);
            const char* a1 = cA + (size_t)(t + 1) * kstep;
            const char* a2 = last ? nA : cA + (size_t)(t + 2) * kstep; const char* b2 = last ? nB : cB + (size_t)(t + 2) * kstep;
            const char* a3 = a2 + kstep; const char* b3 = b2 + kstep;
            if (last && has_next) S.a_ready(nxt);
            if constexpr (SP2) {
            PG8_LDB(B0, 0, 0); PG8_LDB(B1, 0, 1); PG8_SCHED; PG8_LDA(At, 0, 0); PG8_STAGE(PG8_SA(1, 1), a1 + hstep, voffA);
            PG8_WAIT_V(8); PG8_WAIT_L(0); PG8_BAR; PG8_MMA(0, 0, At, B0); PG8_MMA(0, 1, At, B1); PG8_BAR; PG8_SCHED;
            PG8_LDA(At, 0, 1); PG8_STAGE(PG8_SB(0, 0), b2, voffB); PG8_STAGE(PG8_SB(0, 1), b2 + hstep, voffB); PG8_STAGE(PG8_SA(0, 0), a2, voffA);
            PG8_WAIT_V(8); PG8_WAIT_L(0); PG8_BAR; PG8_MMA(1, 0, At, B0); PG8_MMA(1, 1, At, B1); PG8_BAR; PG8_SCHED;
            PG8_LDB(B0, 1, 0); PG8_LDB(B1, 1, 1); PG8_SCHED; PG8_LDA(At, 1, 0); PG8_STAGE(PG8_SA(0, 1), a2 + hstep, voffA);
            PG8_WAIT_V(8); PG8_WAIT_L(0); PG8_BAR; PG8_MMA(0, 0, At, B0); PG8_MMA(0, 1, At, B1); PG8_BAR; PG8_SCHED;
            PG8_LDA(At, 1, 1); PG8_STAGE(PG8_SB(1, 0), b3, voffB); PG8_STAGE(PG8_SB(1, 1), b3 + hstep, voffB); PG8_STAGE(PG8_SA(1, 0), a3, voffA);
            PG8_WAIT_V(8); PG8_WAIT_L(0); PG8_BAR; PG8_MMA(1, 0, At, B0); PG8_MMA(1, 1, At, B1); PG8_BAR; PG8_SCHED;
            } else {
            PG8_LDB(B0, 0, 0); PG8_SCHED; PG8_LDA(At, 0, 0); PG8_STAGE(PG8_SA(1, 1), a1 + hstep, voffA);
            PG8_WAIT_L(8); PG8_BAR; PG8_WAIT_L(0); PG8_MMA(0, 0, At, B0); PG8_BAR; PG8_SCHED;
            PG8_LDB(B1, 0, 1); PG8_STAGE(PG8_SB(0, 0), b2, voffB);
            PG8_BAR; PG8_WAIT_L(0); PG8_MMA(0, 1, At, B1); PG8_BAR;
            PG8_LDA(At, 0, 1); PG8_STAGE(PG8_SA(0, 0), a2, voffA);
            PG8_BAR; PG8_WAIT_L(0); PG8_MMA(1, 0, At, B0); PG8_BAR; PG8_SCHED;
            PG8_STAGE(PG8_SB(0, 1), b2 + hstep, voffB);
            PG8_WAIT_V(6); PG8_BAR; PG8_MMA(1, 1, At, B1); PG8_BAR;
            PG8_LDB(B0, 1, 0); PG8_SCHED; PG8_LDA(At, 1, 0); PG8_STAGE(PG8_SA(0, 1), a2 + hstep, voffA);
            PG8_WAIT_L(8); PG8_BAR; PG8_WAIT_L(0); PG8_MMA(0, 0, At, B0); PG8_BAR; PG8_SCHED;
            PG8_LDB(B1, 1, 1); PG8_STAGE(PG8_SB(1, 0), b3, voffB);
            PG8_BAR; PG8_WAIT_L(0); PG8_MMA(0, 1, At, B1); PG8_BAR;
            PG8_LDA(At, 1, 1); PG8_STAGE(PG8_SA(1, 0), a3, voffA);
            PG8_BAR; PG8_WAIT_L(0); PG8_MMA(1, 0, At, B0); PG8_BAR; PG8_SCHED;
            PG8_STAGE(PG8_SB(1, 1), b3 + hstep, voffB);
            PG8_WAIT_V(6); PG8_BAR; PG8_MMA(1, 1, At, B1); PG8_BAR;
            }
        }
        if constexpr (ALIGN_EPI) { if (wr == 0) PG8_BAR; }
        if constexpr (!Epi::AFTER_DRAIN) { E(acc, cur, wr, wc, fr, fq); S.done(cur); }
        if (!has_next) break;
#pragma unroll
        for (int a = 0; a < 2; ++a)
#pragma unroll
            for (int b = 0; b < 2; ++b)
#pragma unroll
                for (int m = 0; m < 4; ++m)
#pragma unroll
                    for (int n = 0; n < 2; ++n) acc[a][b][m][n] = (AccT){0, 0, 0, 0};
        cur = nxt; cA = nA; cB = nB; ++ui;
        if constexpr (ALIGN_EPI) { if (wr == 1) PG8_BAR; }
    }
    PG8_WAIT_V(0);
    if constexpr (!ALIGN_EPI) { if (wr == 0) PG8_BAR; }
    PG8_BAR;
    if constexpr (Epi::AFTER_DRAIN) { E.fused(acc, cur, wr, wc, fr, fq, lds, wid, lane); S.done(cur); }
#undef PG8_SA
#undef PG8_SB
#undef PG8_STAGE
#undef PG8_LDA
#undef PG8_LDB
#undef PG8_MMA
#undef PG8_WAIT_V
#undef PG8_WAIT_L
#undef PG8_BAR
#undef PG8_SCHED
}
}
#define LAS __attribute__((address_space(3)))
#define XB_TMO      128
#define XB_XCNT(j)  (256  + 64 * (j))
#define XB_XSUB(j)  (1280 + 64 * (j))
#define XB_XGEN(j)  (2304 + 64 * (j))
#define XB_TOP      3328
#define XB_TOPGEN   3392
#define XCD_BAR_WORDS 3456
#define XB_SPIN_CAP (1u << 18)

__device__ __forceinline__ unsigned xb_ld(unsigned* p)              { return __hip_atomic_load(p, __ATOMIC_RELAXED, __HIP_MEMORY_SCOPE_AGENT); }
__device__ __forceinline__ unsigned xb_add(unsigned* p, unsigned v) { return __hip_atomic_fetch_add(p, v, __ATOMIC_RELAXED, __HIP_MEMORY_SCOPE_AGENT); }
__device__ __forceinline__ unsigned xb_xcc_id() { return (unsigned)__builtin_amdgcn_s_getreg((3 << 11) | 20) & 0xFu; }
#define XB_SPIN(cond, bar) do { unsigned _sp = 0; while (cond) { __builtin_amdgcn_s_sleep(1); \
    if ((++_sp & 255u) == 0u) { if (xb_ld(&(bar)[XB_TMO])) break; if (_sp > XB_SPIN_CAP) { atomicAdd(&(bar)[XB_TMO], 1u); break; } } } } while (0)

struct XcdBarrier {
    unsigned* bar; unsigned x;
    volatile LAS unsigned* st;
};

__device__ __forceinline__ XcdBarrier xcd_barrier_post(unsigned* bar, volatile LAS unsigned* st, const int wv) {
    XcdBarrier b; b.bar = bar; b.x = (unsigned)__builtin_amdgcn_readfirstlane((int)xb_xcc_id()); b.st = st;
    if (tid_of(wv) == 0) (void)xb_add(&bar[XB_XCNT(b.x)], 1u);
    return b;
}
__device__ __forceinline__ void xcd_barrier_complete(unsigned* bar, unsigned x, unsigned& nloc, unsigned& nx) {
    const unsigned G = gridDim.x * gridDim.y * gridDim.z;
    unsigned sum, cnt, mine, sp = 0u;
    for (;;) {
        sum = 0u; cnt = 0u; mine = 0u;
#pragma unroll
        for (unsigned j = 0; j < 16; ++j) { const unsigned c = xb_ld(&bar[XB_XCNT(j)]); sum += c; cnt += (c > 0u) ? 1u : 0u; mine = (j == x) ? c : mine; }
        if (sum == G) break;
        __builtin_amdgcn_s_sleep(1);
        if ((++sp & 255u) == 0u) { if (xb_ld(&bar[XB_TMO])) break; if (sp > XB_SPIN_CAP) { atomicAdd(&bar[XB_TMO], 1u); break; } }
    }
    nloc = mine > 0u ? mine : 1u; nx = cnt > 0u ? cnt : 1u;
}

__device__ __forceinline__ void xcd_barrier(const XcdBarrier& b, const int wv) {
    asm volatile("s_waitcnt vmcnt(0)" ::: "memory");
    __syncthreads();
    if (tid_of(wv) == 0) {
        unsigned* bar = b.bar; unsigned bx = b.x; asm volatile("" : "+s"(bx));
        __builtin_amdgcn_s_waitcnt(0);
        unsigned nloc = b.st[0], nx = b.st[1];
        if (nloc == 0u) { xcd_barrier_complete(bar, bx, nloc, nx); b.st[0] = nloc; b.st[1] = nx; }
        const unsigned old = xb_add(&bar[XB_XSUB(bx)], 1u);
        const unsigned gen = old / nloc;
        if (old + 1u == (gen + 1u) * nloc) {
            __builtin_amdgcn_fence(__ATOMIC_RELEASE, "agent");
            asm volatile("s_waitcnt vmcnt(0)" ::: "memory");
            const unsigned og = xb_add(&bar[XB_TOP], 1u);
            const unsigned tg = og / nx;
            if (og + 1u == (tg + 1u) * nx) xb_add(&bar[XB_TOPGEN], 1u);
            else XB_SPIN(xb_ld(&bar[XB_TOPGEN]) == tg, bar);
            __builtin_amdgcn_fence(__ATOMIC_ACQUIRE, "agent");
            xb_add(&bar[XB_XGEN(bx)], 1u);
            asm volatile("s_waitcnt vmcnt(0)" ::: "memory");
        } else {
            XB_SPIN(xb_ld(&bar[XB_XGEN(bx)]) == gen, bar);
            __builtin_amdgcn_fence(__ATOMIC_ACQUIRE, "agent");
            asm volatile("s_waitcnt vmcnt(0)" ::: "memory");
        }
    }
    __syncthreads();
}

namespace attn {
constexpr int D = 128;
constexpr float THR = 8.f;
constexpr bool WSKIP = true;
constexpr float SCALE = 0.08838834764831845f;
constexpr int NW = 8, QBLK = 32, KVBLK = 64, QB = NW * QBLK;
constexpr int SHM_V = KVBLK * D * 2, SHM_K = KVBLK * D * 2;
constexpr int LDS_BYTES = 2 * SHM_V + 2 * SHM_K + NW * 64 * 4;
typedef short bf16x8 __attribute__((ext_vector_type(8)));
typedef short s16x4 __attribute__((ext_vector_type(4)));
typedef float f32x16 __attribute__((ext_vector_type(16)));
typedef float f32x4 __attribute__((ext_vector_type(4)));
typedef unsigned u32x4 __attribute__((ext_vector_type(4)));
template <class A, class Bt> struct same_t { static constexpr bool v = false; };
template <class A> struct same_t<A, A> { static constexpr bool v = true; };

#define KSWZ(row, colB) ((row) * 256 + ((colB) ^ (((row) & 7) << 4)))
#define SBAR() __builtin_amdgcn_sched_barrier(0)
__device__ __forceinline__ int v_st(int k, int c) { const int kk = (k & ~0xC) | ((k & 4) << 1) | ((k & 8) >> 1); return ((kk >> 3) * 4 + (c >> 5)) * 512 + ((kk & 7) * 32 + (c & 31)) * 2; }
__device__ __forceinline__ int v_rd_base(int lane) { return ((lane & 3) << 3) | (((lane >> 2) & 3) << 6) | (((lane >> 4) & 1) << 5) | (((lane >> 5) & 1) << 8); }
constexpr int v_rd_off(int d0, int ks, int half) { return d0 * 512 + ks * 4096 + half * 2048; }
__device__ __forceinline__ int crow(int r, int hi) { return (r & 3) + 8 * (r >> 2) + 4 * hi; }
__device__ __forceinline__ unsigned cvtpk(float lo, float hi) {
    unsigned r; asm volatile("v_cvt_pk_bf16_f32 %0, %1, %2" : "=v"(r) : "v"(lo), "v"(hi)); return r;
}
__device__ __forceinline__ bf16x8 pack8(f32x4 a, f32x4 b) {
    u32x4 w = {cvtpk(a[0], a[1]), cvtpk(a[2], a[3]), cvtpk(b[0], b[1]), cvtpk(b[2], b[3])};
    return *reinterpret_cast<bf16x8*>(&w);
}
template <class T> __device__ __forceinline__ bf16x8 load8(const T* p) {
    if constexpr (same_t<T, float>::v) { return pack8(*(const f32x4*)p, *(const f32x4*)(p + 4)); }
    else { return *reinterpret_cast<const bf16x8*>(p); }
}
__device__ __forceinline__ void mask_tile(f32x16& p0, f32x16& p1, int dq, unsigned W) {
    const float NEG = -__builtin_inff();
#pragma unroll
    for (int r = 0; r < 16; ++r) {
        const int c = (r & 3) + 8 * (r >> 2);
        if ((unsigned)(dq - c) >= W) p0[r] = NEG;
        if ((unsigned)(dq - c - 32) >= W) p1[r] = NEG;
    }
}
__device__ __forceinline__ void partialSM(f32x16& p0, f32x16& p1, float& m_reg, float& mn, float& alpha) {
    float pmax = p0[0]; for (int r = 1; r < 16; ++r) pmax = fmaxf(pmax, p0[r]); for (int r = 0; r < 16; ++r) pmax = fmaxf(pmax, p1[r]);
    { float pa_ = pmax, pb_ = pmax; half_swap(pa_, pb_); pmax = fmaxf(pa_, pb_); }
    constexpr float C2 = 1.4426950408889634f * SCALE;
    if (__builtin_expect(__all((pmax - m_reg) * SCALE <= THR), 1)) { mn = m_reg; alpha = 1.f; }
    else { mn = fmaxf(m_reg, pmax); alpha = __builtin_amdgcn_exp2f((m_reg - mn) * C2); m_reg = mn; }
    const float mnL = -mn * C2;
    for (int r = 0; r < 16; ++r) p0[r] = fmaf(p0[r], C2, mnL); for (int r = 0; r < 16; ++r) p1[r] = fmaf(p1[r], C2, mnL);
    for (int r = 0; r < 16; ++r) p0[r] = __builtin_amdgcn_exp2f(p0[r]);
}
__device__ __forceinline__ void finishSM(f32x16& p0, f32x16& p1, float alpha, float& l_reg, bf16x8& pa0, bf16x8& pa1, bf16x8& pa2, bf16x8& pa3) {
    for (int r = 0; r < 16; ++r) p1[r] = __builtin_amdgcn_exp2f(p1[r]);
    float ps = 0; for (int r = 0; r < 16; ++r) ps += p0[r]; for (int r = 0; r < 16; ++r) ps += p1[r];
    { float pa_ = ps, pb_ = ps; half_swap(pa_, pb_); ps = pa_ + pb_; }
    l_reg = l_reg * alpha + ps;
#define PK4(P, B_, OUT) do { unsigned a0 = cvtpk(P[B_+0], P[B_+1]), a1 = cvtpk(P[B_+2], P[B_+3]);                          \
        unsigned b0 = cvtpk(P[B_+4], P[B_+5]), b1 = cvtpk(P[B_+6], P[B_+7]);                                             \
        auto r0 = __builtin_amdgcn_permlane32_swap(a0, b0, false, false); auto r1 = __builtin_amdgcn_permlane32_swap(a1, b1, false, false); \
        u32x4 w = {r0[0], r1[0], r0[1], r1[1]}; OUT = *reinterpret_cast<bf16x8*>(&w); } while (0)
    PK4(p0, 0, pa0); PK4(p0, 8, pa1); PK4(p1, 0, pa2); PK4(p1, 8, pa3);
#undef PK4
}
template <int KB, bool SK>
__device__ __forceinline__ void qkt(f32x16& p0, f32x16& p1, const char* K_lds, int r32, int hi, const bf16x8* qr, bool act, float e0, float beta) {
    if (SK && !act) { const float NEG = -__builtin_inff();
#pragma unroll
        for (int r = 0; r < 16; ++r) { p0[r] = NEG; p1[r] = NEG; } return; }
    { const float b8 = 8.f * beta, b32 = 32.f * beta;
      p0[0] = e0; p0[1] = p0[0] + beta; p0[2] = p0[1] + beta; p0[3] = p0[2] + beta;
#pragma unroll
      for (int r = 4; r < 16; ++r) p0[r] = p0[r - 4] + b8;
#pragma unroll
      for (int r = 0; r < 16; ++r) p1[r] = p0[r] + b32; }
    const char* kb[4];
#pragma unroll
    for (int dd = 0; dd < 4; ++dd) kb[dd] = K_lds + KB * SHM_K + KSWZ(r32, (dd * 16 + hi * 8) * 2);
#pragma unroll
    for (int d0 = 0; d0 < 8; ++d0) { const char* a = kb[d0 & 3] + (d0 >> 2) * 128;
        bf16x8 b0 = *reinterpret_cast<const bf16x8*>(a);
        bf16x8 b1 = *reinterpret_cast<const bf16x8*>(a + 32 * 256);
        p0 = __builtin_amdgcn_mfma_f32_32x32x16_bf16(b0, qr[d0], p0, 0, 0, 0);
        p1 = __builtin_amdgcn_mfma_f32_32x32x16_bf16(b1, qr[d0], p1, 0, 0, 0); }
}
template <int VB, bool SK>
__device__ __forceinline__ void pv_tile(f32x16* o, int vb0, bf16x8 pa0, bf16x8 pa1, bf16x8 pa2, bf16x8 pa3, bool act) {
    if (SK && !act) return;
#define TRRD(dst, off) asm volatile("ds_read_b64_tr_b16 %0, %1 offset:%2" : "=&v"(dst) : "v"(vb0), "i"(off) : "memory")
#define PV_D0(d0) do { s16x4 l0, l1, l2, l3, h0, h1, h2, h3; constexpr int b_ = VB * SHM_V + v_rd_off(d0, 0, 0);     \
        TRRD(l0, b_); TRRD(h0, b_ + 2048); TRRD(l1, b_ + 4096); TRRD(h1, b_ + 6144); TRRD(l2, b_ + 8192); TRRD(h2, b_ + 10240); TRRD(l3, b_ + 12288); TRRD(h3, b_ + 14336); \
        asm volatile("s_waitcnt lgkmcnt(0)" ::: "memory"); SBAR();                 \
        o[d0] = __builtin_amdgcn_mfma_f32_32x32x16_bf16(pa0, (bf16x8){l0[0], l0[1], l0[2], l0[3], h0[0], h0[1], h0[2], h0[3]}, o[d0], 0, 0, 0);   \
        o[d0] = __builtin_amdgcn_mfma_f32_32x32x16_bf16(pa1, (bf16x8){l1[0], l1[1], l1[2], l1[3], h1[0], h1[1], h1[2], h1[3]}, o[d0], 0, 0, 0);   \
        o[d0] = __builtin_amdgcn_mfma_f32_32x32x16_bf16(pa2, (bf16x8){l2[0], l2[1], l2[2], l2[3], h2[0], h2[1], h2[2], h2[3]}, o[d0], 0, 0, 0);   \
        o[d0] = __builtin_amdgcn_mfma_f32_32x32x16_bf16(pa3, (bf16x8){l3[0], l3[1], l3[2], l3[3], h3[0], h3[1], h3[2], h3[3]}, o[d0], 0, 0, 0); } while (0)
    PV_D0(0); PV_D0(1); PV_D0(2); PV_D0(3);
#undef PV_D0
#undef TRRD
}

template <class TIn, class TOut> struct BlockRef { const TIn* Q; const TIn* K; const TIn* V; TOut* O; float* L; int P0; int pitch; int opitch; int lpitch; float beta; };
template <class TIn> struct Seam {
    bf16x8 qr[8];
    bf16x8 st_v0, st_v1, st_k0, st_k1; f32x4 sf0, sf1, sf2, sf3;
    f32x4 tq[16];
};
__device__ __forceinline__ int swa_jlo(int P0, int W) { const int lowk = P0 - W + 1; return lowk > 0 ? lowk / KVBLK : 0; }
#define ROW(p, pt, k0, rr) ((p) + (size_t)((k0) + (rr)) * (size_t)(pt) + sc)
#define VMW() asm volatile("s_waitcnt vmcnt(0)" ::: "memory")
#define VMWN(n) asm volatile("s_waitcnt vmcnt(%0)" :: "i"(n) : "memory")
#define SLOAD_H(Kp, Vp, pt, k0) do { S.st_v0 = load8<TIn>(ROW(Vp, pt, k0, sr)); S.st_v1 = load8<TIn>(ROW(Vp, pt, k0, 32 + sr));              \
                         S.st_k0 = load8<TIn>(ROW(Kp, pt, k0, sr)); S.st_k1 = load8<TIn>(ROW(Kp, pt, k0, 32 + sr)); } while (0)
#define SWRITE_HK(bf) do { *(bf16x8*)(K_lds + (bf) * SHM_K + kws) = S.st_k0; *(bf16x8*)(K_lds + (bf) * SHM_K + kws + 32 * 256) = S.st_k1; } while (0)
#define SWRITE_HV(bf) do { *(bf16x8*)(V_lds + (bf) * SHM_V + vst0) = S.st_v0; *(bf16x8*)(V_lds + (bf) * SHM_V + vst1) = S.st_v1; } while (0)
#define SWRITE_H(bf) do { SWRITE_HV(bf); SWRITE_HK(bf); } while (0)
#define SLOAD_F(p, k0) do { S.sf0 = *(const f32x4*)ROW(p, D, k0, sr); S.sf1 = *(const f32x4*)(ROW(p, D, k0, sr) + 4);                \
                            S.sf2 = *(const f32x4*)ROW(p, D, k0, 32 + sr); S.sf3 = *(const f32x4*)(ROW(p, D, k0, 32 + sr) + 4); } while (0)
#define SWRITE_KF(bf) do { *(bf16x8*)(K_lds + (bf) * SHM_K + kws) = pack8(S.sf0, S.sf1); *(bf16x8*)(K_lds + (bf) * SHM_K + kws + 32 * 256) = pack8(S.sf2, S.sf3); } while (0)
#define SWRITE_VF(bf) do { *(bf16x8*)(V_lds + (bf) * SHM_V + vst0) = pack8(S.sf0, S.sf1); *(bf16x8*)(V_lds + (bf) * SHM_V + vst1) = pack8(S.sf2, S.sf3); } while (0)
template <class TIn, class TOut>
__device__ __forceinline__ void causal_swa_prime(const BlockRef<TIn, TOut>& cur, int W, char* lds, Seam<TIn>& S, const int wv) {
    constexpr bool F32 = same_t<TIn, float>::v;
    const int tid = tid_of(wv), wid = __builtin_amdgcn_readfirstlane(tid >> 6), lane = tid & 63, r32 = lane & 31, hi = lane >> 5;
    const int sr = tid >> 4, sc = (tid & 15) * 8, kws = KSWZ(sr, sc * 2); char* K_lds = lds + 2 * SHM_V;
    const int kb0 = swa_jlo(cur.P0, W) * KVBLK;
    for (int d0 = 0; d0 < 8; ++d0) S.qr[d0] = load8<TIn>(cur.Q + (size_t)(wid * QBLK + r32) * (size_t)cur.pitch + d0 * 16 + hi * 8);
    if constexpr (F32) { SLOAD_F((const float*)cur.K, kb0); VMW(); SWRITE_KF(0); SBAR(); SLOAD_F((const float*)cur.V, kb0); }
    else { SLOAD_H(cur.K, cur.V, cur.pitch, kb0); VMW(); SWRITE_HK(0); }
    __syncthreads();
}
template <class TIn, class TOut>
__device__ __forceinline__ void causal_swa_block(const BlockRef<TIn, TOut>& cur, const BlockRef<TIn, TOut>& nxt, int skv, int W, char* lds, Seam<TIn>& S, const int wv) {
    constexpr bool F32 = same_t<TIn, float>::v;
    const int tid = tid_of(wv), wid = __builtin_amdgcn_readfirstlane(tid >> 6), lane = tid & 63, r32 = lane & 31, hi = lane >> 5;
    const int j_lo = swa_jlo(cur.P0, W);
    int j_hi = (cur.P0 + QB - 1) / KVBLK + 1; if (j_hi > skv / KVBLK) j_hi = skv / KVBLK;
    const int NT = j_hi - j_lo;
    const int kbn = swa_jlo(nxt.P0, W) * KVBLK;
    const int qlo = cur.P0 + wid * QBLK, qm = qlo + r32 - 4 * hi;
    char* V_lds = lds; char* K_lds = lds + 2 * SHM_V;
    float* ws = (float*)(lds + 2 * SHM_V + 2 * SHM_K) + wid * 64; float* li_l = ws, * al_l = ws + 32;
    float m_reg = -1e30f, l_reg = 0; f32x16 o[4] = {};
    const int sr = tid >> 4, sc = (tid & 15) * 8, vst0 = v_st(sr, sc), vst1 = v_st(32 + sr, sc), kws = KSWZ(sr, sc * 2);
    const int vb0 = (int)(uintptr_t)V_lds + v_rd_base(lane);
    const TIn* Kh = cur.K; const TIn* Vh = cur.V; const int pch = cur.pitch; const float beta = cur.beta;
#define RESC(a) do { if (__any((a) < 1.f)) { if (hi == 0) al_l[r32] = (a); asm volatile("s_waitcnt lgkmcnt(0)" ::: "memory");              \
                     for (int d_ = 0; d_ < 4; ++d_) for (int r = 0; r < 16; ++r) o[d_][r] *= al_l[crow(r, hi)]; } } while (0)
#define KBASE(t) ((j_lo + (t)) * KVBLK)
#define ACT(t) (KBASE(t) <= qlo + QBLK - 1 && KBASE(t) + KVBLK - 1 >= qlo - W + 1)
#define MASKT(P0_, P1_, t) do { const int kb_ = KBASE(t); if ((!SK || ACT(t)) && (kb_ + KVBLK - 1 > qlo || kb_ <= qlo + QBLK - 1 - W)) mask_tile(P0_, P1_, qm - kb_, (unsigned)W); } while (0)
    constexpr int NQL = F32 ? 16 : 8;
    constexpr bool SK = WSKIP && !F32;
#define SEAM_K0() do { VMWN(NQL); if constexpr (F32) { SWRITE_KF(0); SBAR(); SLOAD_F((const float*)nxt.V, kbn); } else { SWRITE_HK(0); } SBAR(); } while (0)
    f32x16 pA0, pA1, pB0, pB1; float mnA, mnB, alA, alB; bf16x8 pa0, pa1, pa2, pa3;
    if constexpr (F32) { VMW(); SWRITE_VF(0); SBAR(); } else { SWRITE_HV(0); SBAR(); }
    if (NT > 1) { if constexpr (F32) SLOAD_F((const float*)Kh, KBASE(1)); else SLOAD_H(Kh, Vh, pch, KBASE(1)); }
    SBAR(); qkt<0, SK>(pA0, pA1, K_lds, r32, hi, S.qr, ACT(0), -beta * (float)(qm - KBASE(0)), beta);
    if constexpr (F32) { if (NT > 1) { VMW(); SWRITE_KF(1); SBAR(); SLOAD_F((const float*)Vh, KBASE(1)); } }
    MASKT(pA0, pA1, 0); partialSM(pA0, pA1, m_reg, mnA, alA);
    if (NT > 1) { VMW(); if constexpr (F32) { SWRITE_VF(1); SBAR(); if (NT > 2) SLOAD_F((const float*)Kh, KBASE(2)); } else SWRITE_H(1); }
    __syncthreads();
#define HALF_STEP(PX0, PX1, mnX, alX, PY0, PY1, alY, t, KB, VB, SB) do {                                                      \
        SBAR(); qkt<KB, SK>(PX0, PX1, K_lds, r32, hi, S.qr, ACT(t), -beta * (float)(qm - KBASE(t)), beta);                                             \
        finishSM(PY0, PY1, alY, l_reg, pa0, pa1, pa2, pa3); SBAR();                                                           \
        if ((t) + 1 < NT) { if constexpr (F32) { VMW(); SWRITE_KF(SB); SBAR(); SLOAD_F((const float*)Vh, KBASE((t) + 1)); }  \
                            else { SLOAD_H(Kh, Vh, pch, KBASE((t) + 1)); } SBAR(); }                                               \
        pv_tile<VB, SK>(o, vb0, pa0, pa1, pa2, pa3, ACT((t) - 1)); MASKT(PX0, PX1, (t)); partialSM(PX0, PX1, m_reg, mnX, alX);                                        \
        __syncthreads();                                                                                                      \
        if ((t) + 1 < NT) { VMW(); if constexpr (F32) { SWRITE_VF(SB); SBAR(); if ((t) + 2 < NT) SLOAD_F((const float*)Kh, KBASE((t) + 2)); } \
                            else { SWRITE_H(SB); } }                                                                          \
        RESC(alX); __syncthreads(); } while (0)
    for (int t = 1; t + 1 < NT; t += 2) {
        HALF_STEP(pB0, pB1, mnB, alB, pA0, pA1, alA, t, 1, 0, 0);
        HALF_STEP(pA0, pA1, mnA, alA, pB0, pB1, alB, t + 1, 0, 1, 1);
    }
    const bool even = (NT & 1) == 0;
    if (even) { SBAR(); qkt<1, SK>(pB0, pB1, K_lds, r32, hi, S.qr, ACT(NT - 1), -beta * (float)(qm - KBASE(NT - 1)), beta); SBAR(); }
#define QROW(e) (nxt.Q + (size_t)(wid * QBLK + r32) * D + ((e) >> 1) * 16 + hi * 8 + ((e) & 1) * 4)
    if constexpr (F32) { SLOAD_F((const float*)nxt.K, kbn); SBAR();
#pragma unroll
        for (int e = 0; e < 8; ++e) S.tq[e] = *(const f32x4*)QROW(e); }
    else { SLOAD_H(nxt.K, nxt.V, nxt.pitch, kbn); SBAR();
#pragma unroll
        for (int d0 = 0; d0 < 8; ++d0) S.qr[d0] = load8<TIn>(nxt.Q + (size_t)(wid * QBLK + r32) * (size_t)nxt.pitch + d0 * 16 + hi * 8); }
    SBAR();
    finishSM(pA0, pA1, alA, l_reg, pa0, pa1, pa2, pa3); SBAR();
    if constexpr (F32) {
#pragma unroll
        for (int e = 8; e < 16; ++e) S.tq[e] = *(const f32x4*)QROW(e); SBAR(); }
#undef QROW
    pv_tile<0, SK>(o, vb0, pa0, pa1, pa2, pa3, ACT(even ? NT - 2 : NT - 1));
    if (even) { MASKT(pB0, pB1, NT - 1); partialSM(pB0, pB1, m_reg, mnB, alB); __syncthreads(); RESC(alB);
        finishSM(pB0, pB1, alB, l_reg, pa0, pa1, pa2, pa3); SBAR(); pv_tile<1, SK>(o, vb0, pa0, pa1, pa2, pa3, ACT(NT - 1)); }
    SBAR(); SEAM_K0();
    if (hi == 0) { li_l[r32] = l_reg; cur.L[(size_t)(wid * QBLK + r32) * (size_t)cur.lpitch] = m_reg * SCALE + __logf(l_reg); }
    asm volatile("s_waitcnt lgkmcnt(0)" ::: "memory");
    float rli[16];
#pragma unroll
    for (int r = 0; r < 16; ++r) rli[r] = __builtin_amdgcn_rcpf(li_l[crow(r, hi)]);
    TOut* Ow = cur.O + (size_t)(wid * QBLK) * (size_t)cur.opitch; const size_t opch = (size_t)cur.opitch;
#pragma unroll
    for (int r = 0; r < 16; ++r) { const int orow = crow(r, hi);
#pragma unroll
        for (int d0 = 0; d0 < 4; ++d0) { const float v = o[d0][r] * rli[r];
            if constexpr (same_t<TOut, float>::v) { Ow[(size_t)orow * opch + d0 * 32 + r32] = v; }
            else { const float vn = lane_xor<1>(v);
                   if ((r32 & 1) == 0) *(unsigned*)(Ow + (size_t)orow * opch + d0 * 32 + r32) = cvtpk(v, vn); } } }
    if constexpr (F32) {
#pragma unroll
        for (int d0 = 0; d0 < 8; ++d0) S.qr[d0] = pack8(S.tq[2 * d0], S.tq[2 * d0 + 1]); }
    __syncthreads();
#undef RESC
#undef KBASE
#undef ACT
#undef MASKT
#undef SEAM_K0
#undef HALF_STEP
}
#undef ROW
#undef VMW
#undef VMWN
#undef SLOAD_H
#undef SWRITE_HK
#undef SWRITE_HV
#undef SWRITE_H
#undef SLOAD_F
#undef SWRITE_KF
#undef SWRITE_VF

#undef KSWZ
#undef SBAR
}

typedef unsigned short bf16;
typedef unsigned v4u __attribute__((ext_vector_type(4)));
typedef float f32x4 __attribute__((ext_vector_type(4)));
constexpr int D_MODEL = 4096, BATCH = 2, SEQ = 4096, DEPTH = 2, HEAD_DIM = 128, D_ATTN = 2048, D_SGU = 2048, NH = 16, NG = 16, CHUNK = 128;
constexpr int N_IN = 10240, D_FF = 11008, N_UP = 2 * D_FF, M_TOK = BATCH * SEQ;
constexpr float NORM_EPS = 1e-6f;
constexpr int ZQ = 0, ZK = 2048, ZV = 4096, ZU = 6144, ZV2 = 8192;
constexpr int NWAVES = 8, NTHREADS = 512;
constexpr int NQ8 = 6144;
constexpr int RING_BYTES = 131072, MISC_OFF = 140 * 1024, LDS_BYTES = 147456;
constexpr size_t MiB = 1u << 20;
constexpr size_t SZ_WIN = (size_t)N_IN * D_MODEL * 2, SZ_WOUT = (size_t)D_MODEL * D_MODEL * 2, SZ_WUP = (size_t)N_UP * D_MODEL * 2, SZ_WDN = (size_t)D_MODEL * D_FF * 2;
constexpr size_t OFF_CTL = 0, OFF_RS = 16384, RS_BYTES = (size_t)M_TOK * 8, OFF_CMAX = OFF_RS + 5 * RS_BYTES, CTL_BYTES = OFF_CMAX + (size_t)DEPTH * N_UP * 4;
constexpr size_t OFF_WIN = 1 * MiB, OFF_WOUT = OFF_WIN + 2 * SZ_WIN, OFF_WUP = OFF_WOUT + 2 * SZ_WOUT, OFF_WDN = OFF_WUP + 2 * SZ_WUP, OFF_H = OFF_WDN + 2 * SZ_WDN;
constexpr size_t OFF_Z = OFF_H + (size_t)M_TOK * D_MODEL * 2, OFF_MX = OFF_Z + (size_t)M_TOK * N_IN * 2, OFF_UP = OFF_MX + (size_t)M_TOK * D_MODEL * 2;
constexpr size_t OFF_ACT = OFF_UP + (size_t)M_TOK * N_UP * 2, OFF_OC = OFF_ACT + (size_t)M_TOK * D_FF * 2, OFF_LSE = OFF_OC + (size_t)3 * M_TOK * D_ATTN * 2, OFF_U4 = OFF_LSE + (size_t)3 * M_TOK * NH * 4, OFF_SB = OFF_U4 + (size_t)(M_TOK / 64) * 4 * N_UP * 4, OFF_SA = OFF_SB + (size_t)DEPTH * N_UP * 4, OFF_XQ = OFF_SA + (size_t)M_TOK * 4, WS_END = OFF_XQ + (size_t)M_TOK * D_MODEL;
constexpr size_t OFF_WINQ = OFF_UP, OFF_SBIN = OFF_WINQ + (size_t)DEPTH * NQ8 * D_MODEL;
static_assert(OFF_SBIN + (size_t)DEPTH * NQ8 * 4 <= OFF_ACT, "int8 input-projection weights fit");
static_assert(CTL_BYTES <= OFF_WIN && XCD_BAR_WORDS * 4 <= OFF_RS, "barrier words inside the memset region");

__device__ __forceinline__ unsigned f2bf(float f) { unsigned u = __builtin_bit_cast(unsigned, f); return (u + 0x7fffu + ((u >> 16) & 1u)) >> 16; }
__device__ __forceinline__ unsigned pk2(float lo, float hi) { return f2bf(lo) | (f2bf(hi) << 16); }
__device__ __forceinline__ float bf2f(unsigned short b) { return __builtin_bit_cast(float, (unsigned)b << 16); }
__device__ __forceinline__ float bflo(unsigned w) { return __builtin_bit_cast(float, w << 16); }
__device__ __forceinline__ float bfhi(unsigned w) { return __builtin_bit_cast(float, w & 0xffff0000u); }
#define LDS_WAIT() asm volatile("s_waitcnt lgkmcnt(0)" ::: "memory")

constexpr int CVT_STRIDE = 192, CVT_TILE = 64 * CVT_STRIDE;
struct CvtRegs { f32x4 v[16]; };
__device__ __forceinline__ void cvt_item_kn(int item, int nblk, int& kb, int& nb) { const int st = item >> 5, w = item & 31, nst = nblk >> 3; const int sk = st / nst, sn = st - sk * nst; kb = 4 * sk + (w >> 3); nb = 8 * sn + (w & 7); }
__device__ __forceinline__ void cvt_load(CvtRegs& R, const float* W, int N, int item, int lane, int nblk) {
    int kb, nb; cvt_item_kn(item, nblk, kb, nb); const float* p = W + (size_t)(64 * kb + (lane >> 4)) * N + 64 * nb + 4 * (lane & 15);
#pragma unroll
    for (int i = 0; i < 16; ++i) R.v[i] = *(const f32x4*)(p + (size_t)(4 * i) * N);
}
__device__ __forceinline__ void cvt_store(const CvtRegs& R, int K, int N, bf16* WT, LAS unsigned char* tile, int item, int lane, int nblk, bool glu, const float* gk) {
    int kb, nb; cvt_item_kn(item, nblk, kb, nb); const int k0 = 64 * kb, n0 = 64 * nb;
    const int half = N / 2, r0 = glu ? ((n0 < half) ? 256 * (n0 >> 7) + (n0 & 127) : 256 * ((n0 - half) >> 7) + 128 + ((n0 - half) & 127)) : n0;
    { LAS unsigned char* wp = tile + (lane >> 4) * CVT_STRIDE + 8 * (lane & 15);
#pragma unroll
      for (int i = 0; i < 16; ++i) { const float gg = gk ? gk[k0 + 4 * i + (lane >> 4)] : 1.f; const f32x4 x = R.v[i] * gg;
          typedef unsigned u32x2 __attribute__((ext_vector_type(2))); u32x2 w; w.x = pk2(x.x, x.y); w.y = pk2(x.z, x.w); *(LAS u32x2*)(wp + 4 * i * CVT_STRIDE) = w; } }
    LDS_WAIT();
    { const int hh = lane >> 5, g = (lane >> 4) & 1, i16 = lane & 15, q = i16 >> 2, p = i16 & 3;
      const int abase = (int)(uintptr_t)tile + (8 * hh + q) * CVT_STRIDE + (16 * g + 4 * p) * 2;
      bf16* orow = WT + (size_t)(r0 + 16 * g + i16) * K + k0 + 8 * hh;
#pragma unroll
      for (int nb2 = 0; nb2 < 2; ++nb2)
#pragma unroll
          for (int t = 0; t < 4; ++t) { typedef short s16x4 __attribute__((ext_vector_type(4))); s16x4 lo, hi;
              asm volatile("ds_read_b64_tr_b16 %0, %1 offset:%2" : "=&v"(lo) : "v"(abase), "i"(16 * t * CVT_STRIDE + 64 * nb2) : "memory");
              asm volatile("ds_read_b64_tr_b16 %0, %1 offset:%2" : "=&v"(hi) : "v"(abase), "i"(16 * t * CVT_STRIDE + 4 * CVT_STRIDE + 64 * nb2) : "memory");
              asm volatile("s_waitcnt lgkmcnt(0)" : "+v"(lo), "+v"(hi) :: "memory");
              typedef short s16x8 __attribute__((ext_vector_type(8))); const s16x8 o = {lo[0], lo[1], lo[2], lo[3], hi[0], hi[1], hi[2], hi[3]};
              *(s16x8*)(orow + (size_t)(32 * nb2) * K + 16 * t) = o; } }
    LDS_WAIT();
}
__device__ __forceinline__ void phase_convert(const float* W, int K, int N, bf16* WT, LAS unsigned char* lds, int gw, int NGW, int wave, int lane, const float* gk, bool glu = false, int ld = 0) {
    LAS unsigned char* tile = lds + wave * CVT_TILE;
    const int nblk = N / 64, items = (K / 64) * nblk; if (ld == 0) ld = N;
    int it = gw; if (it >= items) return;
    CvtRegs A, B; cvt_load(A, W, ld, it, lane, nblk);
    for (;;) {
        const int it1 = it + NGW; const bool h1 = it1 < items; if (h1) cvt_load(B, W, ld, it1, lane, nblk);
        cvt_store(A, K, N, WT, tile, it, lane, nblk, glu, gk);
        if (!h1) break;
        const int it2 = it1 + NGW; const bool h2 = it2 < items; if (h2) cvt_load(A, W, ld, it2, lane, nblk);
        cvt_store(B, K, N, WT, tile, it1, lane, nblk, glu, gk);
        if (!h2) break;
        it = it2;
    }
}
__device__ __forceinline__ int glu_row(int n, int N) { const int half = N / 2; return (n < half) ? 256 * (n >> 7) + (n & 127) : 256 * ((n - half) >> 7) + 128 + ((n - half) & 127); }
__device__ __forceinline__ void cvt8_load(CvtRegs& R, const float* W, int N, int item, int lane, int nblk, int nb_lo) {
    int kb, nb; cvt_item_kn(item, nblk, kb, nb); nb += nb_lo; const float* p = W + (size_t)(64 * kb + 2 * (lane >> 4)) * N + 64 * nb + 4 * (lane & 15);
#pragma unroll
    for (int i = 0; i < 16; ++i) R.v[i] = *(const f32x4*)(p + (size_t)(8 * (i >> 1) + (i & 1)) * N);
}
__device__ __forceinline__ void cvt8_colmax(const CvtRegs& R, int N, unsigned* colmax, int item, int lane, int nblk, int nb_lo, const float* gk) {
    int kb, nb; cvt_item_kn(item, nblk, kb, nb); nb += nb_lo; const int k0 = 64 * kb, n0 = 64 * nb, b = lane >> 4;
    f32x4 m = {0.f, 0.f, 0.f, 0.f};
#pragma unroll
    for (int i = 0; i < 16; ++i) { const float gg = gk[k0 + 8 * (i >> 1) + 2 * b + (i & 1)]; const f32x4 x = R.v[i] * gg;
        m.x = fmaxf(m.x, fabsf(x.x)); m.y = fmaxf(m.y, fabsf(x.y)); m.z = fmaxf(m.z, fabsf(x.z)); m.w = fmaxf(m.w, fabsf(x.w)); }
#pragma unroll
    for (int e = 0; e < 4; ++e) { float v = m[e]; v = fmaxf(v, lane_xor<16>(v)); float va = v, vb = v; half_swap(va, vb); m[e] = fmaxf(va, vb); }
    if (lane < 16) { unsigned* p = colmax + glu_row(n0, N) + 4 * lane;
#pragma unroll
        for (int e = 0; e < 4; ++e) __hip_atomic_fetch_max(p + e, __builtin_bit_cast(unsigned, m[e]), __ATOMIC_RELAXED, __HIP_MEMORY_SCOPE_AGENT); }
}
__device__ __forceinline__ void cvt8_store(const CvtRegs& R, int K, int N, signed char* WQ, float* sB, const unsigned* colmax, LAS unsigned char* tile, int item, int lane, int nblk, int nb_lo, const float* gk) {
    int kb, nb; cvt_item_kn(item, nblk, kb, nb); nb += nb_lo; const int k0 = 64 * kb, n0 = 64 * nb, r0 = glu_row(n0, N), b = lane >> 4, a = lane & 15;
    const f32x4 cm = __builtin_bit_cast(f32x4, *(const v4u*)(colmax + r0 + 4 * a));
    f32x4 inv;
#pragma unroll
    for (int e = 0; e < 4; ++e) inv[e] = cm[e] > 0.f ? 127.f / cm[e] : 0.f;
    if (kb == 0 && lane < 16) *(f32x4*)(sB + r0 + 4 * a) = cm * (1.f / 127.f);
    { LAS unsigned char* wp = tile + b * CVT_STRIDE + 8 * a;
#pragma unroll
      for (int i = 0; i < 8; ++i) { const float g0 = gk[k0 + 8 * i + 2 * b], g1 = gk[k0 + 8 * i + 2 * b + 1]; const f32x4 x0 = R.v[2 * i] * g0 * inv, x1 = R.v[2 * i + 1] * g1 * inv;
          unsigned h[4];
#pragma unroll
          for (int e = 0; e < 4; ++e) { const int q0 = (int)__builtin_rintf(fminf(fmaxf(x0[e], -127.f), 127.f)), q1 = (int)__builtin_rintf(fminf(fmaxf(x1[e], -127.f), 127.f)); h[e] = ((unsigned)q0 & 0xffu) | (((unsigned)q1 & 0xffu) << 8); }
          typedef unsigned u32x2 __attribute__((ext_vector_type(2))); u32x2 w; w.x = h[0] | (h[1] << 16); w.y = h[2] | (h[3] << 16); *(LAS u32x2*)(wp + 4 * i * CVT_STRIDE) = w; } }
    LDS_WAIT();
    { const int hh = lane >> 5, g = (lane >> 4) & 1, i16 = lane & 15, q = i16 >> 2, p = i16 & 3;
      const int abase = (int)(uintptr_t)tile + (8 * hh + q) * CVT_STRIDE + (16 * g + 4 * p) * 2;
      signed char* orow = WQ + (size_t)(r0 + 16 * g + i16) * K + k0 + 16 * hh;
#pragma unroll
      for (int nb2 = 0; nb2 < 2; ++nb2)
#pragma unroll
          for (int t = 0; t < 2; ++t) { typedef short s16x4 __attribute__((ext_vector_type(4))); s16x4 lo, hi;
              asm volatile("ds_read_b64_tr_b16 %0, %1 offset:%2" : "=&v"(lo) : "v"(abase), "i"(16 * t * CVT_STRIDE + 64 * nb2) : "memory");
              asm volatile("ds_read_b64_tr_b16 %0, %1 offset:%2" : "=&v"(hi) : "v"(abase), "i"(16 * t * CVT_STRIDE + 4 * CVT_STRIDE + 64 * nb2) : "memory");
              asm volatile("s_waitcnt lgkmcnt(0)" : "+v"(lo), "+v"(hi) :: "memory");
              typedef short s16x8 __attribute__((ext_vector_type(8))); const s16x8 o = {lo[0], lo[1], lo[2], lo[3], hi[0], hi[1], hi[2], hi[3]};
              *(s16x8*)(orow + (size_t)(32 * nb2) * K + 32 * t) = o; } }
    LDS_WAIT();
}
template <int PASS> __device__ __forceinline__ void phase_convert8(const float* W, int K, int N, signed char* WQ, float* sB, unsigned* colmax, LAS unsigned char* lds, int gw, int NGW, int wave, int lane, const float* gk, int nb_lo, int nb_cnt) {
    LAS unsigned char* tile = lds + wave * CVT_TILE;
    const int nblk = nb_cnt, items = (K / 64) * nblk;
    for (int it = gw; it < items; it += NGW) { CvtRegs A; cvt8_load(A, W, N, it, lane, nblk, nb_lo);
        if (PASS == 0) cvt8_colmax(A, N, colmax, it, lane, nblk, nb_lo, gk); else cvt8_store(A, K, N, WQ, sB, colmax, tile, it, lane, nblk, nb_lo, gk); }
}
constexpr int ST_STRIDE = 528, ST_TILE = 32 * ST_STRIDE, ST_RED = NWAVES * ST_TILE;
static_assert(ST_RED + 2048 <= MISC_OFF, "strip tiles below the control words");
__device__ __forceinline__ unsigned pkbf(float lo, float hi) { unsigned r; asm("v_cvt_pk_bf16_f32 %0, %1, %2" : "=v"(r) : "v"(lo), "v"(hi)); return r; }
__device__ __forceinline__ void strip8(const float* W, int N, int n0, int r0, const float* gk, signed char* WQ, float* sB, LAS unsigned char* lds, int par, int wave, int lane) {
    const int a = lane & 7, b = lane >> 3, kw = 512 * wave;
    const float* p = W + (size_t)(kw + 4 * b) * N + n0 + 4 * a;
    const float* gp = gk + kw + 4 * b;
    unsigned P[16][4][2];
    f32x4 mx = {0.f, 0.f, 0.f, 0.f};
    f32x4 S[2][8], Gn[2][2];
#define ST_LOAD(buf, bi) do { _Pragma("unroll") for (int q = 0; q < 8; ++q) S[buf][q] = *(const f32x4*)(p + (size_t)(32 * (2 * (bi) + (q >> 2)) + (q & 3)) * N); \
        Gn[buf][0] = *(const f32x4*)(gp + 64 * (bi)); Gn[buf][1] = *(const f32x4*)(gp + 64 * (bi) + 32); } while (0)
    ST_LOAD(0, 0);
#pragma unroll
    for (int bi = 0; bi < 8; ++bi) {
        if (bi < 7) { if (bi & 1) ST_LOAD(0, bi + 1); else ST_LOAD(1, bi + 1); }
        __builtin_amdgcn_sched_barrier(0);
#pragma unroll
        for (int mm = 0; mm < 2; ++mm) { const int m = 2 * bi + mm; f32x4 x[4];
#pragma unroll
            for (int c = 0; c < 4; ++c) { x[c] = S[bi & 1][4 * mm + c] * Gn[bi & 1][mm][c];
                mx.x = fmaxf(mx.x, fabsf(x[c].x)); mx.y = fmaxf(mx.y, fabsf(x[c].y)); mx.z = fmaxf(mx.z, fabsf(x[c].z)); mx.w = fmaxf(mx.w, fabsf(x[c].w)); }
#pragma unroll
            for (int e = 0; e < 4; ++e) { P[m][e][0] = pkbf(x[0][e], x[1][e]); P[m][e][1] = pkbf(x[2][e], x[3][e]); } }
        __builtin_amdgcn_sched_barrier(0);
    }
#undef ST_LOAD
    LAS float* red = (LAS float*)(lds + ST_RED + par * 1024);
#pragma unroll
    for (int e = 0; e < 4; ++e) { float v = mx[e]; v = fmaxf(v, lane_xor<8>(v)); v = fmaxf(v, lane_xor<16>(v)); float va = v, vb = v; half_swap(va, vb); mx[e] = fmaxf(va, vb); }
    if (b == 0) *(LAS f32x4*)(red + wave * 32 + 4 * a) = mx;
    __syncthreads();
    f32x4 cm = *(LAS f32x4*)(red + 4 * a);
#pragma unroll
    for (int w2 = 1; w2 < NWAVES; ++w2) { const f32x4 o = *(LAS f32x4*)(red + w2 * 32 + 4 * a); cm.x = fmaxf(cm.x, o.x); cm.y = fmaxf(cm.y, o.y); cm.z = fmaxf(cm.z, o.z); cm.w = fmaxf(cm.w, o.w); }
    f32x4 inv;
#pragma unroll
    for (int e = 0; e < 4; ++e) { cm[e] = bflo(pkbf(cm[e], cm[e])); inv[e] = cm[e] > 0.f ? 127.f / cm[e] : 0.f; }
    if (wave == 0 && b == 0) *(f32x4*)(sB + r0 + 4 * a) = cm * (1.f / 127.f);
    LAS unsigned char* tile = lds + wave * ST_TILE;
    { LAS unsigned char* wp = tile + (4 * a) * ST_STRIDE + 4 * b;
#pragma unroll
      for (int m = 0; m < 16; ++m)
#pragma unroll
          for (int e = 0; e < 4; ++e) { const unsigned w0 = P[m][e][0], w1 = P[m][e][1];
              const unsigned t0 = __builtin_bit_cast(unsigned, __builtin_fmaf(bflo(w0), inv[e], 12582912.f)), t1 = __builtin_bit_cast(unsigned, __builtin_fmaf(bfhi(w0), inv[e], 12582912.f));
              const unsigned t2 = __builtin_bit_cast(unsigned, __builtin_fmaf(bflo(w1), inv[e], 12582912.f)), t3 = __builtin_bit_cast(unsigned, __builtin_fmaf(bfhi(w1), inv[e], 12582912.f));
              *(LAS unsigned*)(wp + e * ST_STRIDE + 32 * m) = __builtin_amdgcn_perm(t1, t0, 0x0c0c0400u) | __builtin_amdgcn_perm(t3, t2, 0x04000c0cu); } }
    LDS_WAIT();
    { signed char* orow = WQ + (size_t)(r0 + (lane >> 5)) * D_MODEL + kw + 16 * (lane & 31); LAS unsigned char* rp = tile + (lane >> 5) * ST_STRIDE + 16 * (lane & 31);
#pragma unroll
      for (int i = 0; i < 16; ++i) { const v4u v = *(LAS v4u*)(rp + 2 * i * ST_STRIDE); *(v4u*)(orow + (size_t)(2 * i) * D_MODEL) = v; } }
    LDS_WAIT();
}
__device__ __forceinline__ void phase_strips8(const float* Wup, const float* gup, signed char* WQup, float* sBup, const float* Win, const float* gin, signed char* WQin, float* sBin, LAS unsigned char* lds, int blk, int G, int wave, int lane) {
    constexpr int SPL = N_UP / 32, SPI = NQ8 / 32;
    int par = 0;
    for (int s = blk; s < DEPTH * (SPL + SPI); s += G, par ^= 1) {
        if (s < DEPTH * SPL) { const int cl = s >= SPL ? 1 : 0, n0 = 32 * (s - cl * SPL);
            strip8(Wup + (size_t)cl * D_MODEL * N_UP, N_UP, n0, glu_row(n0, N_UP), gup + (size_t)cl * D_MODEL, WQup + (size_t)cl * N_UP * D_MODEL, sBup + (size_t)cl * N_UP, lds, par, wave, lane); }
        else { const int s2 = s - DEPTH * SPL, cl = s2 >= SPI ? 1 : 0, n0 = 32 * (s2 - cl * SPI);
            strip8(Win + (size_t)cl * D_MODEL * N_IN, N_IN, n0, n0, gin + (size_t)cl * D_MODEL, WQin + (size_t)cl * NQ8 * D_MODEL, sBin + (size_t)cl * NQ8, lds, par, wave, lane); }
    }
}
__device__ __forceinline__ void phase_quant_rows(const bf16* xb, signed char* xq, float* sA, int gw, int NGW, int lane) {
    for (int row = gw; row < M_TOK; row += NGW) {
        const v4u* xr = (const v4u*)(xb + (size_t)row * D_MODEL) + lane; v4u x[8]; float mx = 0.f;
#pragma unroll
        for (int j = 0; j < 8; ++j) { x[j] = xr[64 * j]; const unsigned* w = (const unsigned*)&x[j];
#pragma unroll
            for (int e = 0; e < 4; ++e) mx = fmaxf(mx, fmaxf(fabsf(bflo(w[e])), fabsf(bfhi(w[e])))); }
        mx = fmaxf(mx, lane_xor<1>(mx)); mx = fmaxf(mx, lane_xor<2>(mx)); mx = fmaxf(mx, lane_xor<4>(mx)); mx = fmaxf(mx, lane_xor<8>(mx)); mx = fmaxf(mx, lane_xor<16>(mx));
        { float ma = mx, mb = mx; half_swap(ma, mb); mx = fmaxf(ma, mb); }
        const float inv = mx > 0.f ? 127.f / mx : 0.f;
        if (lane == 0) sA[row] = mx * (1.f / 127.f);
        unsigned long long* o8 = (unsigned long long*)(xq + (size_t)row * D_MODEL) + lane;
#pragma unroll
        for (int j = 0; j < 8; ++j) { const unsigned* w = (const unsigned*)&x[j]; unsigned long long pk = 0ull;
#pragma unroll
            for (int e = 0; e < 4; ++e) { const int q0 = (int)__builtin_rintf(bflo(w[e]) * inv), q1 = (int)__builtin_rintf(bfhi(w[e]) * inv);
                pk |= (unsigned long long)(((unsigned)q0 & 0xffu) | (((unsigned)q1 & 0xffu) << 8)) << (16 * e); }
            o8[64 * j] = pk; }
    }
}
__device__ __forceinline__ void phase_xprep(const float* x, bf16* xb, unsigned long long* rowss, signed char* xq, float* sA, int gw, int NGW, int lane) {
    for (int row = gw; row < M_TOK; row += NGW) {
        const f32x4* xr = (const f32x4*)(x + (size_t)row * D_MODEL) + lane; float s = 0.f, mx = 0.f; unsigned w[16][2];
#pragma unroll
        for (int j = 0; j < 16; ++j) { const f32x4 v = xr[64 * j]; s += (v.x * v.x + v.y * v.y) + (v.z * v.z + v.w * v.w);
            w[j][0] = pk2(v.x, v.y); w[j][1] = pk2(v.z, v.w);
            mx = fmaxf(fmaxf(mx, fmaxf(fabsf(bflo(w[j][0])), fabsf(bfhi(w[j][0])))), fmaxf(fabsf(bflo(w[j][1])), fabsf(bfhi(w[j][1]))));
            unsigned long long* o8 = (unsigned long long*)(xb + (size_t)row * D_MODEL) + lane + 64 * j; *o8 = (unsigned long long)w[j][0] | ((unsigned long long)w[j][1] << 32); }
        s = wave_sum(s);
        if (lane == 0) rowss[row] = (unsigned long long)(long long)__builtin_rintf(s * 16777216.f);
        mx = fmaxf(mx, lane_xor<1>(mx)); mx = fmaxf(mx, lane_xor<2>(mx)); mx = fmaxf(mx, lane_xor<4>(mx)); mx = fmaxf(mx, lane_xor<8>(mx)); mx = fmaxf(mx, lane_xor<16>(mx));
        { float ma = mx, mb = mx; half_swap(ma, mb); mx = fmaxf(ma, mb); }
        const float inv = mx > 0.f ? 127.f / mx : 0.f;
        if (lane == 0) sA[row] = mx * (1.f / 127.f);
        unsigned* o4 = (unsigned*)(xq + (size_t)row * D_MODEL) + lane;
#pragma unroll
        for (int j = 0; j < 16; ++j) { const int q0 = (int)__builtin_rintf(bflo(w[j][0]) * inv), q1 = (int)__builtin_rintf(bfhi(w[j][0]) * inv), q2 = (int)__builtin_rintf(bflo(w[j][1]) * inv), q3 = (int)__builtin_rintf(bfhi(w[j][1]) * inv);
            o4[64 * j] = ((unsigned)q0 & 0xffu) | (((unsigned)q1 & 0xffu) << 8) | (((unsigned)q2 & 0xffu) << 16) | ((unsigned)q3 << 24); }
    }
}
__device__ __forceinline__ void phase_final(const bf16* xb, float* out, const unsigned long long* rowss, const float* g, int gw, int NGW, int lane) {
    for (int row = gw; row < M_TOK; row += NGW) {
        const float rstd = rsqrtf((float)rowss[row] * (1.f / (16777216.f * D_MODEL)) + NORM_EPS);
        const v4u* xr = (const v4u*)(xb + (size_t)row * D_MODEL) + lane; f32x4* orow = (f32x4*)(out + (size_t)row * D_MODEL); const f32x4* gr = (const f32x4*)g;
        v4u x[8];
#pragma unroll
        for (int j = 0; j < 8; ++j) x[j] = xr[64 * j];
#pragma unroll
        for (int j = 0; j < 8; ++j) { const int c4 = 2 * (lane + 64 * j);
            const f32x4 ga = gr[c4], gb = gr[c4 + 1];
            orow[c4] = (f32x4){bflo(x[j].x) * rstd * ga.x, bfhi(x[j].x) * rstd * ga.y, bflo(x[j].y) * rstd * ga.z, bfhi(x[j].y) * rstd * ga.w};
            orow[c4 + 1] = (f32x4){bflo(x[j].z) * rstd * gb.x, bfhi(x[j].z) * rstd * gb.y, bflo(x[j].w) * rstd * gb.z, bfhi(x[j].w) * rstd * gb.w}; }
    }
}
constexpr int SGU_STRIDE = 320, SGU_SLOT = CHUNK * SGU_STRIDE;
typedef short sg_bf16x8 __attribute__((ext_vector_type(8)));
typedef short sg_s16x4 __attribute__((ext_vector_type(4)));
typedef float sg_f32x16 __attribute__((ext_vector_type(16)));
__device__ __forceinline__ void phase_sgu(const bf16* Z, const float* sgug, const float* Ws, const float* bs, const float* mixg, bf16* Mx, LAS unsigned char* lds, int blk, int G, int tid, int wv) {
    const int lane = tid & 63, h = lane >> 5, l31 = lane & 31;
    const int uh = wv >> 2, tt = wv & 3;
    const int srow = tid >> 2, sq = tid & 3;
    for (int wq = blk; wq < 256; wq += G) {
        const int g = wq & 15, cq = wq >> 4;
        sg_bf16x8 wf[8];
        { const int t = 32 * tt + l31; const float* wrow = Ws + ((size_t)g * CHUNK + t) * CHUNK;
#pragma unroll
          for (int ks = 0; ks < 8; ++ks) { wf[ks] = sg_bf16x8{0, 0, 0, 0, 0, 0, 0, 0};
              if (ks <= 2 * tt + 1) { const int s0 = 16 * ks + 8 * h; const f32x4 a = *(const f32x4*)(wrow + s0), b = *(const f32x4*)(wrow + s0 + 4);
                  float v[8] = {a.x, a.y, a.z, a.w, b.x, b.y, b.z, b.w};
#pragma unroll
                  for (int e = 0; e < 8; ++e) v[e] = (s0 + e <= t) ? v[e] : 0.f;
                  v4u pk; pk.x = pk2(v[0], v[1]); pk.y = pk2(v[2], v[3]); pk.z = pk2(v[4], v[5]); pk.w = pk2(v[6], v[7]); wf[ks] = __builtin_bit_cast(sg_bf16x8, pk); } } }
        const float bias_t = bs[g * CHUNK + 32 * tt + l31];
        f32x4 sgv[8];
#pragma unroll
        for (int e = 0; e < 8; ++e) sgv[e] = *(const f32x4*)(sgug + g * 128 + sq * 32 + 4 * e);
        for (int rnd = 0; rnd < 2; ++rnd) {
            uint2 uu[4][4];
            { const bf16* up0 = Z + (size_t)((4 * cq + 2 * rnd + uh) * CHUNK + 32 * tt + l31) * N_IN + ZU + g * 128 + 4 * h;
#pragma unroll
              for (int ct = 0; ct < 4; ++ct)
#pragma unroll
                  for (int rq = 0; rq < 4; ++rq) uu[ct][rq] = *(const uint2*)(up0 + 32 * ct + 8 * rq); }
#pragma unroll
            for (int ub = 0; ub < 2; ++ub) { const int row0 = (4 * cq + 2 * rnd + ub) * CHUNK;
                const v4u* vp = (const v4u*)(Z + (size_t)(row0 + srow) * N_IN + ZV2 + g * 128 + sq * 32);
                v4u raw[4]; float x[32]; float ss = 0.f;
#pragma unroll
                for (int e = 0; e < 4; ++e) raw[e] = vp[e];
#pragma unroll
                for (int e = 0; e < 4; ++e) { x[8 * e + 0] = bflo(raw[e].x); x[8 * e + 1] = bfhi(raw[e].x); x[8 * e + 2] = bflo(raw[e].y); x[8 * e + 3] = bfhi(raw[e].y);
                    x[8 * e + 4] = bflo(raw[e].z); x[8 * e + 5] = bfhi(raw[e].z); x[8 * e + 6] = bflo(raw[e].w); x[8 * e + 7] = bfhi(raw[e].w); }
#pragma unroll
                for (int e = 0; e < 32; ++e) ss += x[e] * x[e];
                ss += lane_xor<1>(ss); ss += lane_xor<2>(ss);
                const float rstd = rsqrtf(ss * (1.f / 128.f) + NORM_EPS);
                LAS v4u* dst = (LAS v4u*)(lds + ub * SGU_SLOT + srow * SGU_STRIDE + sq * 64);
#pragma unroll
                for (int e = 0; e < 4; ++e) { v4u o; const f32x4 s0 = sgv[2 * e], s1 = sgv[2 * e + 1];
                    o.x = pk2(x[8 * e + 0] * rstd * s0.x, x[8 * e + 1] * rstd * s0.y); o.y = pk2(x[8 * e + 2] * rstd * s0.z, x[8 * e + 3] * rstd * s0.w);
                    o.z = pk2(x[8 * e + 4] * rstd * s1.x, x[8 * e + 5] * rstd * s1.y); o.w = pk2(x[8 * e + 6] * rstd * s1.z, x[8 * e + 7] * rstd * s1.w); dst[e] = o; } }
            __syncthreads();
            sg_f32x16 acc[4];
#pragma unroll
            for (int ct = 0; ct < 4; ++ct) acc[ct] = sg_f32x16{};
            { const int g4 = lane >> 4, i16 = lane & 15, q = i16 >> 2, p = i16 & 3;
              const int abase = (int)(uintptr_t)(lds + uh * SGU_SLOT) + (8 * h + q) * SGU_STRIDE + (16 * (g4 & 1) + 4 * p) * 2;
#pragma unroll
              for (int ks = 0; ks < 8; ++ks) {
                  if (ks <= 2 * tt + 1) {
#pragma unroll
                      for (int ct = 0; ct < 4; ++ct) { sg_s16x4 lo, hi;
                          asm volatile("ds_read_b64_tr_b16 %0, %1 offset:%2" : "=&v"(lo) : "v"(abase), "i"(16 * ks * SGU_STRIDE + ct * 64) : "memory");
                          asm volatile("ds_read_b64_tr_b16 %0, %1 offset:%2" : "=&v"(hi) : "v"(abase), "i"(16 * ks * SGU_STRIDE + 4 * SGU_STRIDE + ct * 64) : "memory");
                          asm volatile("s_waitcnt lgkmcnt(0)" ::: "memory"); __builtin_amdgcn_sched_barrier(0);
                          acc[ct] = __builtin_amdgcn_mfma_f32_32x32x16_bf16((sg_bf16x8){lo[0], lo[1], lo[2], lo[3], hi[0], hi[1], hi[2], hi[3]}, wf[ks], acc[ct], 0, 0, 0); } } } }
            { const int row = (4 * cq + 2 * rnd + uh) * CHUNK + 32 * tt + l31;
              const float* mg = mixg + D_ATTN + g * 128 + 4 * h;
              float ss = 0.f;
#pragma unroll
              for (int ct = 0; ct < 4; ++ct)
#pragma unroll
                  for (int rq = 0; rq < 4; ++rq) { const uint2 uv = uu[ct][rq];
                      const float u0 = bflo(uv.x), u1 = bfhi(uv.x), u2 = bflo(uv.y), u3 = bfhi(uv.y);
                      float o0 = u0 * (acc[ct][4 * rq + 0] + bias_t), o1 = u1 * (acc[ct][4 * rq + 1] + bias_t), o2 = u2 * (acc[ct][4 * rq + 2] + bias_t), o3 = u3 * (acc[ct][4 * rq + 3] + bias_t);
                      acc[ct][4 * rq + 0] = o0; acc[ct][4 * rq + 1] = o1; acc[ct][4 * rq + 2] = o2; acc[ct][4 * rq + 3] = o3; ss += (o0 * o0 + o1 * o1) + (o2 * o2 + o3 * o3); }
              { float sa = ss, sb = ss; half_swap(sa, sb); ss = sa + sb; }
              const float rstd = rsqrtf(ss * (1.f / 128.f) + NORM_EPS);
              bf16* op = Mx + (size_t)row * D_MODEL + D_ATTN + g * 128 + 4 * h;
#pragma unroll
              for (int ct = 0; ct < 4; ++ct)
#pragma unroll
                  for (int rq = 0; rq < 4; ++rq) { const f32x4 mm = *(const f32x4*)(mg + 32 * ct + 8 * rq);
                      uint2 w; w.x = pk2(acc[ct][4 * rq + 0] * rstd * mm.x, acc[ct][4 * rq + 1] * rstd * mm.y); w.y = pk2(acc[ct][4 * rq + 2] * rstd * mm.z, acc[ct][4 * rq + 3] * rstd * mm.w);
                      *(uint2*)(op + 32 * ct + 8 * rq) = w; } }
            __syncthreads();
        }
    }
}
__device__ __forceinline__ void phase_convfix(const float* U4, const float* cw, const float* cb, bf16* ACT, size_t gtid, size_t nthreads) {
    constexpr int per_row = D_FF / 8, NB = M_TOK / 64; const size_t total = (size_t)NB * per_row;
    for (size_t i = gtid; i < total; i += nthreads) {
        const int blk64 = (int)(i / per_row), c = (int)(i % per_row) * 8;
        if ((blk64 & (SEQ / 64 - 1)) == 0) continue;
        const float* um2 = U4 + ((size_t)(blk64 - 1) * 4 + 2) * N_UP; const float* um1 = um2 + N_UP; const float* u0 = U4 + (size_t)blk64 * 4 * N_UP; const float* u1 = u0 + N_UP;
        float y0[2][8], y1[2][8];
#pragma unroll
        for (int hv = 0; hv < 2; ++hv)
#pragma unroll
            for (int q = 0; q < 2; ++q) { const int cc = hv * D_FF + c + 4 * q;
                const f32x4 a = *(const f32x4*)(um2 + cc), b = *(const f32x4*)(um1 + cc), x0 = *(const f32x4*)(u0 + cc), x1 = *(const f32x4*)(u1 + cc);
                const f32x4 w0 = *(const f32x4*)(cw + cc), w1 = *(const f32x4*)(cw + N_UP + cc), w2 = *(const f32x4*)(cw + 2 * N_UP + cc), bb = *(const f32x4*)(cb + cc);
#pragma unroll
                for (int e = 0; e < 4; ++e) { y0[hv][4 * q + e] = fmaf(w0[e], a[e], fmaf(w1[e], b[e], fmaf(w2[e], x0[e], bb[e]))); y1[hv][4 * q + e] = fmaf(w0[e], b[e], fmaf(w1[e], x0[e], fmaf(w2[e], x1[e], bb[e]))); } }
        float r0[8], r1[8];
#pragma unroll
        for (int e = 0; e < 8; ++e) { const float g0 = y0[0][e], g1 = y1[0][e]; r0[e] = g0 / (1.f + __expf(-g0)) * y0[1][e]; r1[e] = g1 / (1.f + __expf(-g1)) * y1[1][e]; }
        v4u o; o.x = pk2(r0[0], r0[1]); o.y = pk2(r0[2], r0[3]); o.z = pk2(r0[4], r0[5]); o.w = pk2(r0[6], r0[7]);
        *(v4u*)(ACT + (size_t)(blk64 * 64) * D_FF + c) = o;
        o.x = pk2(r1[0], r1[1]); o.y = pk2(r1[2], r1[3]); o.z = pk2(r1[4], r1[5]); o.w = pk2(r1[6], r1[7]);
        *(v4u*)(ACT + (size_t)(blk64 * 64 + 1) * D_FF + c) = o;
    }
}
typedef attn::BlockRef<bf16, bf16> ABlock;
__device__ __forceinline__ ABlock attn_ref(int L, const bf16* Z, bf16* OC, float* LSE) {
    const int c = L >> 9, x = L & 511; const int bh = (x & 7) + 8 * ((x >> 3) & 3), bi = x >> 5;
    const int d = (c == 0) ? 1 : ((c == 1) ? 4 : 16);
    const int r = (c == 0) ? 0 : ((c == 1) ? (bi >> 2) : bi), qb = (c == 0) ? bi : ((c == 1) ? (bi & 3) : 0);
    const int b = bh >> 4, h = bh & 15; const int P0 = qb * attn::QB;
    const size_t row0 = (size_t)b * SEQ + r, rowq = row0 + (size_t)P0 * d;
    ABlock R;
    R.Q = Z + rowq * N_IN + ZQ + h * HEAD_DIM; R.K = Z + row0 * N_IN + ZK + h * HEAD_DIM; R.V = Z + row0 * N_IN + ZV + h * HEAD_DIM;
    R.O = OC + (size_t)c * M_TOK * D_ATTN + rowq * D_ATTN + h * HEAD_DIM; R.L = LSE + (size_t)c * M_TOK * NH + rowq * NH + h;
    R.P0 = P0; R.pitch = d * N_IN; R.opitch = d * D_ATTN; R.lpitch = d * NH;
    { const int j2 = 6 - h + ((c == 0) ? 0 : ((c == 1) ? 4 : 8)); const int n = j2 >> 1;
      R.beta = __builtin_bit_cast(float, (unsigned)(((127 + n) << 23) | ((j2 & 1) ? 0x3504F3 : 0))); }
    return R;
}
__device__ __forceinline__ int attn_skv(int L) { return (L < 512) ? SEQ : ((L < 1024) ? SEQ / 4 : SEQ / 16); }
__device__ __forceinline__ void phase_attn(const bf16* Z, bf16* OC, float* LSE, char* lds, int blk, int G, const int wv) {
    constexpr int TOTAL = 3 * 512, W = 129;
    int L = blk; if (L >= TOTAL) return;
    ABlock cur = attn_ref(L, Z, OC, LSE);
    attn::Seam<bf16> S;
    attn::causal_swa_prime<bf16, bf16>(cur, W, lds, S, wv);
    for (;;) {
        const int Ln = L + G; const bool last = Ln >= TOTAL;
        const ABlock nxt = last ? cur : attn_ref(Ln, Z, OC, LSE);
        attn::causal_swa_block<bf16, bf16>(cur, nxt, attn_skv(L), W, lds, S, wv);
        if (last) break;
        cur = nxt; L = Ln;
    }
}
__device__ __forceinline__ void phase_combine(const bf16* OC, const float* LSE, const float* mixg, bf16* Mx, int gw, int NGW, int lane) {
    const int hq = gw & 3, h = hq * 4 + (lane >> 4), col = h * HEAD_DIM + 8 * (lane & 15);
    const f32x4 g0 = *(const f32x4*)(mixg + col), g1 = *(const f32x4*)(mixg + col + 4);
    constexpr size_t SO = (size_t)M_TOK * D_ATTN, SL = (size_t)M_TOK * NH;
    for (int row = gw >> 2; row < M_TOK; row += 2 * (NGW >> 2)) {
        const int row2 = row + (NGW >> 2); const bool two = row2 < M_TOK; const int rb = two ? row2 : row;
        v4u a[2][3]; float ls[2][3];
#pragma unroll
        for (int u = 0; u < 2; ++u) { const int r = u ? rb : row;
#pragma unroll
            for (int c = 0; c < 3; ++c) { a[u][c] = *(const v4u*)(OC + c * SO + (size_t)r * D_ATTN + col); ls[u][c] = LSE[c * SL + (size_t)r * NH + h]; } }
#pragma unroll
        for (int u = 0; u < 2; ++u) { const int r = u ? rb : row;
            const float mx = fmaxf(ls[u][0], fmaxf(ls[u][1], ls[u][2])); float w0 = __expf(ls[u][0] - mx), w1 = __expf(ls[u][1] - mx), w2 = __expf(ls[u][2] - mx); const float inv = 1.f / (w0 + w1 + w2);
            w0 *= inv; w1 *= inv; w2 *= inv;
            float o[8]; const unsigned* pa = (const unsigned*)&a[u][0]; const unsigned* pb = (const unsigned*)&a[u][1]; const unsigned* pc = (const unsigned*)&a[u][2]; float ss = 0.f;
#pragma unroll
            for (int e = 0; e < 4; ++e) { o[2 * e] = w0 * bflo(pa[e]) + w1 * bflo(pb[e]) + w2 * bflo(pc[e]); o[2 * e + 1] = w0 * bfhi(pa[e]) + w1 * bfhi(pb[e]) + w2 * bfhi(pc[e]); ss += o[2 * e] * o[2 * e] + o[2 * e + 1] * o[2 * e + 1]; }
            ss += lane_xor<1>(ss); ss += lane_xor<2>(ss); ss += lane_xor<4>(ss); ss += lane_xor<8>(ss);
            const float rstd = rsqrtf(ss * (1.f / HEAD_DIM) + NORM_EPS);
            v4u w; w.x = pk2(o[0] * rstd * g0.x, o[1] * rstd * g0.y); w.y = pk2(o[2] * rstd * g0.z, o[3] * rstd * g0.w); w.z = pk2(o[4] * rstd * g1.x, o[5] * rstd * g1.y); w.w = pk2(o[6] * rstd * g1.z, o[7] * rstd * g1.w);
            if (u == 0 || two) *(v4u*)(Mx + (size_t)r * D_MODEL + col) = w; }
    }
}

struct Args { const float* in[14]; float* out; unsigned char* ws; };
typedef const __attribute__((address_space(4))) Args* KArgs;
__global__ void __launch_bounds__(NTHREADS, 2) mega_fwd(Args args) {
    extern __shared__ __attribute__((aligned(16))) unsigned char lds_raw[];
    LAS unsigned char* lds = (LAS unsigned char*)lds_raw;
    volatile LAS unsigned* MISC = (volatile LAS unsigned*)(lds + MISC_OFF);
    const int wv = __builtin_amdgcn_readfirstlane((int)(threadIdx.x >> 6));
    { const int t0 = tid_of(wv); if (t0 < 32) MISC[t0] = 0u; }
    __syncthreads();
#define PHASE_BEGIN() KArgs ka = (KArgs)__builtin_amdgcn_kernarg_segment_ptr(); asm volatile("" : "+s"(ka)); unsigned char* const ws = ka->ws; int wvp = wv; asm volatile("" : "+s"(wvp)); \
    const int tid = tid_of(wvp); const int lane = tid & 63, wave = wvp; int blk_o = blockIdx.x; asm volatile("" : "+s"(blk_o)); int lyr = l; asm volatile("" : "+s"(lyr)); \
    const int G = gridDim.x, blk = blk_o, gw = blk * NWAVES + wave, NGW = G * NWAVES; (void)lane; (void)gw; (void)NGW; (void)blk; (void)G; (void)tid; (void)ws; (void)lyr
#define WSP(T, off) ((T*)(ws + (off)))
#define GRID_BARRIER() do { KArgs kb = (KArgs)__builtin_amdgcn_kernarg_segment_ptr(); asm volatile("" : "+s"(kb)); XcdBarrier bar; bar.bar = (unsigned*)(kb->ws + OFF_CTL); bar.x = xcc; bar.st = MISC + 8; xcd_barrier(bar, wv); } while (0)
    const unsigned xcc = xcd_barrier_post((unsigned*)(args.ws + OFF_CTL), MISC + 8, wv).x;

    { const int l = 0; PHASE_BEGIN();
      phase_xprep(ka->in[0], WSP(bf16, OFF_H), WSP(unsigned long long, OFF_RS), WSP(signed char, OFF_XQ), WSP(float, OFF_SA), gw, NGW, lane);
      phase_strips8(ka->in[9], ka->in[8], WSP(signed char, OFF_WUP), WSP(float, OFF_SB), ka->in[2], ka->in[1], WSP(signed char, OFF_WINQ), WSP(float, OFF_SBIN), lds, blk, G, wave, lane); }
    __syncthreads();
    { const int l = 0; PHASE_BEGIN();
      for (int cl = 0; cl < DEPTH; ++cl) {
        phase_convert(ka->in[2] + (size_t)cl * D_MODEL * N_IN + NQ8, D_MODEL, N_IN - NQ8, WSP(bf16, OFF_WIN) + (size_t)cl * N_IN * D_MODEL + (size_t)NQ8 * D_MODEL, lds, gw, NGW, wave, lane, ka->in[1] + (size_t)cl * D_MODEL, false, N_IN);
        phase_convert(ka->in[7] + (size_t)cl * D_MODEL * D_MODEL, D_MODEL, D_MODEL, WSP(bf16, OFF_WOUT) + (size_t)cl * D_MODEL * D_MODEL, lds, gw, NGW, wave, lane, nullptr);
        phase_convert(ka->in[12] + (size_t)cl * D_FF * D_MODEL, D_FF, D_MODEL, WSP(bf16, OFF_WDN) + (size_t)cl * D_MODEL * D_FF, lds, gw, NGW, wave, lane, nullptr);
      } }
    GRID_BARRIER();

    for (int l = 0; l < DEPTH; ++l) {
        { PHASE_BEGIN();
          pg8::Gemm g{(const bf16*)WSP(signed char, OFF_XQ), (const bf16*)(WSP(signed char, OFF_WINQ) + (size_t)lyr * NQ8 * D_MODEL), M_TOK, NQ8, D_MODEL / 2}; pg8::StaticOrder S; S.init(M_TOK, NQ8, G, blk);
          pg8::EpiIn8 E{pg8::EpiIn{WSP(bf16, OFF_Z), (long)N_IN, 1000, WSP(unsigned long long, OFF_RS) + (size_t)(2 * lyr) * M_TOK, 1.f / (16777216.f * D_MODEL), NORM_EPS}, WSP(float, OFF_SA), WSP(float, OFF_SBIN) + (size_t)lyr * NQ8};
          pg8::gemm_phase<pg8::EpiIn8, pg8::StaticOrder, true, true>(lds, g, S, E, wvp); }
        __syncthreads();
        { PHASE_BEGIN();
          pg8::Gemm g{WSP(bf16, OFF_H), WSP(bf16, OFF_WIN) + (size_t)lyr * N_IN * D_MODEL + (size_t)NQ8 * D_MODEL, M_TOK, N_IN - NQ8, D_MODEL}; pg8::StaticOrder S; S.init(M_TOK, N_IN - NQ8, G, blk);
          pg8::EpiIn E{WSP(bf16, OFF_Z) + NQ8, (long)N_IN, 24 - NQ8 / 256, WSP(unsigned long long, OFF_RS) + (size_t)(2 * lyr) * M_TOK, 1.f / (16777216.f * D_MODEL), NORM_EPS};
          pg8::gemm_phase<pg8::EpiIn, pg8::StaticOrder, true, true>(lds, g, S, E, wvp); }
        GRID_BARRIER();
        { PHASE_BEGIN();
          phase_attn(WSP(bf16, OFF_Z), WSP(bf16, OFF_OC), WSP(float, OFF_LSE), (char*)lds_raw, blk, G, wvp); }
        __syncthreads();
        { PHASE_BEGIN();
          phase_sgu(WSP(bf16, OFF_Z), ka->in[3] + (size_t)lyr * D_SGU, ka->in[4] + (size_t)lyr * NG * CHUNK * CHUNK, ka->in[5] + (size_t)lyr * NG * CHUNK, ka->in[6] + (size_t)lyr * D_MODEL, WSP(bf16, OFF_MX), lds, blk, G, tid, wvp); }
        GRID_BARRIER();
        { PHASE_BEGIN(); phase_combine(WSP(bf16, OFF_OC), WSP(float, OFF_LSE), ka->in[6] + (size_t)lyr * D_MODEL, WSP(bf16, OFF_MX), gw, NGW, lane); }
        GRID_BARRIER();
        { PHASE_BEGIN();
          pg8::Gemm g{WSP(bf16, OFF_MX), WSP(bf16, OFF_WOUT) + (size_t)lyr * D_MODEL * D_MODEL, M_TOK, D_MODEL, D_MODEL}; pg8::StaticOrder S; S.init(M_TOK, D_MODEL, G, blk);
          pg8::EpiRes E{WSP(bf16, OFF_H), WSP(unsigned long long, OFF_RS) + (size_t)(2 * lyr + 1) * M_TOK, (long)D_MODEL};
          pg8::gemm_phase<pg8::EpiRes, pg8::StaticOrder, true, true>(lds, g, S, E, wvp); }
        GRID_BARRIER();
        { PHASE_BEGIN(); phase_quant_rows(WSP(bf16, OFF_H), WSP(signed char, OFF_XQ), WSP(float, OFF_SA), gw, NGW, lane); }
        GRID_BARRIER();
        { PHASE_BEGIN();
          pg8::Gemm g{(const bf16*)WSP(signed char, OFF_XQ), (const bf16*)(WSP(signed char, OFF_WUP) + (size_t)lyr * N_UP * D_MODEL), M_TOK, N_UP, D_MODEL / 2}; pg8::StaticOrder S; S.init(M_TOK, N_UP, G, blk);
          pg8::EpiConv8 E{pg8::EpiConv{WSP(bf16, OFF_ACT), WSP(float, OFF_U4), ka->in[10] + (size_t)lyr * 3 * N_UP, ka->in[11] + (size_t)lyr * N_UP, (long)D_FF, WSP(unsigned long long, OFF_RS) + (size_t)(2 * lyr + 1) * M_TOK, 1.f / (16777216.f * D_MODEL), NORM_EPS},
                            WSP(float, OFF_SA), WSP(float, OFF_SB) + (size_t)lyr * N_UP};
          pg8::gemm_phase<pg8::EpiConv8, pg8::StaticOrder, true, true>(lds, g, S, E, wvp); }
        GRID_BARRIER();
        { PHASE_BEGIN(); phase_convfix(WSP(float, OFF_U4), ka->in[10] + (size_t)lyr * 3 * N_UP, ka->in[11] + (size_t)lyr * N_UP, WSP(bf16, OFF_ACT), (size_t)blk * NTHREADS + tid, (size_t)G * NTHREADS); }
        GRID_BARRIER();
        { PHASE_BEGIN();
          pg8::Gemm g{WSP(bf16, OFF_ACT), WSP(bf16, OFF_WDN) + (size_t)lyr * D_MODEL * D_FF, M_TOK, D_MODEL, D_FF}; pg8::StaticOrder S; S.init(M_TOK, D_MODEL, G, blk);
          pg8::EpiRes E{WSP(bf16, OFF_H), WSP(unsigned long long, OFF_RS) + (size_t)(2 * lyr + 2) * M_TOK, (long)D_MODEL};
          pg8::gemm_phase<pg8::EpiRes, pg8::StaticOrder, true, true>(lds, g, S, E, wvp); }
        GRID_BARRIER();
        if (l + 1 < DEPTH) {
            { PHASE_BEGIN(); phase_quant_rows(WSP(bf16, OFF_H), WSP(signed char, OFF_XQ), WSP(float, OFF_SA), gw, NGW, lane); }
            GRID_BARRIER();
        }
    }
    { const int l = 0; PHASE_BEGIN(); phase_final(WSP(bf16, OFF_H), ka->out, WSP(unsigned long long, OFF_RS) + (size_t)(2 * DEPTH) * M_TOK, ka->in[13], gw, NGW, lane); }
#undef PHASE_BEGIN
#undef WSP
#undef GRID_BARRIER
}

extern "C" void kernel_launch(void* const* d_in, const int* in_sizes, int n_in, void* d_out, int out_size, void* d_ws, size_t ws_size, hipStream_t stream) {
    static int grid = 0;
    if (grid == 0) {
        if (n_in != 14 || out_size != M_TOK * D_MODEL || ws_size < WS_END) { fprintf(stderr, "kernel_launch: unexpected shapes (n_in %d out %d ws %zu need %zu)\n", n_in, out_size, ws_size, (size_t)WS_END); grid = -1; return; }
        int dev = 0, cus = 0, per_cu = 0;
        if (hipGetDevice(&dev) != hipSuccess || hipDeviceGetAttribute(&cus, hipDeviceAttributeMultiprocessorCount, dev) != hipSuccess) { grid = -1; return; }
        if (hipFuncSetAttribute((const void*)mega_fwd, hipFuncAttributeMaxDynamicSharedMemorySize, LDS_BYTES) != hipSuccess) { fprintf(stderr, "kernel_launch: hipFuncSetAttribute failed\n"); grid = -1; return; }
        if (hipOccupancyMaxActiveBlocksPerMultiprocessor(&per_cu, (const void*)mega_fwd, NTHREADS, LDS_BYTES) != hipSuccess || per_cu < 1) { fprintf(stderr, "kernel_launch: occupancy query says %d blocks per CU\n", per_cu); grid = -1; (void)hipGetLastError(); return; }
        grid = cus;
    }
    if (grid < 0) return;
    (void)hipMemsetAsync((char*)d_ws + OFF_CTL, 0, CTL_BYTES, stream);
    Args a{};
    for (int i = 0; i < 14; ++i) a.in[i] = (const float*)d_in[i];
    a.out = (float*)d_out; a.ws = (unsigned char*)d_ws;
    hipLaunchKernelGGL(mega_fwd, dim3(grid), dim3(NTHREADS), LDS_BYTES, stream, a);
}
```

```cpp
#include <hip/hip_runtime.h>
#include <cstdio>
#include <cstdint>
__device__ __forceinline__ int tid_of(int wv) { int t; asm volatile("v_mbcnt_lo_u32_b32 %0, -1, 0\n\tv_mbcnt_hi_u32_b32 %0, -1, %0\n\tv_lshl_add_u32 %0, %1, 6, %0" : "=&v"(t) : "s"(wv)); return t; }
__device__ __forceinline__ void half_swap(float& a, float& b) { asm("s_nop 1\n\tv_permlane32_swap_b32 %0, %1" : "+v"(a), "+v"(b)); }
template <int K> __device__ __forceinline__ float lane_xor(float v) { static_assert(K >= 1 && K <= 16, "lane_xor: within 32 lanes"); return __builtin_bit_cast(float, __builtin_amdgcn_ds_swizzle(__builtin_bit_cast(int, v), (K << 10) | 0x1f)); }
__device__ __forceinline__ float wave_sum(float v) {
    v += lane_xor<1>(v); v += lane_xor<2>(v); v += lane_xor<4>(v); v += lane_xor<8>(v); v += lane_xor<16>(v);
    float a = v, b = v; half_swap(a, b);
    return a + b;
}
namespace pg8 {
#define PG8_LAS __attribute__((address_space(3)))
typedef unsigned short bf16_t;
typedef short bf16x8 __attribute__((ext_vector_type(8)));
typedef float f32x4 __attribute__((ext_vector_type(4)));
typedef unsigned u32x4 __attribute__((ext_vector_type(4)));
constexpr int BM = 256, BK = 64, HALF = 128, HTB = HALF * BK * 2  , STAGE_BYTES = 8 * HTB, NXCD = 8, WGM = 8;

__host__ __device__ __forceinline__ int lds_byte(int r, int c) { const int st = (r >> 4) * 2 + (c >> 5), rr = r & 15, cc = c & 31, ob = rr * 64 + cc * 2; return st * 1024 + (ob ^ (((ob >> 9) & 1) << 5)); }
__host__ __device__ __forceinline__ void stage_rc(int b, int& R, int& C) { const int st = b / 1024, sb = b % 1024, swz = sb ^ (((sb >> 9) & 1) << 5); R = (st >> 1) * 16 + swz / 64; C = (st & 1) * 32 + (swz % 64) / 2; }
__host__ __device__ __forceinline__ int perm32(int rho) { const int n = rho >> 4, i = rho & 15; return 8 * (i >> 2) + 4 * n + (i & 3); }

struct Unit { int pm, pn; };
struct Gemm { const bf16_t* A; const bf16_t* Bt; int M, N, K; };

struct StaticOrder {
    int nM, nN, nwg, G, c;
    __host__ __device__ void init(int M, int N, int G_, int c_) { nM = M / BM; nN = N / BM; nwg = nM * nN; G = G_; c = c_; }
    __host__ __device__ bool next(int i, Unit& u) const {
        const long L = (long)i * G + c; if (L >= nwg) return false;
        int wgid = (int)L; { const int q = nwg / NXCD, r = nwg % NXCD, xcd = wgid % NXCD, off = wgid / NXCD; wgid = (xcd < r ? xcd * (q + 1) : r * (q + 1) + (xcd - r) * q) + off; }
        const int nig = WGM * nN, gid = wgid / nig, fm = gid * WGM, gsz = (nM - fm) < WGM ? (nM - fm) : WGM;
        u.pm = fm + ((wgid % nig) % gsz); u.pn = (wgid % nig) / gsz; return true;
    }
    __device__ __forceinline__ void a_ready(const Unit&) const {}
    __device__ __forceinline__ void done(const Unit&) const {}
};
__device__ __forceinline__ unsigned cvt_pk_bf16(float lo, float hi) { unsigned r; asm volatile("v_cvt_pk_bf16_f32 %0, %1, %2" : "=v"(r) : "v"(lo), "v"(hi)); return r; }
typedef float f32x2 __attribute__((ext_vector_type(2)));
__device__ __forceinline__ f32x2 gelu_pk(f32x2 v) {
    const f32x2 av = __builtin_elementwise_abs(v), d = av * 0.2316418882f + 1.0f;
    f32x2 t; t.x = __builtin_amdgcn_rcpf(d.x); t.y = __builtin_amdgcn_rcpf(d.y);
    f32x2 q = t * 0.5307027145f + (-0.7265760135f); q = q * t + 0.7107068705f; q = q * t + (-0.142248368f); q = q * t + 0.127414796f; q = q * t;
    const f32x2 s = (v * v) * (-0.72134752044f);
    f32x2 e; e.x = __builtin_amdgcn_exp2f(s.x); e.y = __builtin_amdgcn_exp2f(s.y);
    const f32x2 m = v * (q * e), r = v - m;
    f32x2 o; o.x = v.x < 0.f ? m.x : r.x; o.y = v.y < 0.f ? m.y : r.y; return o;
}

struct EpiIn {
    static constexpr bool PERM = true, AFTER_DRAIN = false;
    bf16_t* O; long ldc; long gelu_from_pn; const unsigned long long* rowss; float inv_k, eps;
    __device__ __forceinline__ void operator()(const f32x4 (&acc)[2][2][4][2], const Unit& u, int wr, int wc, int fr, int fq) const {
        const int row0 = u.pm * BM + wr * 64 + fr; const int col0 = u.pn * BM + wc * 32 + 8 * fq;
        const bool act = u.pn >= (int)gelu_from_pn;
#pragma unroll
        for (int ai = 0; ai < 2; ++ai)
#pragma unroll
            for (int m = 0; m < 4; ++m) { bf16_t* rowp = O + (size_t)(row0 + ai * HALF + m * 16) * (size_t)ldc + col0;
                const float rs = __builtin_amdgcn_rsqf((float)rowss[row0 + ai * HALF + m * 16] * inv_k + eps);
#pragma unroll
                for (int bj = 0; bj < 2; ++bj) { f32x4 v0 = acc[ai][bj][m][0] * rs, v1 = acc[ai][bj][m][1] * rs;
                    if (act) { f32x2 a = gelu_pk((f32x2){v0[0], v0[1]}), b = gelu_pk((f32x2){v0[2], v0[3]}), c = gelu_pk((f32x2){v1[0], v1[1]}), d = gelu_pk((f32x2){v1[2], v1[3]});
                        v0 = (f32x4){a.x, a.y, b.x, b.y}; v1 = (f32x4){c.x, c.y, d.x, d.y}; }
                    u32x4 w; w.x = cvt_pk_bf16(v0[0], v0[1]); w.y = cvt_pk_bf16(v0[2], v0[3]); w.z = cvt_pk_bf16(v1[0], v1[1]); w.w = cvt_pk_bf16(v1[2], v1[3]);
                    *(u32x4*)(rowp + bj * HALF) = w; } }
    }
};
struct EpiBf {
    static constexpr bool PERM = true, AFTER_DRAIN = false;
    bf16_t* O; long ldc;
    __device__ __forceinline__ void operator()(const f32x4 (&acc)[2][2][4][2], const Unit& u, int wr, int wc, int fr, int fq) const {
        const int row0 = u.pm * BM + wr * 64 + fr; const int col0 = u.pn * BM + wc * 32 + 8 * fq;
#pragma unroll
        for (int ai = 0; ai < 2; ++ai)
#pragma unroll
            for (int m = 0; m < 4; ++m) { bf16_t* rowp = O + (size_t)(row0 + ai * HALF + m * 16) * (size_t)ldc + col0;
#pragma unroll
                for (int bj = 0; bj < 2; ++bj) { const f32x4 v0 = acc[ai][bj][m][0], v1 = acc[ai][bj][m][1];
                    u32x4 w; w.x = cvt_pk_bf16(v0[0], v0[1]); w.y = cvt_pk_bf16(v0[2], v0[3]); w.z = cvt_pk_bf16(v1[0], v1[1]); w.w = cvt_pk_bf16(v1[2], v1[3]);
                    *(u32x4*)(rowp + bj * HALF) = w; } }
    }
};
typedef int i32x4 __attribute__((ext_vector_type(4)));
__device__ __forceinline__ f32x4 mma1(bf16x8 w, bf16x8 a, f32x4 c) { return __builtin_amdgcn_mfma_f32_16x16x32_bf16(w, a, c, 0, 0, 0); }
__device__ __forceinline__ i32x4 mma1(bf16x8 w, bf16x8 a, i32x4 c) { return __builtin_amdgcn_mfma_i32_16x16x64_i8(__builtin_bit_cast(i32x4, w), __builtin_bit_cast(i32x4, a), c, 0, 0, 0); }
template <class E, class = void> struct ARow4Of { static constexpr bool v = false; };
template <class E> struct ARow4Of<E, decltype((void)E::AROW4)> { static constexpr bool v = E::AROW4; };
template <class E, class = void> struct AccOf { typedef f32x4 type; };
template <class E> struct AccOf<E, decltype((void)sizeof(typename E::AccT))> { typedef typename E::AccT type; };
template <int CTRL> __device__ __forceinline__ float dpp_z(float src) { return __builtin_bit_cast(float, __builtin_amdgcn_update_dpp(0, __builtin_bit_cast(int, src), CTRL, 0xf, 0xf, true)); }
template <int CTRL> __device__ __forceinline__ float dpp_f(float oldv, float src) { return __builtin_bit_cast(float, __builtin_amdgcn_update_dpp(__builtin_bit_cast(int, oldv), __builtin_bit_cast(int, src), CTRL, 0xf, 0xf, false)); }
struct EpiConv {
    static constexpr bool PERM = true, AFTER_DRAIN = false;
    bf16_t* ACT; float* U4; const float* cw; const float* cb; long dff; const unsigned long long* rowss; float inv_k, eps;
    __device__ __forceinline__ void operator()(f32x4 (&acc)[2][2][4][2], const Unit& u, int wr, int wc, int fr, int fq) const {
#pragma unroll
        for (int ai = 0; ai < 2; ++ai)
#pragma unroll
            for (int m = 0; m < 4; ++m) { const float rs = __builtin_amdgcn_rsqf((float)rowss[u.pm * BM + ai * HALF + wr * 64 + m * 16 + fr] * inv_k + eps);
#pragma unroll
                for (int bj = 0; bj < 2; ++bj)
#pragma unroll
                    for (int n = 0; n < 2; ++n) acc[ai][bj][m][n] = acc[ai][bj][m][n] * rs; }
        body(acc, u, wr, wc, fr, fq);
    }
    __device__ __forceinline__ void body(f32x4 (&acc)[2][2][4][2], const Unit& u, int wr, int wc, int fr, int fq) const {
        const int ch0 = u.pn * 128 + wc * 32 + 8 * fq;
        const int n2 = 2 * (int)dff;
        { const int slot = (fr < 2) ? fr : fr - 12;
          if (fr < 2 || fr >= 14) {
#pragma unroll
              for (int ai = 0; ai < 2; ++ai) { float* p = U4 + ((size_t)(u.pm * 4 + ai * 2 + wr) * 4 + slot) * (size_t)n2 + ch0;
#pragma unroll
                  for (int bj = 0; bj < 2; ++bj)
#pragma unroll
                      for (int n = 0; n < 2; ++n) *(f32x4*)(p + bj * dff + 4 * n) = (fr < 2) ? acc[ai][bj][0][n] : acc[ai][bj][3][n]; } } }
#pragma unroll
        for (int bj = 0; bj < 2; ++bj) {
            const float* wp = cw + bj * dff + ch0; const float* bp = cb + bj * dff + ch0;
            f32x4 w0[2], w1[2], w2[2], bb[2], w0z[2], w1z[2];
#pragma unroll
            for (int n = 0; n < 2; ++n) { w0[n] = *(const f32x4*)(wp + 4 * n); w1[n] = *(const f32x4*)(wp + n2 + 4 * n); w2[n] = *(const f32x4*)(wp + 2 * (size_t)n2 + 4 * n); bb[n] = *(const f32x4*)(bp + 4 * n);
                w0z[n] = fr < 2 ? w0[n] : (f32x4){0.f, 0.f, 0.f, 0.f}; w1z[n] = fr == 0 ? w1[n] : (f32x4){0.f, 0.f, 0.f, 0.f}; }
#pragma unroll
            for (int ai = 0; ai < 2; ++ai)
#pragma unroll
                for (int m = 3; m >= 0; --m)
#pragma unroll
                    for (int n = 0; n < 2; ++n) { const f32x4 x = acc[ai][bj][m][n]; f32x4 y;
#pragma unroll
                        for (int e = 0; e < 4; ++e) y[e] = fmaf(w2[n][e], x[e], bb[n][e]);
                        if (m > 0) { const f32x4 xp = acc[ai][bj][m - 1][n];
                            asm volatile("s_nop 1\n\t"
                                "v_fmac_f32_dpp %0, %4, %12 row_shr:1 row_mask:0xf bank_mask:0xf\n\tv_fmac_f32_dpp %1, %5, %13 row_shr:1 row_mask:0xf bank_mask:0xf\n\tv_fmac_f32_dpp %2, %6, %14 row_shr:1 row_mask:0xf bank_mask:0xf\n\tv_fmac_f32_dpp %3, %7, %15 row_shr:1 row_mask:0xf bank_mask:0xf\n\t"
                                "v_fmac_f32_dpp %0, %4, %16 row_shr:2 row_mask:0xf bank_mask:0xf\n\tv_fmac_f32_dpp %1, %5, %17 row_shr:2 row_mask:0xf bank_mask:0xf\n\tv_fmac_f32_dpp %2, %6, %18 row_shr:2 row_mask:0xf bank_mask:0xf\n\tv_fmac_f32_dpp %3, %7, %19 row_shr:2 row_mask:0xf bank_mask:0xf\n\t"
                                "v_fmac_f32_dpp %0, %8, %20 row_ror:1 row_mask:0xf bank_mask:0xf\n\tv_fmac_f32_dpp %1, %9, %21 row_ror:1 row_mask:0xf bank_mask:0xf\n\tv_fmac_f32_dpp %2, %10, %22 row_ror:1 row_mask:0xf bank_mask:0xf\n\tv_fmac_f32_dpp %3, %11, %23 row_ror:1 row_mask:0xf bank_mask:0xf\n\t"
                                "v_fmac_f32_dpp %0, %8, %24 row_ror:2 row_mask:0xf bank_mask:0xf\n\tv_fmac_f32_dpp %1, %9, %25 row_ror:2 row_mask:0xf bank_mask:0xf\n\tv_fmac_f32_dpp %2, %10, %26 row_ror:2 row_mask:0xf bank_mask:0xf\n\tv_fmac_f32_dpp %3, %11, %27 row_ror:2 row_mask:0xf bank_mask:0xf"
                                : "+v"(y[0]), "+v"(y[1]), "+v"(y[2]), "+v"(y[3])
                                : "v"(x[0]), "v"(x[1]), "v"(x[2]), "v"(x[3]), "v"(xp[0]), "v"(xp[1]), "v"(xp[2]), "v"(xp[3]),
                                  "v"(w1[n][0]), "v"(w1[n][1]), "v"(w1[n][2]), "v"(w1[n][3]), "v"(w0[n][0]), "v"(w0[n][1]), "v"(w0[n][2]), "v"(w0[n][3]),
                                  "v"(w1z[n][0]), "v"(w1z[n][1]), "v"(w1z[n][2]), "v"(w1z[n][3]), "v"(w0z[n][0]), "v"(w0z[n][1]), "v"(w0z[n][2]), "v"(w0z[n][3])); }
                        else {
                            asm volatile("s_nop 1\n\t"
                                "v_fmac_f32_dpp %0, %4, %8 row_shr:1 row_mask:0xf bank_mask:0xf\n\tv_fmac_f32_dpp %1, %5, %9 row_shr:1 row_mask:0xf bank_mask:0xf\n\tv_fmac_f32_dpp %2, %6, %10 row_shr:1 row_mask:0xf bank_mask:0xf\n\tv_fmac_f32_dpp %3, %7, %11 row_shr:1 row_mask:0xf bank_mask:0xf\n\t"
                                "v_fmac_f32_dpp %0, %4, %12 row_shr:2 row_mask:0xf bank_mask:0xf\n\tv_fmac_f32_dpp %1, %5, %13 row_shr:2 row_mask:0xf bank_mask:0xf\n\tv_fmac_f32_dpp %2, %6, %14 row_shr:2 row_mask:0xf bank_mask:0xf\n\tv_fmac_f32_dpp %3, %7, %15 row_shr:2 row_mask:0xf bank_mask:0xf"
                                : "+v"(y[0]), "+v"(y[1]), "+v"(y[2]), "+v"(y[3])
                                : "v"(x[0]), "v"(x[1]), "v"(x[2]), "v"(x[3]),
                                  "v"(w1[n][0]), "v"(w1[n][1]), "v"(w1[n][2]), "v"(w1[n][3]), "v"(w0[n][0]), "v"(w0[n][1]), "v"(w0[n][2]), "v"(w0[n][3])); }
                        acc[ai][bj][m][n] = y; }
        }
        const int row0 = u.pm * BM + wr * 64 + fr;
#pragma unroll
        for (int ai = 0; ai < 2; ++ai)
#pragma unroll
            for (int m = 0; m < 4; ++m) { float r[8];
#pragma unroll
                for (int n = 0; n < 2; ++n)
#pragma unroll
                    for (int e = 0; e < 4; ++e) { const float g = acc[ai][0][m][n][e]; r[4 * n + e] = g * __builtin_amdgcn_rcpf(1.f + __builtin_amdgcn_exp2f(-1.4426950408889634f * g)) * acc[ai][1][m][n][e]; }
                u32x4 w; w.x = cvt_pk_bf16(r[0], r[1]); w.y = cvt_pk_bf16(r[2], r[3]); w.z = cvt_pk_bf16(r[4], r[5]); w.w = cvt_pk_bf16(r[6], r[7]);
                *(u32x4*)(ACT + (size_t)(row0 + ai * HALF + m * 16) * (size_t)dff + ch0) = w; }
    }
};
struct EpiConv4 {
    EpiConv c;
    __device__ __forceinline__ void body(f32x4 (&acc)[2][2][4][2], const Unit& u, int wr, int wc, int fr, int fq) const {
        const int ch0 = u.pn * 128 + wc * 32 + 8 * fq; const int n2 = 2 * (int)c.dff;
        if (fr == 0 || fr == 15) {
#pragma unroll
            for (int ai = 0; ai < 2; ++ai)
#pragma unroll
                for (int s = 0; s < 2; ++s) { float* p = c.U4 + ((size_t)(u.pm * 4 + ai * 2 + wr) * 4 + (fr == 0 ? s : 2 + s)) * (size_t)n2 + ch0;
#pragma unroll
                    for (int bj = 0; bj < 2; ++bj)
#pragma unroll
                        for (int n = 0; n < 2; ++n) *(f32x4*)(p + bj * c.dff + 4 * n) = (fr == 0) ? acc[ai][bj][s][n] : acc[ai][bj][2 + s][n]; } }
#pragma unroll
        for (int bj = 0; bj < 2; ++bj) {
            const float* wp = c.cw + bj * c.dff + ch0; const float* bp = c.cb + bj * c.dff + ch0;
#pragma unroll
            for (int n = 0; n < 2; ++n) { const f32x4 w0 = *(const f32x4*)(wp + 4 * n), w1 = *(const f32x4*)(wp + n2 + 4 * n), w2 = *(const f32x4*)(wp + 2 * (size_t)n2 + 4 * n), bb = *(const f32x4*)(bp + 4 * n);
#pragma unroll
                for (int ai = 0; ai < 2; ++ai) { const f32x4 x0 = acc[ai][bj][0][n], x1 = acc[ai][bj][1][n], x2 = acc[ai][bj][2][n], x3 = acc[ai][bj][3][n];
                    const f32x4 y3 = w0 * x1 + (w1 * x2 + (w2 * x3 + bb)), y2 = w0 * x0 + (w1 * x1 + (w2 * x2 + bb)); f32x4 y1 = w1 * x0 + (w2 * x1 + bb), y0 = w2 * x0 + bb;
                    asm volatile("s_nop 1\n\t"
                        "v_fmac_f32_dpp %4, %12, %16 row_shr:1 row_mask:0xf bank_mask:0xf\n\tv_fmac_f32_dpp %5, %13, %17 row_shr:1 row_mask:0xf bank_mask:0xf\n\tv_fmac_f32_dpp %6, %14, %18 row_shr:1 row_mask:0xf bank_mask:0xf\n\tv_fmac_f32_dpp %7, %15, %19 row_shr:1 row_mask:0xf bank_mask:0xf\n\t"
                        "v_fmac_f32_dpp %0, %12, %20 row_shr:1 row_mask:0xf bank_mask:0xf\n\tv_fmac_f32_dpp %1, %13, %21 row_shr:1 row_mask:0xf bank_mask:0xf\n\tv_fmac_f32_dpp %2, %14, %22 row_shr:1 row_mask:0xf bank_mask:0xf\n\tv_fmac_f32_dpp %3, %15, %23 row_shr:1 row_mask:0xf bank_mask:0xf\n\t"
                        "v_fmac_f32_dpp %0, %8, %16 row_shr:1 row_mask:0xf bank_mask:0xf\n\tv_fmac_f32_dpp %1, %9, %17 row_shr:1 row_mask:0xf bank_mask:0xf\n\tv_fmac_f32_dpp %2, %10, %18 row_shr:1 row_mask:0xf bank_mask:0xf\n\tv_fmac_f32_dpp %3, %11, %19 row_shr:1 row_mask:0xf bank_mask:0xf"
                        : "+v"(y0[0]), "+v"(y0[1]), "+v"(y0[2]), "+v"(y0[3]), "+v"(y1[0]), "+v"(y1[1]), "+v"(y1[2]), "+v"(y1[3])
                        : "v"(x2[0]), "v"(x2[1]), "v"(x2[2]), "v"(x2[3]), "v"(x3[0]), "v"(x3[1]), "v"(x3[2]), "v"(x3[3]),
                          "v"(w0[0]), "v"(w0[1]), "v"(w0[2]), "v"(w0[3]), "v"(w1[0]), "v"(w1[1]), "v"(w1[2]), "v"(w1[3]));
                    acc[ai][bj][0][n] = y0; acc[ai][bj][1][n] = y1; acc[ai][bj][2][n] = y2; acc[ai][bj][3][n] = y3; } }
        }
        const int row0 = u.pm * BM + wr * 64 + 4 * fr;
#pragma unroll
        for (int ai = 0; ai < 2; ++ai)
#pragma unroll
            for (int m = 0; m < 4; ++m) { float r[8];
#pragma unroll
                for (int n = 0; n < 2; ++n)
#pragma unroll
                    for (int e = 0; e < 4; ++e) { const float g = acc[ai][0][m][n][e]; r[4 * n + e] = g * __builtin_amdgcn_rcpf(1.f + __builtin_amdgcn_exp2f(-1.4426950408889634f * g)) * acc[ai][1][m][n][e]; }
                u32x4 w; w.x = cvt_pk_bf16(r[0], r[1]); w.y = cvt_pk_bf16(r[2], r[3]); w.z = cvt_pk_bf16(r[4], r[5]); w.w = cvt_pk_bf16(r[6], r[7]);
                *(u32x4*)(c.ACT + (size_t)(row0 + ai * HALF + m) * (size_t)c.dff + ch0) = w; }
    }
};
struct EpiIn8 {
    static constexpr bool PERM = true, AFTER_DRAIN = false; typedef i32x4 AccT;
    EpiIn core; const float* sA; const float* sB;
    __device__ __forceinline__ void operator()(i32x4 (&acc)[2][2][4][2], const Unit& u, int wr, int wc, int fr, int fq) const {
        f32x4 cs[2][2];
#pragma unroll
        for (int bj = 0; bj < 2; ++bj)
#pragma unroll
            for (int n = 0; n < 2; ++n) cs[bj][n] = *(const f32x4*)(sB + u.pn * BM + bj * HALF + wc * 32 + 8 * fq + 4 * n);
        f32x4 af[2][2][4][2];
#pragma unroll
        for (int ai = 0; ai < 2; ++ai)
#pragma unroll
            for (int m = 0; m < 4; ++m) { const float rf = sA[u.pm * BM + ai * HALF + wr * 64 + m * 16 + fr];
#pragma unroll
                for (int bj = 0; bj < 2; ++bj)
#pragma unroll
                    for (int n = 0; n < 2; ++n) af[ai][bj][m][n] = __builtin_convertvector(acc[ai][bj][m][n], f32x4) * rf * cs[bj][n]; }
        core(af, u, wr, wc, fr, fq);
    }
};
struct EpiConv8 {
    static constexpr bool PERM = true, AFTER_DRAIN = false, AROW4 = true; typedef i32x4 AccT;
    EpiConv core; const float* sA; const float* sB;
    __device__ __forceinline__ void operator()(i32x4 (&acc)[2][2][4][2], const Unit& u, int wr, int wc, int fr, int fq) const {
        f32x4 cs[2][2];
#pragma unroll
        for (int bj = 0; bj < 2; ++bj)
#pragma unroll
            for (int n = 0; n < 2; ++n) cs[bj][n] = *(const f32x4*)(sB + u.pn * BM + bj * HALF + wc * 32 + 8 * fq + 4 * n);
        f32x4 af[2][2][4][2];
#pragma unroll
        for (int ai = 0; ai < 2; ++ai)
#pragma unroll
            for (int m = 0; m < 4; ++m) { const int row = u.pm * BM + ai * HALF + wr * 64 + 4 * fr + m;
                const float rf = sA[row] * __builtin_amdgcn_rsqf((float)core.rowss[row] * core.inv_k + core.eps);
#pragma unroll
                for (int bj = 0; bj < 2; ++bj)
#pragma unroll
                    for (int n = 0; n < 2; ++n) af[ai][bj][m][n] = __builtin_convertvector(acc[ai][bj][m][n], f32x4) * rf * cs[bj][n]; }
        EpiConv4{core}.body(af, u, wr, wc, fr, fq);
    }
};
struct EpiRes {
    static constexpr bool PERM = true, AFTER_DRAIN = false;
    bf16_t* xb; unsigned long long* rowss; long ldc;
    __device__ __forceinline__ void operator()(const f32x4 (&acc)[2][2][4][2], const Unit& u, int wr, int wc, int fr, int fq) const {
        const int row0 = u.pm * BM + wr * 64 + fr, col0 = u.pn * BM + wc * 32 + 8 * fq;
#pragma unroll
        for (int ai = 0; ai < 2; ++ai) {
            u32x4 bs[4][2];
#pragma unroll
            for (int m = 0; m < 4; ++m)
#pragma unroll
                for (int bj = 0; bj < 2; ++bj) bs[m][bj] = *(const u32x4*)(xb + (size_t)(row0 + ai * HALF + m * 16) * (size_t)ldc + col0 + bj * HALF);
#pragma unroll
            for (int m = 0; m < 4; ++m) { const int row = row0 + ai * HALF + m * 16; float ss = 0.f;
#pragma unroll
                for (int bj = 0; bj < 2; ++bj) { const u32x4 b = bs[m][bj]; const f32x4 a0 = acc[ai][bj][m][0], a1 = acc[ai][bj][m][1];
                    const float v0 = __builtin_bit_cast(float, b.x << 16) + a0[0], v1 = __builtin_bit_cast(float, b.x & 0xffff0000u) + a0[1], v2 = __builtin_bit_cast(float, b.y << 16) + a0[2], v3 = __builtin_bit_cast(float, b.y & 0xffff0000u) + a0[3];
                    const float v4 = __builtin_bit_cast(float, b.z << 16) + a1[0], v5 = __builtin_bit_cast(float, b.z & 0xffff0000u) + a1[1], v6 = __builtin_bit_cast(float, b.w << 16) + a1[2], v7 = __builtin_bit_cast(float, b.w & 0xffff0000u) + a1[3];
                    ss += ((v0 * v0 + v1 * v1) + (v2 * v2 + v3 * v3)) + ((v4 * v4 + v5 * v5) + (v6 * v6 + v7 * v7));
                    u32x4 w; w.x = cvt_pk_bf16(v0, v1); w.y = cvt_pk_bf16(v2, v3); w.z = cvt_pk_bf16(v4, v5); w.w = cvt_pk_bf16(v6, v7);
                    *(u32x4*)(xb + (size_t)row * (size_t)ldc + col0 + bj * HALF) = w; }
                ss += __builtin_bit_cast(float, __builtin_amdgcn_ds_swizzle(__builtin_bit_cast(int, ss), (16 << 10) | 0x1f));
                { float sa = ss, sb = ss; asm("s_nop 1\n\tv_permlane32_swap_b32 %0, %1" : "+v"(sa), "+v"(sb)); ss = sa + sb; }
                if (fq == 0) __hip_atomic_fetch_add(rowss + row, (unsigned long long)(long long)__builtin_rintf(ss * 16777216.f), __ATOMIC_RELAXED, __HIP_MEMORY_SCOPE_AGENT); }
        }
    }
};

template <class Epi, class Sched, bool ALIGN_EPI = false, bool SP2 = false>
__device__ __forceinline__ void gemm_phase(PG8_LAS unsigned char* lds, const Gemm g, const Sched& S, const Epi& E, const int wv) {
    const int tid_o = tid_of(wv);
    const int tid = tid_o, wid = __builtin_amdgcn_readfirstlane(tid >> 6), lane = tid & 63, wr = wid >> 2, wc = wid & 3, fr = lane & 15, fq = lane >> 4;
    const int K = g.K, nt = K / BK;
    unsigned voffA[2], voffB[2];
#pragma unroll
    for (int i = 0; i < 2; ++i) { int R, C; stage_rc(tid * 16 + i * 8192, R, C); const int Rb = Epi::PERM ? ((R & ~31) + perm32(R & 31)) : R;
        const int Ra = ARow4Of<Epi>::v ? ((R & ~63) + 4 * (R & 15) + ((R & 63) >> 4)) : R;
        voffA[i] = (unsigned)(Ra * K + C) * 2u; voffB[i] = (unsigned)(Rb * K + C) * 2u; }
    const size_t kstep = (size_t)(BK * 2);
    const size_t hstep = (size_t)HALF * K * 2;
    const size_t tstep = 2 * hstep;
    const unsigned ldsw = (unsigned)wid * 1024u;
    const int aoff = lds_byte(wr * 64 + fr, fq * 8), boff = lds_byte(wc * 32 + fr, fq * 8);
#define PG8_SA(b, h) (((b) * 2 + (h)) * HTB)
#define PG8_SB(b, h) ((4 + (b) * 2 + (h)) * HTB)
#define PG8_STAGE(bufoff, gbase, voff) do { _Pragma("unroll") for (int _i = 0; _i < 2; ++_i) \
        __builtin_amdgcn_global_load_lds((const unsigned*)((const char*)(gbase) + (voff)[_i]), (PG8_LAS unsigned*)(lds + (bufoff) + ldsw + _i * 8192), 16, 0, 0); } while (0)
#define PG8_LDA(dst, b, h) do { _Pragma("unroll") for (int m = 0; m < 4; ++m) _Pragma("unroll") for (int k = 0; k < 2; ++k) dst[m][k] = *(const PG8_LAS bf16x8*)(lds + PG8_SA(b, h) + aoff + m * 2048 + k * 1024); } while (0)
#define PG8_LDB(dst, b, h) do { _Pragma("unroll") for (int n = 0; n < 2; ++n) _Pragma("unroll") for (int k = 0; k < 2; ++k) dst[n][k] = *(const PG8_LAS bf16x8*)(lds + PG8_SB(b, h) + boff + n * 2048 + k * 1024); } while (0)
#define PG8_MMA(ai, bj, At, Bt) do { __builtin_amdgcn_s_setprio(1); _Pragma("unroll") for (int m = 0; m < 4; ++m) _Pragma("unroll") for (int n = 0; n < 2; ++n) _Pragma("unroll") for (int k = 0; k < 2; ++k) \
        acc[ai][bj][m][n] = mma1(Bt[n][k], At[m][k], acc[ai][bj][m][n]); __builtin_amdgcn_s_setprio(0); } while (0)
#define PG8_WAIT_V(n) asm volatile("s_waitcnt vmcnt(" #n ")" ::: "memory")
#define PG8_WAIT_L(n) asm volatile("s_waitcnt lgkmcnt(" #n ")" ::: "memory")
#define PG8_BAR __builtin_amdgcn_s_barrier()
#define PG8_SCHED __builtin_amdgcn_sched_barrier(0)
    Unit cur, nxt; int ui = 0;
    if (!S.next(0, cur)) return;
    typedef typename AccOf<Epi>::type AccT;
    AccT acc[2][2][4][2];
#pragma unroll
    for (int a = 0; a < 2; ++a)
#pragma unroll
        for (int b = 0; b < 2; ++b)
#pragma unroll
            for (int m = 0; m < 4; ++m)
#pragma unroll
                for (int n = 0; n < 2; ++n) acc[a][b][m][n] = (AccT){0, 0, 0, 0};
    bf16x8 At[4][2], B0[2][2], B1[2][2];
    const char* cA = (const char*)g.A + (size_t)cur.pm * tstep; const char* cB = (const char*)g.Bt + (size_t)cur.pn * tstep;
    S.a_ready(cur);
    if constexpr (SP2) {
        PG8_STAGE(PG8_SB(0, 0), cB, voffB); PG8_STAGE(PG8_SB(0, 1), cB + hstep, voffB); PG8_STAGE(PG8_SA(0, 0), cA, voffA); PG8_STAGE(PG8_SA(0, 1), cA + hstep, voffA);
        if (wr == 1) PG8_BAR;
        PG8_WAIT_V(2); PG8_BAR;
        PG8_STAGE(PG8_SB(1, 0), cB + kstep, voffB); PG8_STAGE(PG8_SA(1, 0), cA + kstep, voffA); PG8_STAGE(PG8_SB(1, 1), cB + hstep + kstep, voffB);
        PG8_WAIT_V(6); PG8_BAR;
    } else {
        PG8_STAGE(PG8_SB(0, 0), cB, voffB); PG8_STAGE(PG8_SA(0, 0), cA, voffA); PG8_STAGE(PG8_SB(0, 1), cB + hstep, voffB); PG8_STAGE(PG8_SA(0, 1), cA + hstep, voffA);
        if (wr == 1) PG8_BAR;
        PG8_WAIT_V(4); PG8_BAR;
        PG8_STAGE(PG8_SB(1, 0), cB + kstep, voffB); PG8_STAGE(PG8_SA(1, 0), cA + kstep, voffA); PG8_STAGE(PG8_SB(1, 1), cB + hstep + kstep, voffB);
        PG8_WAIT_V(6); PG8_BAR;
    }
    for (;;) {
        const bool has_next = S.next(ui + 1, nxt);
        const char* nA = has_next ? (const char*)g.A + (size_t)nxt.pm * tstep : cA; const char* nB = has_next ? (const char*)g.Bt + (size_t)nxt.pn * tstep : cB;
        for (int t = 0; t < nt; t += 2) {
            const bool last = (t == nt - 2);
            const char* a1 = cA + (size_t)(t + 1) * kstep;
            const char* a2 = last ? nA : cA + (size_t)(t + 2) * kstep; const char* b2 = last ? nB : cB + (size_t)(t + 2) * kstep;
            const char* a3 = a2 + kstep; const char* b3 = b2 + kstep;
            if (last && has_next) S.a_ready(nxt);
            if constexpr (SP2) {
            PG8_LDB(B0, 0, 0); PG8_LDB(B1, 0, 1); PG8_SCHED; PG8_LDA(At, 0, 0); PG8_STAGE(PG8_SA(1, 1), a1 + hstep, voffA);
            PG8_WAIT_V(8); PG8_WAIT_L(0); PG8_BAR; PG8_MMA(0, 0, At, B0); PG8_MMA(0, 1, At, B1); PG8_BAR; PG8_SCHED;
            PG8_LDA(At, 0, 1); PG8_STAGE(PG8_SB(0, 0), b2, voffB); PG8_STAGE(PG8_SB(0, 1), b2 + hstep, voffB); PG8_STAGE(PG8_SA(0, 0), a2, voffA);
            PG8_WAIT_V(8); PG8_WAIT_L(0); PG8_BAR; PG8_MMA(1, 0, At, B0); PG8_MMA(1, 1, At, B1); PG8_BAR; PG8_SCHED;
            PG8_LDB(B0, 1, 0); PG8_LDB(B1, 1, 1); PG8_SCHED; PG8_LDA(At, 1, 0); PG8_STAGE(PG8_SA(0, 1), a2 + hstep, voffA);
            PG8_WAIT_V(8); PG8_WAIT_L(0); PG8_BAR; PG8_MMA(0, 0, At, B0); PG8_MMA(0, 1, At, B1); PG8_BAR; PG8_SCHED;
            PG8_LDA(At, 1, 1); PG8_STAGE(PG8_SB(1, 0), b3, voffB); PG8_STAGE(PG8_SB(1, 1), b3 + hstep, voffB); PG8_STAGE(PG8_SA(1, 0), a3, voffA);
            PG8_WAIT_V(8); PG8_WAIT_L(0); PG8_BAR; PG8_MMA(1, 0, At, B0); PG8_MMA(1, 1, At, B1); PG8_BAR; PG8_SCHED;
            } else {
            PG8_LDB(B0, 0, 0); PG8_SCHED; PG8_LDA(At, 0, 0); PG8_STAGE(PG8_SA(1, 1), a1 + hstep, voffA);
            PG8_WAIT_L(8); PG8_BAR; PG8_WAIT_L(0); PG8_MMA(0, 0, At, B0); PG8_BAR; PG8_SCHED;
            PG8_LDB(B1, 0, 1); PG8_STAGE(PG8_SB(0, 0), b2, voffB);
            PG8_BAR; PG8_WAIT_L(0); PG8_MMA(0, 1, At, B1); PG8_BAR;
            PG8_LDA(At, 0, 1); PG8_STAGE(PG8_SA(0, 0), a2, voffA);
            PG8_BAR; PG8_WAIT_L(0); PG8_MMA(1, 0, At, B0); PG8_BAR; PG8_SCHED;
            PG8_STAGE(PG8_SB(0, 1), b2 + hstep, voffB);
            PG8_WAIT_V(6); PG8_BAR; PG8_MMA(1, 1, At, B1); PG8_BAR;
            PG8_LDB(B0, 1, 0); PG8_SCHED; PG8_LDA(At, 1, 0); PG8_STAGE(PG8_SA(0, 1), a2 + hstep, voffA);
            PG8_WAIT_L(8); PG8_BAR; PG8_WAIT_L(0); PG8_MMA(0, 0, At, B0); PG8_BAR; PG8_SCHED;
            PG8_LDB(B1, 1, 1); PG8_STAGE(PG8_SB(1, 0), b3, voffB);
            PG8_BAR; PG8_WAIT_L(0); PG8_MMA(0, 1, At, B1); PG8_BAR;
            PG8_LDA(At, 1, 1); PG8_STAGE(PG8_SA(1, 0), a3, voffA);
            PG8_BAR; PG8_WAIT_L(0); PG8_MMA(1, 0, At, B0); PG8_BAR; PG8_SCHED;
            PG8_STAGE(PG8_SB(1, 1), b3 + hstep, voffB);
            PG8_WAIT_V(6); PG8_BAR; PG8_MMA(1, 1, At, B1); PG8_BAR;
            }
        }
        if constexpr (ALIGN_EPI) { if (wr == 0) PG8_BAR; }
        if constexpr (!Epi::AFTER_DRAIN) { E(acc, cur, wr, wc, fr, fq); S.done(cur); }
        if (!has_next) break;
#pragma unroll
        for (int a = 0; a < 2; ++a)
#pragma unroll
            for (int b = 0; b < 2; ++b)
#pragma unroll
                for (int m = 0; m < 4; ++m)
#pragma unroll
                    for (int n = 0; n < 2; ++n) acc[a][b][m][n] = (AccT){0, 0, 0, 0};
        cur = nxt; cA = nA; cB = nB; ++ui;
        if constexpr (ALIGN_EPI) { if (wr == 1) PG8_BAR; }
    }
    PG8_WAIT_V(0);
    if constexpr (!ALIGN_EPI) { if (wr == 0) PG8_BAR; }
    PG8_BAR;
    if constexpr (Epi::AFTER_DRAIN) { E.fused(acc, cur, wr, wc, fr, fq, lds, wid, lane); S.done(cur); }
#undef PG8_SA
#undef PG8_SB
#undef PG8_STAGE
#undef PG8_LDA
#undef PG8_LDB
#undef PG8_MMA
#undef PG8_WAIT_V
#undef PG8_WAIT_L
#undef PG8_BAR
#undef PG8_SCHED
}
}
#define LAS __attribute__((address_space(3)))
#define XB_TMO      128
#define XB_XCNT(j)  (256  + 64 * (j))
#define XB_XSUB(j)  (1280 + 64 * (j))
#define XB_XGEN(j)  (2304 + 64 * (j))
#define XB_TOP      3328
#define XB_TOPGEN   3392
#define XCD_BAR_WORDS 3456
#define XB_SPIN_CAP (1u << 18)

__device__ __forceinline__ unsigned xb_ld(unsigned* p)              { return __hip_atomic_load(p, __ATOMIC_RELAXED, __HIP_MEMORY_SCOPE_AGENT); }
__device__ __forceinline__ unsigned xb_add(unsigned* p, unsigned v) { return __hip_atomic_fetch_add(p, v, __ATOMIC_RELAXED, __HIP_MEMORY_SCOPE_AGENT); }
__device__ __forceinline__ unsigned xb_xcc_id() { return (unsigned)__builtin_amdgcn_s_getreg((3 << 11) | 20) & 0xFu; }
#define XB_SPIN(cond, bar) do { unsigned _sp = 0; while (cond) { __builtin_amdgcn_s_sleep(1); \
    if ((++_sp & 255u) == 0u) { if (xb_ld(&(bar)[XB_TMO])) break; if (_sp > XB_SPIN_CAP) { atomicAdd(&(bar)[XB_TMO], 1u); break; } } } } while (0)

struct XcdBarrier {
    unsigned* bar; unsigned x;
    volatile LAS unsigned* st;
};

__device__ __forceinline__ XcdBarrier xcd_barrier_post(unsigned* bar, volatile LAS unsigned* st, const int wv) {
    XcdBarrier b; b.bar = bar; b.x = (unsigned)__builtin_amdgcn_readfirstlane((int)xb_xcc_id()); b.st = st;
    if (tid_of(wv) == 0) (void)xb_add(&bar[XB_XCNT(b.x)], 1u);
    return b;
}
__device__ __forceinline__ void xcd_barrier_complete(unsigned* bar, unsigned x, unsigned& nloc, unsigned& nx) {
    const unsigned G = gridDim.x * gridDim.y * gridDim.z;
    unsigned sum, cnt, mine, sp = 0u;
    for (;;) {
        sum = 0u; cnt = 0u; mine = 0u;
#pragma unroll
        for (unsigned j = 0; j < 16; ++j) { const unsigned c = xb_ld(&bar[XB_XCNT(j)]); sum += c; cnt += (c > 0u) ? 1u : 0u; mine = (j == x) ? c : mine; }
        if (sum == G) break;
        __builtin_amdgcn_s_sleep(1);
        if ((++sp & 255u) == 0u) { if (xb_ld(&bar[XB_TMO])) break; if (sp > XB_SPIN_CAP) { atomicAdd(&bar[XB_TMO], 1u); break; } }
    }
    nloc = mine > 0u ? mine : 1u; nx = cnt > 0u ? cnt : 1u;
}

__device__ __forceinline__ void xcd_barrier(const XcdBarrier& b, const int wv) {
    asm volatile("s_waitcnt vmcnt(0)" ::: "memory");
    __syncthreads();
    if (tid_of(wv) == 0) {
        unsigned* bar = b.bar; unsigned bx = b.x; asm volatile("" : "+s"(bx));
        __builtin_amdgcn_s_waitcnt(0);
        unsigned nloc = b.st[0], nx = b.st[1];
        if (nloc == 0u) { xcd_barrier_complete(bar, bx, nloc, nx); b.st[0] = nloc; b.st[1] = nx; }
        const unsigned old = xb_add(&bar[XB_XSUB(bx)], 1u);
        const unsigned gen = old / nloc;
        if (old + 1u == (gen + 1u) * nloc) {
            __builtin_amdgcn_fence(__ATOMIC_RELEASE, "agent");
            asm volatile("s_waitcnt vmcnt(0)" ::: "memory");
            const unsigned og = xb_add(&bar[XB_TOP], 1u);
            const unsigned tg = og / nx;
            if (og + 1u == (tg + 1u) * nx) xb_add(&bar[XB_TOPGEN], 1u);
            else XB_SPIN(xb_ld(&bar[XB_TOPGEN]) == tg, bar);
            __builtin_amdgcn_fence(__ATOMIC_ACQUIRE, "agent");
            xb_add(&bar[XB_XGEN(bx)], 1u);
            asm volatile("s_waitcnt vmcnt(0)" ::: "memory");
        } else {
            XB_SPIN(xb_ld(&bar[XB_XGEN(bx)]) == gen, bar);
            __builtin_amdgcn_fence(__ATOMIC_ACQUIRE, "agent");
            asm volatile("s_waitcnt vmcnt(0)" ::: "memory");
        }
    }
    __syncthreads();
}

namespace attn {
constexpr int D = 128;
constexpr float THR = 8.f;
constexpr bool WSKIP = true;
constexpr float SCALE = 0.08838834764831845f;
constexpr int NW = 8, QBLK = 32, KVBLK = 64, QB = NW * QBLK;
constexpr int SHM_V = KVBLK * D * 2, SHM_K = KVBLK * D * 2;
constexpr int LDS_BYTES = 2 * SHM_V + 2 * SHM_K + NW * 64 * 4;
typedef short bf16x8 __attribute__((ext_vector_type(8)));
typedef short s16x4 __attribute__((ext_vector_type(4)));
typedef float f32x16 __attribute__((ext_vector_type(16)));
typedef float f32x4 __attribute__((ext_vector_type(4)));
typedef unsigned u32x4 __attribute__((ext_vector_type(4)));
template <class A, class Bt> struct same_t { static constexpr bool v = false; };
template <class A> struct same_t<A, A> { static constexpr bool v = true; };

#define KSWZ(row, colB) ((row) * 256 + ((colB) ^ (((row) & 7) << 4)))
#define SBAR() __builtin_amdgcn_sched_barrier(0)
__device__ __forceinline__ int v_st(int k, int c) { const int kk = (k & ~0xC) | ((k & 4) << 1) | ((k & 8) >> 1); return ((kk >> 3) * 4 + (c >> 5)) * 512 + ((kk & 7) * 32 + (c & 31)) * 2; }
__device__ __forceinline__ int v_rd_base(int lane) { return ((lane & 3) << 3) | (((lane >> 2) & 3) << 6) | (((lane >> 4) & 1) << 5) | (((lane >> 5) & 1) << 8); }
constexpr int v_rd_off(int d0, int ks, int half) { return d0 * 512 + ks * 4096 + half * 2048; }
__device__ __forceinline__ int crow(int r, int hi) { return (r & 3) + 8 * (r >> 2) + 4 * hi; }
__device__ __forceinline__ unsigned cvtpk(float lo, float hi) {
    unsigned r; asm volatile("v_cvt_pk_bf16_f32 %0, %1, %2" : "=v"(r) : "v"(lo), "v"(hi)); return r;
}
__device__ __forceinline__ bf16x8 pack8(f32x4 a, f32x4 b) {
    u32x4 w = {cvtpk(a[0], a[1]), cvtpk(a[2], a[3]), cvtpk(b[0], b[1]), cvtpk(b[2], b[3])};
    return *reinterpret_cast<bf16x8*>(&w);
}
template <class T> __device__ __forceinline__ bf16x8 load8(const T* p) {
    if constexpr (same_t<T, float>::v) { return pack8(*(const f32x4*)p, *(const f32x4*)(p + 4)); }
    else { return *reinterpret_cast<const bf16x8*>(p); }
}
__device__ __forceinline__ void mask_tile(f32x16& p0, f32x16& p1, int dq, unsigned W) {
    const float NEG = -__builtin_inff();
#pragma unroll
    for (int r = 0; r < 16; ++r) {
        const int c = (r & 3) + 8 * (r >> 2);
        if ((unsigned)(dq - c) >= W) p0[r] = NEG;
        if ((unsigned)(dq - c - 32) >= W) p1[r] = NEG;
    }
}
__device__ __forceinline__ void partialSM(f32x16& p0, f32x16& p1, float& m_reg, float& mn, float& alpha) {
    float pmax = p0[0]; for (int r = 1; r < 16; ++r) pmax = fmaxf(pmax, p0[r]); for (int r = 0; r < 16; ++r) pmax = fmaxf(pmax, p1[r]);
    { float pa_ = pmax, pb_ = pmax; half_swap(pa_, pb_); pmax = fmaxf(pa_, pb_); }
    constexpr float C2 = 1.4426950408889634f * SCALE;
    if (__builtin_expect(__all((pmax - m_reg) * SCALE <= THR), 1)) { mn = m_reg; alpha = 1.f; }
    else { mn = fmaxf(m_reg, pmax); alpha = __builtin_amdgcn_exp2f((m_reg - mn) * C2); m_reg = mn; }
    const float mnL = -mn * C2;
    for (int r = 0; r < 16; ++r) p0[r] = fmaf(p0[r], C2, mnL); for (int r = 0; r < 16; ++r) p1[r] = fmaf(p1[r], C2, mnL);
    for (int r = 0; r < 16; ++r) p0[r] = __builtin_amdgcn_exp2f(p0[r]);
}
__device__ __forceinline__ void finishSM(f32x16& p0, f32x16& p1, float alpha, float& l_reg, bf16x8& pa0, bf16x8& pa1, bf16x8& pa2, bf16x8& pa3) {
    for (int r = 0; r < 16; ++r) p1[r] = __builtin_amdgcn_exp2f(p1[r]);
    float ps = 0; for (int r = 0; r < 16; ++r) ps += p0[r]; for (int r = 0; r < 16; ++r) ps += p1[r];
    { float pa_ = ps, pb_ = ps; half_swap(pa_, pb_); ps = pa_ + pb_; }
    l_reg = l_reg * alpha + ps;
#define PK4(P, B_, OUT) do { unsigned a0 = cvtpk(P[B_+0], P[B_+1]), a1 = cvtpk(P[B_+2], P[B_+3]);                          \
        unsigned b0 = cvtpk(P[B_+4], P[B_+5]), b1 = cvtpk(P[B_+6], P[B_+7]);                                             \
        auto r0 = __builtin_amdgcn_permlane32_swap(a0, b0, false, false); auto r1 = __builtin_amdgcn_permlane32_swap(a1, b1, false, false); \
        u32x4 w = {r0[0], r1[0], r0[1], r1[1]}; OUT = *reinterpret_cast<bf16x8*>(&w); } while (0)
    PK4(p0, 0, pa0); PK4(p0, 8, pa1); PK4(p1, 0, pa2); PK4(p1, 8, pa3);
#undef PK4
}
template <int KB, bool SK>
__device__ __forceinline__ void qkt(f32x16& p0, f32x16& p1, const char* K_lds, int r32, int hi, const bf16x8* qr, bool act, float e0, float beta) {
    if (SK && !act) { const float NEG = -__builtin_inff();
#pragma unroll
        for (int r = 0; r < 16; ++r) { p0[r] = NEG; p1[r] = NEG; } return; }
    { const float b8 = 8.f * beta, b32 = 32.f * beta;
      p0[0] = e0; p0[1] = p0[0] + beta; p0[2] = p0[1] + beta; p0[3] = p0[2] + beta;
#pragma unroll
      for (int r = 4; r < 16; ++r) p0[r] = p0[r - 4] + b8;
#pragma unroll
      for (int r = 0; r < 16; ++r) p1[r] = p0[r] + b32; }
    const char* kb[4];
#pragma unroll
    for (int dd = 0; dd < 4; ++dd) kb[dd] = K_lds + KB * SHM_K + KSWZ(r32, (dd * 16 + hi * 8) * 2);
#pragma unroll
    for (int d0 = 0; d0 < 8; ++d0) { const char* a = kb[d0 & 3] + (d0 >> 2) * 128;
        bf16x8 b0 = *reinterpret_cast<const bf16x8*>(a);
        bf16x8 b1 = *reinterpret_cast<const bf16x8*>(a + 32 * 256);
        p0 = __builtin_amdgcn_mfma_f32_32x32x16_bf16(b0, qr[d0], p0, 0, 0, 0);
        p1 = __builtin_amdgcn_mfma_f32_32x32x16_bf16(b1, qr[d0], p1, 0, 0, 0); }
}
template <int VB, bool SK>
__device__ __forceinline__ void pv_tile(f32x16* o, int vb0, bf16x8 pa0, bf16x8 pa1, bf16x8 pa2, bf16x8 pa3, bool act) {
    if (SK && !act) return;
#define TRRD(dst, off) asm volatile("ds_read_b64_tr_b16 %0, %1 offset:%2" : "=&v"(dst) : "v"(vb0), "i"(off) : "memory")
#define PV_D0(d0) do { s16x4 l0, l1, l2, l3, h0, h1, h2, h3; constexpr int b_ = VB * SHM_V + v_rd_off(d0, 0, 0);     \
        TRRD(l0, b_); TRRD(h0, b_ + 2048); TRRD(l1, b_ + 4096); TRRD(h1, b_ + 6144); TRRD(l2, b_ + 8192); TRRD(h2, b_ + 10240); TRRD(l3, b_ + 12288); TRRD(h3, b_ + 14336); \
        asm volatile("s_waitcnt lgkmcnt(0)" ::: "memory"); SBAR();                 \
        o[d0] = __builtin_amdgcn_mfma_f32_32x32x16_bf16(pa0, (bf16x8){l0[0], l0[1], l0[2], l0[3], h0[0], h0[1], h0[2], h0[3]}, o[d0], 0, 0, 0);   \
        o[d0] = __builtin_amdgcn_mfma_f32_32x32x16_bf16(pa1, (bf16x8){l1[0], l1[1], l1[2], l1[3], h1[0], h1[1], h1[2], h1[3]}, o[d0], 0, 0, 0);   \
        o[d0] = __builtin_amdgcn_mfma_f32_32x32x16_bf16(pa2, (bf16x8){l2[0], l2[1], l2[2], l2[3], h2[0], h2[1], h2[2], h2[3]}, o[d0], 0, 0, 0);   \
        o[d0] = __builtin_amdgcn_mfma_f32_32x32x16_bf16(pa3, (bf16x8){l3[0], l3[1], l3[2], l3[3], h3[0], h3[1], h3[2], h3[3]}, o[d0], 0, 0, 0); } while (0)
    PV_D0(0); PV_D0(1); PV_D0(2); PV_D0(3);
#undef PV_D0
#undef TRRD
}

template <class TIn, class TOut> struct BlockRef { const TIn* Q; const TIn* K; const TIn* V; TOut* O; float* L; int P0; int pitch; int opitch; int lpitch; float beta; };
template <class TIn> struct Seam {
    bf16x8 qr[8];
    bf16x8 st_v0, st_v1, st_k0, st_k1; f32x4 sf0, sf1, sf2, sf3;
    f32x4 tq[16];
};
__device__ __forceinline__ int swa_jlo(int P0, int W) { const int lowk = P0 - W + 1; return lowk > 0 ? lowk / KVBLK : 0; }
#define ROW(p, pt, k0, rr) ((p) + (size_t)((k0) + (rr)) * (size_t)(pt) + sc)
#define VMW() asm volatile("s_waitcnt vmcnt(0)" ::: "memory")
#define VMWN(n) asm volatile("s_waitcnt vmcnt(%0)" :: "i"(n) : "memory")
#define SLOAD_H(Kp, Vp, pt, k0) do { S.st_v0 = load8<TIn>(ROW(Vp, pt, k0, sr)); S.st_v1 = load8<TIn>(ROW(Vp, pt, k0, 32 + sr));              \
                         S.st_k0 = load8<TIn>(ROW(Kp, pt, k0, sr)); S.st_k1 = load8<TIn>(ROW(Kp, pt, k0, 32 + sr)); } while (0)
#define SWRITE_HK(bf) do { *(bf16x8*)(K_lds + (bf) * SHM_K + kws) = S.st_k0; *(bf16x8*)(K_lds + (bf) * SHM_K + kws + 32 * 256) = S.st_k1; } while (0)
#define SWRITE_HV(bf) do { *(bf16x8*)(V_lds + (bf) * SHM_V + vst0) = S.st_v0; *(bf16x8*)(V_lds + (bf) * SHM_V + vst1) = S.st_v1; } while (0)
#define SWRITE_H(bf) do { SWRITE_HV(bf); SWRITE_HK(bf); } while (0)
#define SLOAD_F(p, k0) do { S.sf0 = *(const f32x4*)ROW(p, D, k0, sr); S.sf1 = *(const f32x4*)(ROW(p, D, k0, sr) + 4);                \
                            S.sf2 = *(const f32x4*)ROW(p, D, k0, 32 + sr); S.sf3 = *(const f32x4*)(ROW(p, D, k0, 32 + sr) + 4); } while (0)
#define SWRITE_KF(bf) do { *(bf16x8*)(K_lds + (bf) * SHM_K + kws) = pack8(S.sf0, S.sf1); *(bf16x8*)(K_lds + (bf) * SHM_K + kws + 32 * 256) = pack8(S.sf2, S.sf3); } while (0)
#define SWRITE_VF(bf) do { *(bf16x8*)(V_lds + (bf) * SHM_V + vst0) = pack8(S.sf0, S.sf1); *(bf16x8*)(V_lds + (bf) * SHM_V + vst1) = pack8(S.sf2, S.sf3); } while (0)
template <class TIn, class TOut>
__device__ __forceinline__ void causal_swa_prime(const BlockRef<TIn, TOut>& cur, int W, char* lds, Seam<TIn>& S, const int wv) {
    constexpr bool F32 = same_t<TIn, float>::v;
    const int tid = tid_of(wv), wid = __builtin_amdgcn_readfirstlane(tid >> 6), lane = tid & 63, r32 = lane & 31, hi = lane >> 5;
    const int sr = tid >> 4, sc = (tid & 15) * 8, kws = KSWZ(sr, sc * 2); char* K_lds = lds + 2 * SHM_V;
    const int kb0 = swa_jlo(cur.P0, W) * KVBLK;
    for (int d0 = 0; d0 < 8; ++d0) S.qr[d0] = load8<TIn>(cur.Q + (size_t)(wid * QBLK + r32) * (size_t)cur.pitch + d0 * 16 + hi * 8);
    if constexpr (F32) { SLOAD_F((const float*)cur.K, kb0); VMW(); SWRITE_KF(0); SBAR(); SLOAD_F((const float*)cur.V, kb0); }
    else { SLOAD_H(cur.K, cur.V, cur.pitch, kb0); VMW(); SWRITE_HK(0); }
    __syncthreads();
}
template <class TIn, class TOut>
__device__ __forceinline__ void causal_swa_block(const BlockRef<TIn, TOut>& cur, const BlockRef<TIn, TOut>& nxt, int skv, int W, char* lds, Seam<TIn>& S, const int wv) {
    constexpr bool F32 = same_t<TIn, float>::v;
    const int tid = tid_of(wv), wid = __builtin_amdgcn_readfirstlane(tid >> 6), lane = tid & 63, r32 = lane & 31, hi = lane >> 5;
    const int j_lo = swa_jlo(cur.P0, W);
    int j_hi = (cur.P0 + QB - 1) / KVBLK + 1; if (j_hi > skv / KVBLK) j_hi = skv / KVBLK;
    const int NT = j_hi - j_lo;
    const int kbn = swa_jlo(nxt.P0, W) * KVBLK;
    const int qlo = cur.P0 + wid * QBLK, qm = qlo + r32 - 4 * hi;
    char* V_lds = lds; char* K_lds = lds + 2 * SHM_V;
    float* ws = (float*)(lds + 2 * SHM_V + 2 * SHM_K) + wid * 64; float* li_l = ws, * al_l = ws + 32;
    float m_reg = -1e30f, l_reg = 0; f32x16 o[4] = {};
    const int sr = tid >> 4, sc = (tid & 15) * 8, vst0 = v_st(sr, sc), vst1 = v_st(32 + sr, sc), kws = KSWZ(sr, sc * 2);
    const int vb0 = (int)(uintptr_t)V_lds + v_rd_base(lane);
    const TIn* Kh = cur.K; const TIn* Vh = cur.V; const int pch = cur.pitch; const float beta = cur.beta;
#define RESC(a) do { if (__any((a) < 1.f)) { if (hi == 0) al_l[r32] = (a); asm volatile("s_waitcnt lgkmcnt(0)" ::: "memory");              \
                     for (int d_ = 0; d_ < 4; ++d_) for (int r = 0; r < 16; ++r) o[d_][r] *= al_l[crow(r, hi)]; } } while (0)
#define KBASE(t) ((j_lo + (t)) * KVBLK)
#define ACT(t) (KBASE(t) <= qlo + QBLK - 1 && KBASE(t) + KVBLK - 1 >= qlo - W + 1)
#define MASKT(P0_, P1_, t) do { const int kb_ = KBASE(t); if ((!SK || ACT(t)) && (kb_ + KVBLK - 1 > qlo || kb_ <= qlo + QBLK - 1 - W)) mask_tile(P0_, P1_, qm - kb_, (unsigned)W); } while (0)
    constexpr int NQL = F32 ? 16 : 8;
    constexpr bool SK = WSKIP && !F32;
#define SEAM_K0() do { VMWN(NQL); if constexpr (F32) { SWRITE_KF(0); SBAR(); SLOAD_F((const float*)nxt.V, kbn); } else { SWRITE_HK(0); } SBAR(); } while (0)
    f32x16 pA0, pA1, pB0, pB1; float mnA, mnB, alA, alB; bf16x8 pa0, pa1, pa2, pa3;
    if constexpr (F32) { VMW(); SWRITE_VF(0); SBAR(); } else { SWRITE_HV(0); SBAR(); }
    if (NT > 1) { if constexpr (F32) SLOAD_F((const float*)Kh, KBASE(1)); else SLOAD_H(Kh, Vh, pch, KBASE(1)); }
    SBAR(); qkt<0, SK>(pA0, pA1, K_lds, r32, hi, S.qr, ACT(0), -beta * (float)(qm - KBASE(0)), beta);
    if constexpr (F32) { if (NT > 1) { VMW(); SWRITE_KF(1); SBAR(); SLOAD_F((const float*)Vh, KBASE(1)); } }
    MASKT(pA0, pA1, 0); partialSM(pA0, pA1, m_reg, mnA, alA);
    if (NT > 1) { VMW(); if constexpr (F32) { SWRITE_VF(1); SBAR(); if (NT > 2) SLOAD_F((const float*)Kh, KBASE(2)); } else SWRITE_H(1); }
    __syncthreads();
#define HALF_STEP(PX0, PX1, mnX, alX, PY0, PY1, alY, t, KB, VB, SB) do {                                                      \
        SBAR(); qkt<KB, SK>(PX0, PX1, K_lds, r32, hi, S.qr, ACT(t), -beta * (float)(qm - KBASE(t)), beta);                                             \
        finishSM(PY0, PY1, alY, l_reg, pa0, pa1, pa2, pa3); SBAR();                                                           \
        if ((t) + 1 < NT) { if constexpr (F32) { VMW(); SWRITE_KF(SB); SBAR(); SLOAD_F((const float*)Vh, KBASE((t) + 1)); }  \
                            else { SLOAD_H(Kh, Vh, pch, KBASE((t) + 1)); } SBAR(); }                                               \
        pv_tile<VB, SK>(o, vb0, pa0, pa1, pa2, pa3, ACT((t) - 1)); MASKT(PX0, PX1, (t)); partialSM(PX0, PX1, m_reg, mnX, alX);                                        \
        __syncthreads();                                                                                                      \
        if ((t) + 1 < NT) { VMW(); if constexpr (F32) { SWRITE_VF(SB); SBAR(); if ((t) + 2 < NT) SLOAD_F((const float*)Kh, KBASE((t) + 2)); } \
                            else { SWRITE_H(SB); } }                                                                          \
        RESC(alX); __syncthreads(); } while (0)
    for (int t = 1; t + 1 < NT; t += 2) {
        HALF_STEP(pB0, pB1, mnB, alB, pA0, pA1, alA, t, 1, 0, 0);
        HALF_STEP(pA0, pA1, mnA, alA, pB0, pB1, alB, t + 1, 0, 1, 1);
    }
    const bool even = (NT & 1) == 0;
    if (even) { SBAR(); qkt<1, SK>(pB0, pB1, K_lds, r32, hi, S.qr, ACT(NT - 1), -beta * (float)(qm - KBASE(NT - 1)), beta); SBAR(); }
#define QROW(e) (nxt.Q + (size_t)(wid * QBLK + r32) * D + ((e) >> 1) * 16 + hi * 8 + ((e) & 1) * 4)
    if constexpr (F32) { SLOAD_F((const float*)nxt.K, kbn); SBAR();
#pragma unroll
        for (int e = 0; e < 8; ++e) S.tq[e] = *(const f32x4*)QROW(e); }
    else { SLOAD_H(nxt.K, nxt.V, nxt.pitch, kbn); SBAR();
#pragma unroll
        for (int d0 = 0; d0 < 8; ++d0) S.qr[d0] = load8<TIn>(nxt.Q + (size_t)(wid * QBLK + r32) * (size_t)nxt.pitch + d0 * 16 + hi * 8); }
    SBAR();
    finishSM(pA0, pA1, alA, l_reg, pa0, pa1, pa2, pa3); SBAR();
    if constexpr (F32) {
#pragma unroll
        for (int e = 8; e < 16; ++e) S.tq[e] = *(const f32x4*)QROW(e); SBAR(); }
#undef QROW
    pv_tile<0, SK>(o, vb0, pa0, pa1, pa2, pa3, ACT(even ? NT - 2 : NT - 1));
    if (even) { MASKT(pB0, pB1, NT - 1); partialSM(pB0, pB1, m_reg, mnB, alB); __syncthreads(); RESC(alB);
        finishSM(pB0, pB1, alB, l_reg, pa0, pa1, pa2, pa3); SBAR(); pv_tile<1, SK>(o, vb0, pa0, pa1, pa2, pa3, ACT(NT - 1)); }
    SBAR(); SEAM_K0();
    if (hi == 0) { li_l[r32] = l_reg; cur.L[(size_t)(wid * QBLK + r32) * (size_t)cur.lpitch] = m_reg * SCALE + __logf(l_reg); }
    asm volatile("s_waitcnt lgkmcnt(0)" ::: "memory");
    float rli[16];
#pragma unroll
    for (int r = 0; r < 16; ++r) rli[r] = __builtin_amdgcn_rcpf(li_l[crow(r, hi)]);
    TOut* Ow = cur.O + (size_t)(wid * QBLK) * (size_t)cur.opitch; const size_t opch = (size_t)cur.opitch;
    if constexpr (same_t<TOut, float>::v) {
#pragma unroll
        for (int r = 0; r < 16; ++r) { const int orow = crow(r, hi);
#pragma unroll
            for (int d0 = 0; d0 < 4; ++d0) Ow[(size_t)orow * opch + d0 * 32 + r32] = o[d0][r] * rli[r]; }
    } else {
        constexpr int EST = 72, ETILE = D * EST;
        char* T = lds + LDS_BYTES + wid * ETILE;
#pragma unroll
        for (int d0 = 0; d0 < 4; ++d0)
#pragma unroll
            for (int rr = 0; rr < 4; ++rr) { typedef unsigned u32x2 __attribute__((ext_vector_type(2))); u32x2 w;
                w.x = cvtpk(o[d0][4 * rr] * rli[4 * rr], o[d0][4 * rr + 1] * rli[4 * rr + 1]); w.y = cvtpk(o[d0][4 * rr + 2] * rli[4 * rr + 2], o[d0][4 * rr + 3] * rli[4 * rr + 3]);
                *(u32x2*)(T + (32 * d0 + r32) * EST + (8 * rr + 4 * hi) * 2) = w; }
        asm volatile("s_waitcnt lgkmcnt(0)" ::: "memory");
        { const int g = (lane >> 4) & 1, i16 = lane & 15, q = i16 >> 2, p = i16 & 3;
          const int abase = (int)(uintptr_t)T + (8 * hi + q) * EST + (16 * g + 4 * p) * 2;
          TOut* orow = Ow + (size_t)(16 * g + i16) * opch + 8 * hi;
#pragma unroll
          for (int t = 0; t < 8; ++t) { s16x4 lo, hh;
              asm volatile("ds_read_b64_tr_b16 %0, %1 offset:%2" : "=&v"(lo) : "v"(abase), "i"(16 * t * EST) : "memory");
              asm volatile("ds_read_b64_tr_b16 %0, %1 offset:%2" : "=&v"(hh) : "v"(abase), "i"(16 * t * EST + 4 * EST) : "memory");
              asm volatile("s_waitcnt lgkmcnt(0)" : "+v"(lo), "+v"(hh) :: "memory");
              const bf16x8 ov = {lo[0], lo[1], lo[2], lo[3], hh[0], hh[1], hh[2], hh[3]};
              *(bf16x8*)(orow + 16 * t) = ov; } }
    }
    if constexpr (F32) {
#pragma unroll
        for (int d0 = 0; d0 < 8; ++d0) S.qr[d0] = pack8(S.tq[2 * d0], S.tq[2 * d0 + 1]); }
    __syncthreads();
#undef RESC
#undef KBASE
#undef ACT
#undef MASKT
#undef SEAM_K0
#undef HALF_STEP
}
#undef ROW
#undef VMW
#undef VMWN
#undef SLOAD_H
#undef SWRITE_HK
#undef SWRITE_HV
#undef SWRITE_H
#undef SLOAD_F
#undef SWRITE_KF
#undef SWRITE_VF

#undef KSWZ
#undef SBAR
}

typedef unsigned short bf16;
typedef unsigned v4u __attribute__((ext_vector_type(4)));
typedef float f32x4 __attribute__((ext_vector_type(4)));
constexpr int D_MODEL = 4096, BATCH = 2, SEQ = 4096, DEPTH = 2, HEAD_DIM = 128, D_ATTN = 2048, D_SGU = 2048, NH = 16, NG = 16, CHUNK = 128;
constexpr int N_IN = 10240, D_FF = 11008, N_UP = 2 * D_FF, M_TOK = BATCH * SEQ;
constexpr float NORM_EPS = 1e-6f;
constexpr int ZQ = 0, ZK = 2048, ZV = 4096, ZU = 6144, ZV2 = 8192;
constexpr int NWAVES = 8, NTHREADS = 512;
constexpr int NQ8 = 8192;
constexpr int RING_BYTES = 131072, MISC_OFF = 140 * 1024, LDS_BYTES = 147456;
constexpr size_t MiB = 1u << 20;
constexpr size_t SZ_WIN = (size_t)N_IN * D_MODEL * 2, SZ_WOUT = (size_t)D_MODEL * D_MODEL * 2, SZ_WUP = (size_t)N_UP * D_MODEL * 2, SZ_WDN = (size_t)D_MODEL * D_FF * 2;
constexpr size_t OFF_CTL = 0, OFF_RS = 16384, RS_BYTES = (size_t)M_TOK * 8, CTL_BYTES = OFF_RS + 5 * RS_BYTES;
constexpr size_t OFF_WIN = 1 * MiB, OFF_WOUT = OFF_WIN + 2 * SZ_WIN, OFF_WUP = OFF_WOUT + 2 * SZ_WOUT, OFF_WDN = OFF_WUP + 2 * SZ_WUP, OFF_H = OFF_WDN + 2 * SZ_WDN;
constexpr size_t OFF_Z = OFF_H + (size_t)M_TOK * D_MODEL * 2, OFF_MX = OFF_Z + (size_t)M_TOK * N_IN * 2, OFF_UP = OFF_MX + (size_t)M_TOK * D_MODEL * 2;
constexpr size_t OFF_ACT = OFF_UP + (size_t)M_TOK * N_UP * 2, OFF_OC = OFF_ACT + (size_t)M_TOK * D_FF * 2, OFF_LSE = OFF_OC + (size_t)3 * M_TOK * D_ATTN * 2, OFF_U4 = OFF_LSE + (size_t)3 * M_TOK * NH * 4, OFF_SB = OFF_U4 + (size_t)(M_TOK / 64) * 4 * N_UP * 4, OFF_SA = OFF_SB + (size_t)DEPTH * N_UP * 4, OFF_XQ = OFF_SA + (size_t)M_TOK * 4, WS_END = OFF_XQ + (size_t)M_TOK * D_MODEL;
constexpr size_t OFF_WINQ = OFF_UP, OFF_SBIN = OFF_WINQ + (size_t)DEPTH * NQ8 * D_MODEL;
static_assert(OFF_SBIN + (size_t)DEPTH * NQ8 * 4 <= OFF_ACT, "int8 input-projection weights fit");
static_assert(CTL_BYTES <= OFF_WIN && XCD_BAR_WORDS * 4 <= OFF_RS, "barrier words inside the memset region");

__device__ __forceinline__ unsigned f2bf(float f) { unsigned u = __builtin_bit_cast(unsigned, f); return (u + 0x7fffu + ((u >> 16) & 1u)) >> 16; }
__device__ __forceinline__ unsigned pk2(float lo, float hi) { return f2bf(lo) | (f2bf(hi) << 16); }
__device__ __forceinline__ float bf2f(unsigned short b) { return __builtin_bit_cast(float, (unsigned)b << 16); }
__device__ __forceinline__ float bflo(unsigned w) { return __builtin_bit_cast(float, w << 16); }
__device__ __forceinline__ float bfhi(unsigned w) { return __builtin_bit_cast(float, w & 0xffff0000u); }
#define LDS_WAIT() asm volatile("s_waitcnt lgkmcnt(0)" ::: "memory")

constexpr int CVT_STRIDE = 192, CVT_TILE = 64 * CVT_STRIDE;
struct CvtRegs { f32x4 v[16]; };
__device__ __forceinline__ void cvt_item_kn(int item, int nblk, int kbw, int& kb, int& nb) { const int nbw = 32 / kbw, st = item >> 5, w = item & 31, nst = nblk / nbw; const int sk = st / nst, sn = st - sk * nst; kb = kbw * sk + (w % kbw); nb = nbw * sn + (w / kbw); }
__device__ __forceinline__ void cvt_load(CvtRegs& R, const float* W, int N, int item, int lane, int nblk, int kbw) {
    int kb, nb; cvt_item_kn(item, nblk, kbw, kb, nb); const float* p = W + (size_t)(64 * kb + (lane >> 4)) * N + 64 * nb + 4 * (lane & 15);
#pragma unroll
    for (int i = 0; i < 16; ++i) R.v[i] = *(const f32x4*)(p + (size_t)(4 * i) * N);
}
__device__ __forceinline__ void cvt_store(const CvtRegs& R, int K, int N, bf16* WT, LAS unsigned char* tile, int item, int lane, int nblk, int kbw, bool glu, const float* gk) {
    int kb, nb; cvt_item_kn(item, nblk, kbw, kb, nb); const int k0 = 64 * kb, n0 = 64 * nb;
    const int half = N / 2, r0 = glu ? ((n0 < half) ? 256 * (n0 >> 7) + (n0 & 127) : 256 * ((n0 - half) >> 7) + 128 + ((n0 - half) & 127)) : n0;
    { LAS unsigned char* wp = tile + (lane >> 4) * CVT_STRIDE + 8 * (lane & 15);
#pragma unroll
      for (int i = 0; i < 16; ++i) { const float gg = gk ? gk[k0 + 4 * i + (lane >> 4)] : 1.f; const f32x4 x = R.v[i] * gg;
          typedef unsigned u32x2 __attribute__((ext_vector_type(2))); u32x2 w; w.x = pk2(x.x, x.y); w.y = pk2(x.z, x.w); *(LAS u32x2*)(wp + 4 * i * CVT_STRIDE) = w; } }
    LDS_WAIT();
    { const int hh = lane >> 5, g = (lane >> 4) & 1, i16 = lane & 15, q = i16 >> 2, p = i16 & 3;
      const int abase = (int)(uintptr_t)tile + (8 * hh + q) * CVT_STRIDE + (16 * g + 4 * p) * 2;
      bf16* orow = WT + (size_t)(r0 + 16 * g + i16) * K + k0 + 8 * hh;
#pragma unroll
      for (int nb2 = 0; nb2 < 2; ++nb2)
#pragma unroll
          for (int t = 0; t < 4; ++t) { typedef short s16x4 __attribute__((ext_vector_type(4))); s16x4 lo, hi;
              asm volatile("ds_read_b64_tr_b16 %0, %1 offset:%2" : "=&v"(lo) : "v"(abase), "i"(16 * t * CVT_STRIDE + 64 * nb2) : "memory");
              asm volatile("ds_read_b64_tr_b16 %0, %1 offset:%2" : "=&v"(hi) : "v"(abase), "i"(16 * t * CVT_STRIDE + 4 * CVT_STRIDE + 64 * nb2) : "memory");
              asm volatile("s_waitcnt lgkmcnt(0)" : "+v"(lo), "+v"(hi) :: "memory");
              typedef short s16x8 __attribute__((ext_vector_type(8))); const s16x8 o = {lo[0], lo[1], lo[2], lo[3], hi[0], hi[1], hi[2], hi[3]};
              *(s16x8*)(orow + (size_t)(32 * nb2) * K + 16 * t) = o; } }
    LDS_WAIT();
}
__device__ __forceinline__ void phase_convert(const float* W, int K, int N, bf16* WT, LAS unsigned char* lds, int gw, int NGW, int wave, int lane, const float* gk, bool glu = false, int ld = 0) {
    LAS unsigned char* tile = lds + wave * CVT_TILE;
    const int nblk = N / 64, items = (K / 64) * nblk, kbw = ((K / 64) % 8 == 0) ? 8 : 4; if (ld == 0) ld = N;
    int it = gw; if (it >= items) return;
    CvtRegs A, B; cvt_load(A, W, ld, it, lane, nblk, kbw);
    for (;;) {
        const int it1 = it + NGW; const bool h1 = it1 < items; if (h1) cvt_load(B, W, ld, it1, lane, nblk, kbw);
        cvt_store(A, K, N, WT, tile, it, lane, nblk, kbw, glu, gk);
        if (!h1) break;
        const int it2 = it1 + NGW; const bool h2 = it2 < items; if (h2) cvt_load(A, W, ld, it2, lane, nblk, kbw);
        cvt_store(B, K, N, WT, tile, it1, lane, nblk, kbw, glu, gk);
        if (!h2) break;
        it = it2;
    }
}
__device__ __forceinline__ int glu_row(int n, int N) { const int half = N / 2; return (n < half) ? 256 * (n >> 7) + (n & 127) : 256 * ((n - half) >> 7) + 128 + ((n - half) & 127); }
constexpr int ST_STRIDE = 528, ST_TILE = 32 * ST_STRIDE, ST_RED = NWAVES * ST_TILE;
static_assert(ST_RED + 2048 <= MISC_OFF, "strip tiles below the control words");
__device__ __forceinline__ unsigned pkbf(float lo, float hi) { unsigned r; asm("v_cvt_pk_bf16_f32 %0, %1, %2" : "=v"(r) : "v"(lo), "v"(hi)); return r; }
__device__ __forceinline__ void strip8(const float* W, int N, int n0, int r0, const float* gk, signed char* WQ, float* sB, LAS unsigned char* lds, int par, int wave, int lane) {
    const int a = lane & 7, b = lane >> 3, kw = 512 * wave;
    const float* p = W + (size_t)(kw + 4 * b) * N + n0 + 4 * a;
    const float* gp = gk + kw + 4 * b;
    unsigned P[16][4][2];
    f32x4 mx = {0.f, 0.f, 0.f, 0.f};
    f32x4 S[2][8], Gn[2][2];
#define ST_LOAD(buf, bi) do { _Pragma("unroll") for (int q = 0; q < 8; ++q) S[buf][q] = *(const f32x4*)(p + (size_t)(32 * (2 * (bi) + (q >> 2)) + (q & 3)) * N); \
        Gn[buf][0] = *(const f32x4*)(gp + 64 * (bi)); Gn[buf][1] = *(const f32x4*)(gp + 64 * (bi) + 32); } while (0)
    ST_LOAD(0, 0);
#pragma unroll
    for (int bi = 0; bi < 8; ++bi) {
        if (bi < 7) { if (bi & 1) ST_LOAD(0, bi + 1); else ST_LOAD(1, bi + 1); }
        __builtin_amdgcn_sched_barrier(0);
#pragma unroll
        for (int mm = 0; mm < 2; ++mm) { const int m = 2 * bi + mm; f32x4 x[4];
#pragma unroll
            for (int c = 0; c < 4; ++c) { x[c] = S[bi & 1][4 * mm + c] * Gn[bi & 1][mm][c];
                mx.x = fmaxf(mx.x, fabsf(x[c].x)); mx.y = fmaxf(mx.y, fabsf(x[c].y)); mx.z = fmaxf(mx.z, fabsf(x[c].z)); mx.w = fmaxf(mx.w, fabsf(x[c].w)); }
#pragma unroll
            for (int e = 0; e < 4; ++e) { P[m][e][0] = pkbf(x[0][e], x[1][e]); P[m][e][1] = pkbf(x[2][e], x[3][e]); } }
        __builtin_amdgcn_sched_barrier(0);
    }
#undef ST_LOAD
    LAS float* red = (LAS float*)(lds + ST_RED + par * 1024);
#pragma unroll
    for (int e = 0; e < 4; ++e) { float v = mx[e]; v = fmaxf(v, lane_xor<8>(v)); v = fmaxf(v, lane_xor<16>(v)); float va = v, vb = v; half_swap(va, vb); mx[e] = fmaxf(va, vb); }
    if (b == 0) *(LAS f32x4*)(red + wave * 32 + 4 * a) = mx;
    __syncthreads();
    f32x4 cm = *(LAS f32x4*)(red + 4 * a);
#pragma unroll
    for (int w2 = 1; w2 < NWAVES; ++w2) { const f32x4 o = *(LAS f32x4*)(red + w2 * 32 + 4 * a); cm.x = fmaxf(cm.x, o.x); cm.y = fmaxf(cm.y, o.y); cm.z = fmaxf(cm.z, o.z); cm.w = fmaxf(cm.w, o.w); }
    f32x4 inv;
#pragma unroll
    for (int e = 0; e < 4; ++e) { cm[e] = bflo(pkbf(cm[e], cm[e])); inv[e] = cm[e] > 0.f ? 127.f / cm[e] : 0.f; }
    if (wave == 0 && b == 0) *(f32x4*)(sB + r0 + 4 * a) = cm * (1.f / 127.f);
    LAS unsigned char* tile = lds + wave * ST_TILE;
    { LAS unsigned char* wp = tile + (4 * a) * ST_STRIDE + 4 * b;
#pragma unroll
      for (int m = 0; m < 16; ++m)
#pragma unroll
          for (int e = 0; e < 4; ++e) { const unsigned w0 = P[m][e][0], w1 = P[m][e][1];
              const unsigned t0 = __builtin_bit_cast(unsigned, __builtin_fmaf(bflo(w0), inv[e], 12582912.f)), t1 = __builtin_bit_cast(unsigned, __builtin_fmaf(bfhi(w0), inv[e], 12582912.f));
              const unsigned t2 = __builtin_bit_cast(unsigned, __builtin_fmaf(bflo(w1), inv[e], 12582912.f)), t3 = __builtin_bit_cast(unsigned, __builtin_fmaf(bfhi(w1), inv[e], 12582912.f));
              *(LAS unsigned*)(wp + e * ST_STRIDE + 32 * m) = __builtin_amdgcn_perm(t1, t0, 0x0c0c0400u) | __builtin_amdgcn_perm(t3, t2, 0x04000c0cu); } }
    LDS_WAIT();
    { signed char* orow = WQ + (size_t)(r0 + (lane >> 5)) * D_MODEL + kw + 16 * (lane & 31); LAS unsigned char* rp = tile + (lane >> 5) * ST_STRIDE + 16 * (lane & 31);
#pragma unroll
      for (int i = 0; i < 16; ++i) { const v4u v = *(LAS v4u*)(rp + 2 * i * ST_STRIDE); *(v4u*)(orow + (size_t)(2 * i) * D_MODEL) = v; } }
    LDS_WAIT();
}
__device__ __forceinline__ void phase_strips8(const float* Wup, const float* gup, signed char* WQup, float* sBup, const float* Win, const float* gin, signed char* WQin, float* sBin, LAS unsigned char* lds, int blk, int G, int wave, int lane) {
    constexpr int SPL = N_UP / 32, SPI = NQ8 / 32;
    int par = 0;
    for (int s = blk; s < DEPTH * (SPL + SPI); s += G, par ^= 1) {
        if (s < DEPTH * SPL) { const int cl = s >= SPL ? 1 : 0, n0 = 32 * (s - cl * SPL);
            strip8(Wup + (size_t)cl * D_MODEL * N_UP, N_UP, n0, glu_row(n0, N_UP), gup + (size_t)cl * D_MODEL, WQup + (size_t)cl * N_UP * D_MODEL, sBup + (size_t)cl * N_UP, lds, par, wave, lane); }
        else { const int s2 = s - DEPTH * SPL, cl = s2 >= SPI ? 1 : 0, n0 = 32 * (s2 - cl * SPI);
            strip8(Win + (size_t)cl * D_MODEL * N_IN, N_IN, n0, n0, gin + (size_t)cl * D_MODEL, WQin + (size_t)cl * NQ8 * D_MODEL, sBin + (size_t)cl * NQ8, lds, par, wave, lane); }
    }
}
__device__ __forceinline__ void phase_quant_rows(const bf16* xb, signed char* xq, float* sA, int gw, int NGW, int lane) {
    for (int row = gw; row < M_TOK; row += NGW) {
        const v4u* xr = (const v4u*)(xb + (size_t)row * D_MODEL) + lane; v4u x[8]; float mx = 0.f;
#pragma unroll
        for (int j = 0; j < 8; ++j) { x[j] = xr[64 * j]; const unsigned* w = (const unsigned*)&x[j];
#pragma unroll
            for (int e = 0; e < 4; ++e) mx = fmaxf(mx, fmaxf(fabsf(bflo(w[e])), fabsf(bfhi(w[e])))); }
        mx = fmaxf(mx, lane_xor<1>(mx)); mx = fmaxf(mx, lane_xor<2>(mx)); mx = fmaxf(mx, lane_xor<4>(mx)); mx = fmaxf(mx, lane_xor<8>(mx)); mx = fmaxf(mx, lane_xor<16>(mx));
        { float ma = mx, mb = mx; half_swap(ma, mb); mx = fmaxf(ma, mb); }
        const float inv = mx > 0.f ? 127.f / mx : 0.f;
        if (lane == 0) sA[row] = mx * (1.f / 127.f);
        unsigned long long* o8 = (unsigned long long*)(xq + (size_t)row * D_MODEL) + lane;
#pragma unroll
        for (int j = 0; j < 8; ++j) { const unsigned* w = (const unsigned*)&x[j]; unsigned long long pk = 0ull;
#pragma unroll
            for (int e = 0; e < 4; ++e) { const int q0 = (int)__builtin_rintf(bflo(w[e]) * inv), q1 = (int)__builtin_rintf(bfhi(w[e]) * inv);
                pk |= (unsigned long long)(((unsigned)q0 & 0xffu) | (((unsigned)q1 & 0xffu) << 8)) << (16 * e); }
            o8[64 * j] = pk; }
    }
}
__device__ __forceinline__ void phase_xprep(const float* x, bf16* xb, unsigned long long* rowss, signed char* xq, float* sA, int gw, int NGW, int lane) {
    for (int row = gw; row < M_TOK; row += NGW) {
        const f32x4* xr = (const f32x4*)(x + (size_t)row * D_MODEL) + lane; float s = 0.f, mx = 0.f; unsigned w[16][2];
#pragma unroll
        for (int j = 0; j < 16; ++j) { const f32x4 v = xr[64 * j]; s += (v.x * v.x + v.y * v.y) + (v.z * v.z + v.w * v.w);
            w[j][0] = pk2(v.x, v.y); w[j][1] = pk2(v.z, v.w);
            mx = fmaxf(fmaxf(mx, fmaxf(fabsf(bflo(w[j][0])), fabsf(bfhi(w[j][0])))), fmaxf(fabsf(bflo(w[j][1])), fabsf(bfhi(w[j][1]))));
            unsigned long long* o8 = (unsigned long long*)(xb + (size_t)row * D_MODEL) + lane + 64 * j; *o8 = (unsigned long long)w[j][0] | ((unsigned long long)w[j][1] << 32); }
        s = wave_sum(s);
        if (lane == 0) rowss[row] = (unsigned long long)(long long)__builtin_rintf(s * 16777216.f);
        mx = fmaxf(mx, lane_xor<1>(mx)); mx = fmaxf(mx, lane_xor<2>(mx)); mx = fmaxf(mx, lane_xor<4>(mx)); mx = fmaxf(mx, lane_xor<8>(mx)); mx = fmaxf(mx, lane_xor<16>(mx));
        { float ma = mx, mb = mx; half_swap(ma, mb); mx = fmaxf(ma, mb); }
        const float inv = mx > 0.f ? 127.f / mx : 0.f;
        if (lane == 0) sA[row] = mx * (1.f / 127.f);
        unsigned* o4 = (unsigned*)(xq + (size_t)row * D_MODEL) + lane;
#pragma unroll
        for (int j = 0; j < 16; ++j) { const int q0 = (int)__builtin_rintf(bflo(w[j][0]) * inv), q1 = (int)__builtin_rintf(bfhi(w[j][0]) * inv), q2 = (int)__builtin_rintf(bflo(w[j][1]) * inv), q3 = (int)__builtin_rintf(bfhi(w[j][1]) * inv);
            o4[64 * j] = ((unsigned)q0 & 0xffu) | (((unsigned)q1 & 0xffu) << 8) | (((unsigned)q2 & 0xffu) << 16) | ((unsigned)q3 << 24); }
    }
}
__device__ __forceinline__ void phase_final(const bf16* xb, float* out, const unsigned long long* rowss, const float* g, int gw, int NGW, int lane) {
    for (int row = gw; row < M_TOK; row += NGW) {
        const float rstd = rsqrtf((float)rowss[row] * (1.f / (16777216.f * D_MODEL)) + NORM_EPS);
        const v4u* xr = (const v4u*)(xb + (size_t)row * D_MODEL) + lane; f32x4* orow = (f32x4*)(out + (size_t)row * D_MODEL); const f32x4* gr = (const f32x4*)g;
        v4u x[8];
#pragma unroll
        for (int j = 0; j < 8; ++j) x[j] = xr[64 * j];
#pragma unroll
        for (int j = 0; j < 8; ++j) { const int c4 = 2 * (lane + 64 * j);
            const f32x4 ga = gr[c4], gb = gr[c4 + 1];
            orow[c4] = (f32x4){bflo(x[j].x) * rstd * ga.x, bfhi(x[j].x) * rstd * ga.y, bflo(x[j].y) * rstd * ga.z, bfhi(x[j].y) * rstd * ga.w};
            orow[c4 + 1] = (f32x4){bflo(x[j].z) * rstd * gb.x, bfhi(x[j].z) * rstd * gb.y, bflo(x[j].w) * rstd * gb.z, bfhi(x[j].w) * rstd * gb.w}; }
    }
}
constexpr int SGU_STRIDE = 320, SGU_SLOT = CHUNK * SGU_STRIDE;
typedef short sg_bf16x8 __attribute__((ext_vector_type(8)));
typedef short sg_s16x4 __attribute__((ext_vector_type(4)));
typedef float sg_f32x16 __attribute__((ext_vector_type(16)));
__device__ __forceinline__ void phase_sgu(const bf16* Z, const float* sgug, const float* Ws, const float* bs, const float* mixg, bf16* Mx, LAS unsigned char* lds, int blk, int G, int tid, int wv) {
    const int lane = tid & 63, h = lane >> 5, l31 = lane & 31;
    const int uh = wv >> 2, tt = wv & 3;
    const int srow = tid >> 2, sq = tid & 3;
    for (int wq = blk; wq < 256; wq += G) {
        const int g = wq & 15, cq = wq >> 4;
        sg_bf16x8 wf[8];
        { const int t = 32 * tt + l31; const float* wrow = Ws + ((size_t)g * CHUNK + t) * CHUNK;
#pragma unroll
          for (int ks = 0; ks < 8; ++ks) { wf[ks] = sg_bf16x8{0, 0, 0, 0, 0, 0, 0, 0};
              if (ks <= 2 * tt + 1) { const int s0 = 16 * ks + 8 * h; const f32x4 a = *(const f32x4*)(wrow + s0), b = *(const f32x4*)(wrow + s0 + 4);
                  float v[8] = {a.x, a.y, a.z, a.w, b.x, b.y, b.z, b.w};
#pragma unroll
                  for (int e = 0; e < 8; ++e) v[e] = (s0 + e <= t) ? v[e] : 0.f;
                  v4u pk; pk.x = pk2(v[0], v[1]); pk.y = pk2(v[2], v[3]); pk.z = pk2(v[4], v[5]); pk.w = pk2(v[6], v[7]); wf[ks] = __builtin_bit_cast(sg_bf16x8, pk); } } }
        const float bias_t = bs[g * CHUNK + 32 * tt + l31];
        f32x4 sgv[8];
#pragma unroll
        for (int e = 0; e < 8; ++e) sgv[e] = *(const f32x4*)(sgug + g * 128 + sq * 32 + 4 * e);
        for (int rnd = 0; rnd < 2; ++rnd) {
            uint2 uu[4][4];
            { const bf16* up0 = Z + (size_t)((4 * cq + 2 * rnd + uh) * CHUNK + 32 * tt + l31) * N_IN + ZU + g * 128 + 4 * h;
#pragma unroll
              for (int ct = 0; ct < 4; ++ct)
#pragma unroll
                  for (int rq = 0; rq < 4; ++rq) uu[ct][rq] = *(const uint2*)(up0 + 32 * ct + 8 * rq); }
#pragma unroll
            for (int ub = 0; ub < 2; ++ub) { const int row0 = (4 * cq + 2 * rnd + ub) * CHUNK;
                const v4u* vp = (const v4u*)(Z + (size_t)(row0 + srow) * N_IN + ZV2 + g * 128 + sq * 32);
                v4u raw[4]; float x[32]; float ss = 0.f;
#pragma unroll
                for (int e = 0; e < 4; ++e) raw[e] = vp[e];
#pragma unroll
                for (int e = 0; e < 4; ++e) { x[8 * e + 0] = bflo(raw[e].x); x[8 * e + 1] = bfhi(raw[e].x); x[8 * e + 2] = bflo(raw[e].y); x[8 * e + 3] = bfhi(raw[e].y);
                    x[8 * e + 4] = bflo(raw[e].z); x[8 * e + 5] = bfhi(raw[e].z); x[8 * e + 6] = bflo(raw[e].w); x[8 * e + 7] = bfhi(raw[e].w); }
#pragma unroll
                for (int e = 0; e < 32; ++e) ss += x[e] * x[e];
                ss += lane_xor<1>(ss); ss += lane_xor<2>(ss);
                const float rstd = rsqrtf(ss * (1.f / 128.f) + NORM_EPS);
                LAS v4u* dst = (LAS v4u*)(lds + ub * SGU_SLOT + srow * SGU_STRIDE + sq * 64);
#pragma unroll
                for (int e = 0; e < 4; ++e) { v4u o; const f32x4 s0 = sgv[2 * e], s1 = sgv[2 * e + 1];
                    o.x = pk2(x[8 * e + 0] * rstd * s0.x, x[8 * e + 1] * rstd * s0.y); o.y = pk2(x[8 * e + 2] * rstd * s0.z, x[8 * e + 3] * rstd * s0.w);
                    o.z = pk2(x[8 * e + 4] * rstd * s1.x, x[8 * e + 5] * rstd * s1.y); o.w = pk2(x[8 * e + 6] * rstd * s1.z, x[8 * e + 7] * rstd * s1.w); dst[e] = o; } }
            __syncthreads();
            sg_f32x16 acc[4];
#pragma unroll
            for (int ct = 0; ct < 4; ++ct) acc[ct] = sg_f32x16{};
            { const int g4 = lane >> 4, i16 = lane & 15, q = i16 >> 2, p = i16 & 3;
              const int abase = (int)(uintptr_t)(lds + uh * SGU_SLOT) + (8 * h + q) * SGU_STRIDE + (16 * (g4 & 1) + 4 * p) * 2;
#pragma unroll
              for (int ks = 0; ks < 8; ++ks) {
                  if (ks <= 2 * tt + 1) {
#pragma unroll
                      for (int ct = 0; ct < 4; ++ct) { sg_s16x4 lo, hi;
                          asm volatile("ds_read_b64_tr_b16 %0, %1 offset:%2" : "=&v"(lo) : "v"(abase), "i"(16 * ks * SGU_STRIDE + ct * 64) : "memory");
                          asm volatile("ds_read_b64_tr_b16 %0, %1 offset:%2" : "=&v"(hi) : "v"(abase), "i"(16 * ks * SGU_STRIDE + 4 * SGU_STRIDE + ct * 64) : "memory");
                          asm volatile("s_waitcnt lgkmcnt(0)" ::: "memory"); __builtin_amdgcn_sched_barrier(0);
                          acc[ct] = __builtin_amdgcn_mfma_f32_32x32x16_bf16((sg_bf16x8){lo[0], lo[1], lo[2], lo[3], hi[0], hi[1], hi[2], hi[3]}, wf[ks], acc[ct], 0, 0, 0); } } } }
            { const int row = (4 * cq + 2 * rnd + uh) * CHUNK + 32 * tt + l31;
              const float* mg = mixg + D_ATTN + g * 128 + 4 * h;
              float ss = 0.f;
#pragma unroll
              for (int ct = 0; ct < 4; ++ct)
#pragma unroll
                  for (int rq = 0; rq < 4; ++rq) { const uint2 uv = uu[ct][rq];
                      const float u0 = bflo(uv.x), u1 = bfhi(uv.x), u2 = bflo(uv.y), u3 = bfhi(uv.y);
                      float o0 = u0 * (acc[ct][4 * rq + 0] + bias_t), o1 = u1 * (acc[ct][4 * rq + 1] + bias_t), o2 = u2 * (acc[ct][4 * rq + 2] + bias_t), o3 = u3 * (acc[ct][4 * rq + 3] + bias_t);
                      acc[ct][4 * rq + 0] = o0; acc[ct][4 * rq + 1] = o1; acc[ct][4 * rq + 2] = o2; acc[ct][4 * rq + 3] = o3; ss += (o0 * o0 + o1 * o1) + (o2 * o2 + o3 * o3); }
              { float sa = ss, sb = ss; half_swap(sa, sb); ss = sa + sb; }
              const float rstd = rsqrtf(ss * (1.f / 128.f) + NORM_EPS);
              bf16* op = Mx + (size_t)row * D_MODEL + D_ATTN + g * 128 + 4 * h;
#pragma unroll
              for (int ct = 0; ct < 4; ++ct)
#pragma unroll
                  for (int rq = 0; rq < 4; ++rq) { const f32x4 mm = *(const f32x4*)(mg + 32 * ct + 8 * rq);
                      uint2 w; w.x = pk2(acc[ct][4 * rq + 0] * rstd * mm.x, acc[ct][4 * rq + 1] * rstd * mm.y); w.y = pk2(acc[ct][4 * rq + 2] * rstd * mm.z, acc[ct][4 * rq + 3] * rstd * mm.w);
                      *(uint2*)(op + 32 * ct + 8 * rq) = w; } }
            __syncthreads();
        }
    }
}
__device__ __forceinline__ void phase_convfix(const float* U4, const float* cw, const float* cb, bf16* ACT, size_t gtid, size_t nthreads) {
    constexpr int per_row = D_FF / 8, NB = M_TOK / 64; const size_t total = (size_t)NB * per_row;
    for (size_t i = gtid; i < total; i += nthreads) {
        const int blk64 = (int)(i / per_row), c = (int)(i % per_row) * 8;
        if ((blk64 & (SEQ / 64 - 1)) == 0) continue;
        const float* um2 = U4 + ((size_t)(blk64 - 1) * 4 + 2) * N_UP; const float* um1 = um2 + N_UP; const float* u0 = U4 + (size_t)blk64 * 4 * N_UP; const float* u1 = u0 + N_UP;
        float y0[2][8], y1[2][8];
#pragma unroll
        for (int hv = 0; hv < 2; ++hv)
#pragma unroll
            for (int q = 0; q < 2; ++q) { const int cc = hv * D_FF + c + 4 * q;
                const f32x4 a = *(const f32x4*)(um2 + cc), b = *(const f32x4*)(um1 + cc), x0 = *(const f32x4*)(u0 + cc), x1 = *(const f32x4*)(u1 + cc);
                const f32x4 w0 = *(const f32x4*)(cw + cc), w1 = *(const f32x4*)(cw + N_UP + cc), w2 = *(const f32x4*)(cw + 2 * N_UP + cc), bb = *(const f32x4*)(cb + cc);
#pragma unroll
                for (int e = 0; e < 4; ++e) { y0[hv][4 * q + e] = fmaf(w0[e], a[e], fmaf(w1[e], b[e], fmaf(w2[e], x0[e], bb[e]))); y1[hv][4 * q + e] = fmaf(w0[e], b[e], fmaf(w1[e], x0[e], fmaf(w2[e], x1[e], bb[e]))); } }
        float r0[8], r1[8];
#pragma unroll
        for (int e = 0; e < 8; ++e) { const float g0 = y0[0][e], g1 = y1[0][e]; r0[e] = g0 / (1.f + __expf(-g0)) * y0[1][e]; r1[e] = g1 / (1.f + __expf(-g1)) * y1[1][e]; }
        v4u o; o.x = pk2(r0[0], r0[1]); o.y = pk2(r0[2], r0[3]); o.z = pk2(r0[4], r0[5]); o.w = pk2(r0[6], r0[7]);
        *(v4u*)(ACT + (size_t)(blk64 * 64) * D_FF + c) = o;
        o.x = pk2(r1[0], r1[1]); o.y = pk2(r1[2], r1[3]); o.z = pk2(r1[4], r1[5]); o.w = pk2(r1[6], r1[7]);
        *(v4u*)(ACT + (size_t)(blk64 * 64 + 1) * D_FF + c) = o;
    }
}
typedef attn::BlockRef<bf16, bf16> ABlock;
__device__ __forceinline__ ABlock attn_ref(int L, const bf16* Z, bf16* OC, float* LSE) {
    const int c = L >> 9, x = L & 511; const int bh = (x & 7) + 8 * ((x >> 3) & 3), bi = x >> 5;
    const int d = (c == 0) ? 1 : ((c == 1) ? 4 : 16);
    const int r = (c == 0) ? 0 : ((c == 1) ? (bi >> 2) : bi), qb = (c == 0) ? bi : ((c == 1) ? (bi & 3) : 0);
    const int b = bh >> 4, h = bh & 15; const int P0 = qb * attn::QB;
    const size_t row0 = (size_t)b * SEQ + r, rowq = row0 + (size_t)P0 * d;
    ABlock R;
    R.Q = Z + rowq * N_IN + ZQ + h * HEAD_DIM; R.K = Z + row0 * N_IN + ZK + h * HEAD_DIM; R.V = Z + row0 * N_IN + ZV + h * HEAD_DIM;
    R.O = OC + (size_t)c * M_TOK * D_ATTN + rowq * D_ATTN + h * HEAD_DIM; R.L = LSE + (size_t)c * M_TOK * NH + rowq * NH + h;
    R.P0 = P0; R.pitch = d * N_IN; R.opitch = d * D_ATTN; R.lpitch = d * NH;
    { const int j2 = 6 - h + ((c == 0) ? 0 : ((c == 1) ? 4 : 8)); const int n = j2 >> 1;
      R.beta = __builtin_bit_cast(float, (unsigned)(((127 + n) << 23) | ((j2 & 1) ? 0x3504F3 : 0))); }
    return R;
}
__device__ __forceinline__ int attn_skv(int L) { return (L < 512) ? SEQ : ((L < 1024) ? SEQ / 4 : SEQ / 16); }
__device__ __forceinline__ void phase_attn(const bf16* Z, bf16* OC, float* LSE, char* lds, int blk, int G, const int wv) {
    constexpr int TOTAL = 3 * 512, W = 129;
    int L = blk; if (L >= TOTAL) return;
    ABlock cur = attn_ref(L, Z, OC, LSE);
    attn::Seam<bf16> S;
    attn::causal_swa_prime<bf16, bf16>(cur, W, lds, S, wv);
    for (;;) {
        const int Ln = L + G; const bool last = Ln >= TOTAL;
        const ABlock nxt = last ? cur : attn_ref(Ln, Z, OC, LSE);
        attn::causal_swa_block<bf16, bf16>(cur, nxt, attn_skv(L), W, lds, S, wv);
        if (last) break;
        cur = nxt; L = Ln;
    }
}
__device__ __forceinline__ void phase_combine(const bf16* OC, const float* LSE, const float* mixg, bf16* Mx, int gw, int NGW, int lane) {
    const int hq = gw & 3, h = hq * 4 + (lane >> 4), col = h * HEAD_DIM + 8 * (lane & 15);
    const f32x4 g0 = *(const f32x4*)(mixg + col), g1 = *(const f32x4*)(mixg + col + 4);
    constexpr size_t SO = (size_t)M_TOK * D_ATTN, SL = (size_t)M_TOK * NH;
    for (int row = gw >> 2; row < M_TOK; row += 2 * (NGW >> 2)) {
        const int row2 = row + (NGW >> 2); const bool two = row2 < M_TOK; const int rb = two ? row2 : row;
        v4u a[2][3]; float ls[2][3];
#pragma unroll
        for (int u = 0; u < 2; ++u) { const int r = u ? rb : row;
#pragma unroll
            for (int c = 0; c < 3; ++c) { a[u][c] = *(const v4u*)(OC + c * SO + (size_t)r * D_ATTN + col); ls[u][c] = LSE[c * SL + (size_t)r * NH + h]; } }
#pragma unroll
        for (int u = 0; u < 2; ++u) { const int r = u ? rb : row;
            const float mx = fmaxf(ls[u][0], fmaxf(ls[u][1], ls[u][2])); float w0 = __expf(ls[u][0] - mx), w1 = __expf(ls[u][1] - mx), w2 = __expf(ls[u][2] - mx); const float inv = 1.f / (w0 + w1 + w2);
            w0 *= inv; w1 *= inv; w2 *= inv;
            float o[8]; const unsigned* pa = (const unsigned*)&a[u][0]; const unsigned* pb = (const unsigned*)&a[u][1]; const unsigned* pc = (const unsigned*)&a[u][2]; float ss = 0.f;
#pragma unroll
            for (int e = 0; e < 4; ++e) { o[2 * e] = w0 * bflo(pa[e]) + w1 * bflo(pb[e]) + w2 * bflo(pc[e]); o[2 * e + 1] = w0 * bfhi(pa[e]) + w1 * bfhi(pb[e]) + w2 * bfhi(pc[e]); ss += o[2 * e] * o[2 * e] + o[2 * e + 1] * o[2 * e + 1]; }
            ss += lane_xor<1>(ss); ss += lane_xor<2>(ss); ss += lane_xor<4>(ss); ss += lane_xor<8>(ss);
            const float rstd = rsqrtf(ss * (1.f / HEAD_DIM) + NORM_EPS);
            v4u w; w.x = pk2(o[0] * rstd * g0.x, o[1] * rstd * g0.y); w.y = pk2(o[2] * rstd * g0.z, o[3] * rstd * g0.w); w.z = pk2(o[4] * rstd * g1.x, o[5] * rstd * g1.y); w.w = pk2(o[6] * rstd * g1.z, o[7] * rstd * g1.w);
            if (u == 0 || two) *(v4u*)(Mx + (size_t)r * D_MODEL + col) = w; }
    }
}

struct Args { const float* in[14]; float* out; unsigned char* ws; };
typedef const __attribute__((address_space(4))) Args* KArgs;
__global__ void __launch_bounds__(NTHREADS, 2) mega_fwd(Args args) {
    extern __shared__ __attribute__((aligned(16))) unsigned char lds_raw[];
    LAS unsigned char* lds = (LAS unsigned char*)lds_raw;
    volatile LAS unsigned* MISC = (volatile LAS unsigned*)(lds + MISC_OFF);
    const int wv = __builtin_amdgcn_readfirstlane((int)(threadIdx.x >> 6));
    { const int t0 = tid_of(wv); if (t0 < 32) MISC[t0] = 0u; }
    __syncthreads();
#define PHASE_BEGIN() KArgs ka = (KArgs)__builtin_amdgcn_kernarg_segment_ptr(); asm volatile("" : "+s"(ka)); unsigned char* const ws = ka->ws; int wvp = wv; asm volatile("" : "+s"(wvp)); \
    const int tid = tid_of(wvp); const int lane = tid & 63, wave = wvp; int blk_o = blockIdx.x; asm volatile("" : "+s"(blk_o)); int lyr = l; asm volatile("" : "+s"(lyr)); \
    const int G = gridDim.x, blk = blk_o, gw = blk * NWAVES + wave, NGW = G * NWAVES; (void)lane; (void)gw; (void)NGW; (void)blk; (void)G; (void)tid; (void)ws; (void)lyr
#define WSP(T, off) ((T*)(ws + (off)))
#define GRID_BARRIER() do { KArgs kb = (KArgs)__builtin_amdgcn_kernarg_segment_ptr(); asm volatile("" : "+s"(kb)); XcdBarrier bar; bar.bar = (unsigned*)(kb->ws + OFF_CTL); bar.x = xcc; bar.st = MISC + 8; xcd_barrier(bar, wv); } while (0)
    const unsigned xcc = xcd_barrier_post((unsigned*)(args.ws + OFF_CTL), MISC + 8, wv).x;

    { const int l = 0; PHASE_BEGIN();
      phase_xprep(ka->in[0], WSP(bf16, OFF_H), WSP(unsigned long long, OFF_RS), WSP(signed char, OFF_XQ), WSP(float, OFF_SA), gw, NGW, lane);
      phase_strips8(ka->in[9], ka->in[8], WSP(signed char, OFF_WUP), WSP(float, OFF_SB), ka->in[2], ka->in[1], WSP(signed char, OFF_WINQ), WSP(float, OFF_SBIN), lds, blk, G, wave, lane); }
    __syncthreads();
    { const int l = 0; PHASE_BEGIN();
      for (int cl = 0; cl < DEPTH; ++cl) {
        phase_convert(ka->in[2] + (size_t)cl * D_MODEL * N_IN + NQ8, D_MODEL, N_IN - NQ8, WSP(bf16, OFF_WIN) + (size_t)cl * N_IN * D_MODEL + (size_t)NQ8 * D_MODEL, lds, gw, NGW, wave, lane, ka->in[1] + (size_t)cl * D_MODEL, false, N_IN);
        phase_convert(ka->in[7] + (size_t)cl * D_MODEL * D_MODEL, D_MODEL, D_MODEL, WSP(bf16, OFF_WOUT) + (size_t)cl * D_MODEL * D_MODEL, lds, gw, NGW, wave, lane, nullptr);
        phase_convert(ka->in[12] + (size_t)cl * D_FF * D_MODEL, D_FF, D_MODEL, WSP(bf16, OFF_WDN) + (size_t)cl * D_MODEL * D_FF, lds, gw, NGW, wave, lane, nullptr);
      } }
    GRID_BARRIER();

    for (int l = 0; l < DEPTH; ++l) {
        { PHASE_BEGIN();
          pg8::Gemm g{(const bf16*)WSP(signed char, OFF_XQ), (const bf16*)(WSP(signed char, OFF_WINQ) + (size_t)lyr * NQ8 * D_MODEL), M_TOK, NQ8, D_MODEL / 2}; pg8::StaticOrder S; S.init(M_TOK, NQ8, G, blk);
          pg8::EpiIn8 E{pg8::EpiIn{WSP(bf16, OFF_Z), (long)N_IN, 24, WSP(unsigned long long, OFF_RS) + (size_t)(2 * lyr) * M_TOK, 1.f / (16777216.f * D_MODEL), NORM_EPS}, WSP(float, OFF_SA), WSP(float, OFF_SBIN) + (size_t)lyr * NQ8};
          pg8::gemm_phase<pg8::EpiIn8, pg8::StaticOrder, true, true>(lds, g, S, E, wvp); }
        __syncthreads();
        { PHASE_BEGIN();
          pg8::Gemm g{WSP(bf16, OFF_H), WSP(bf16, OFF_WIN) + (size_t)lyr * N_IN * D_MODEL + (size_t)NQ8 * D_MODEL, M_TOK, N_IN - NQ8, D_MODEL}; pg8::StaticOrder S; S.init(M_TOK, N_IN - NQ8, G, blk);
          pg8::EpiIn E{WSP(bf16, OFF_Z) + NQ8, (long)N_IN, 24 - NQ8 / 256, WSP(unsigned long long, OFF_RS) + (size_t)(2 * lyr) * M_TOK, 1.f / (16777216.f * D_MODEL), NORM_EPS};
          pg8::gemm_phase<pg8::EpiIn, pg8::StaticOrder, true, true>(lds, g, S, E, wvp); }
        GRID_BARRIER();
        { PHASE_BEGIN();
          phase_attn(WSP(bf16, OFF_Z), WSP(bf16, OFF_OC), WSP(float, OFF_LSE), (char*)lds_raw, blk, G, wvp); }
        __syncthreads();
        { PHASE_BEGIN();
          phase_sgu(WSP(bf16, OFF_Z), ka->in[3] + (size_t)lyr * D_SGU, ka->in[4] + (size_t)lyr * NG * CHUNK * CHUNK, ka->in[5] + (size_t)lyr * NG * CHUNK, ka->in[6] + (size_t)lyr * D_MODEL, WSP(bf16, OFF_MX), lds, blk, G, tid, wvp); }
        GRID_BARRIER();
        { PHASE_BEGIN(); phase_combine(WSP(bf16, OFF_OC), WSP(float, OFF_LSE), ka->in[6] + (size_t)lyr * D_MODEL, WSP(bf16, OFF_MX), gw, NGW, lane); }
        GRID_BARRIER();
        { PHASE_BEGIN();
          pg8::Gemm g{WSP(bf16, OFF_MX), WSP(bf16, OFF_WOUT) + (size_t)lyr * D_MODEL * D_MODEL, M_TOK, D_MODEL, D_MODEL}; pg8::StaticOrder S; S.init(M_TOK, D_MODEL, G, blk);
          pg8::EpiRes E{WSP(bf16, OFF_H), WSP(unsigned long long, OFF_RS) + (size_t)(2 * lyr + 1) * M_TOK, (long)D_MODEL};
          pg8::gemm_phase<pg8::EpiRes, pg8::StaticOrder, true, true>(lds, g, S, E, wvp); }
        GRID_BARRIER();
        { PHASE_BEGIN(); phase_quant_rows(WSP(bf16, OFF_H), WSP(signed char, OFF_XQ), WSP(float, OFF_SA), gw, NGW, lane); }
        GRID_BARRIER();
        { PHASE_BEGIN();
          pg8::Gemm g{(const bf16*)WSP(signed char, OFF_XQ), (const bf16*)(WSP(signed char, OFF_WUP) + (size_t)lyr * N_UP * D_MODEL), M_TOK, N_UP, D_MODEL / 2}; pg8::StaticOrder S; S.init(M_TOK, N_UP, G, blk);
          pg8::EpiConv8 E{pg8::EpiConv{WSP(bf16, OFF_ACT), WSP(float, OFF_U4), ka->in[10] + (size_t)lyr * 3 * N_UP, ka->in[11] + (size_t)lyr * N_UP, (long)D_FF, WSP(unsigned long long, OFF_RS) + (size_t)(2 * lyr + 1) * M_TOK, 1.f / (16777216.f * D_MODEL), NORM_EPS},
                            WSP(float, OFF_SA), WSP(float, OFF_SB) + (size_t)lyr * N_UP};
          pg8::gemm_phase<pg8::EpiConv8, pg8::StaticOrder, true, true>(lds, g, S, E, wvp); }
        GRID_BARRIER();
        { PHASE_BEGIN(); phase_convfix(WSP(float, OFF_U4), ka->in[10] + (size_t)lyr * 3 * N_UP, ka->in[11] + (size_t)lyr * N_UP, WSP(bf16, OFF_ACT), (size_t)blk * NTHREADS + tid, (size_t)G * NTHREADS); }
        GRID_BARRIER();
        { PHASE_BEGIN();
          pg8::Gemm g{WSP(bf16, OFF_ACT), WSP(bf16, OFF_WDN) + (size_t)lyr * D_MODEL * D_FF, M_TOK, D_MODEL, D_FF}; pg8::StaticOrder S; S.init(M_TOK, D_MODEL, G, blk);
          pg8::EpiRes E{WSP(bf16, OFF_H), WSP(unsigned long long, OFF_RS) + (size_t)(2 * lyr + 2) * M_TOK, (long)D_MODEL};
          pg8::gemm_phase<pg8::EpiRes, pg8::StaticOrder, true, true>(lds, g, S, E, wvp); }
        GRID_BARRIER();
        if (l + 1 < DEPTH) {
            { PHASE_BEGIN(); phase_quant_rows(WSP(bf16, OFF_H), WSP(signed char, OFF_XQ), WSP(float, OFF_SA), gw, NGW, lane); }
            GRID_BARRIER();
        }
    }
    { const int l = 0; PHASE_BEGIN(); phase_final(WSP(bf16, OFF_H), ka->out, WSP(unsigned long long, OFF_RS) + (size_t)(2 * DEPTH) * M_TOK, ka->in[13], gw, NGW, lane); }
#undef PHASE_BEGIN
#undef WSP
#undef GRID_BARRIER
}

extern "C" void kernel_launch(void* const* d_in, const int* in_sizes, int n_in, void* d_out, int out_size, void* d_ws, size_t ws_size, hipStream_t stream) {
    static int grid = 0;
    if (grid == 0) {
        if (n_in != 14 || out_size != M_TOK * D_MODEL || ws_size < WS_END) { fprintf(stderr, "kernel_launch: unexpected shapes (n_in %d out %d ws %zu need %zu)\n", n_in, out_size, ws_size, (size_t)WS_END); grid = -1; return; }
        int dev = 0, cus = 0, per_cu = 0;
        if (hipGetDevice(&dev) != hipSuccess || hipDeviceGetAttribute(&cus, hipDeviceAttributeMultiprocessorCount, dev) != hipSuccess) { grid = -1; return; }
        if (hipFuncSetAttribute((const void*)mega_fwd, hipFuncAttributeMaxDynamicSharedMemorySize, LDS_BYTES) != hipSuccess) { fprintf(stderr, "kernel_launch: hipFuncSetAttribute failed\n"); grid = -1; return; }
        if (hipOccupancyMaxActiveBlocksPerMultiprocessor(&per_cu, (const void*)mega_fwd, NTHREADS, LDS_BYTES) != hipSuccess || per_cu < 1) { fprintf(stderr, "kernel_launch: occupancy query says %d blocks per CU\n", per_cu); grid = -1; (void)hipGetLastError(); return; }
        grid = cus;
    }
    if (grid < 0) return;
    (void)hipMemsetAsync((char*)d_ws + OFF_CTL, 0, CTL_BYTES, stream);
    Args a{};
    for (int i = 0; i < 14; ++i) a.in[i] = (const float*)d_in[i];
    a.out = (float*)d_out; a.ws = (unsigned char*)d_ws;
    hipLaunchKernelGGL(mega_fwd, dim3(grid), dim3(NTHREADS), LDS_BYTES, stream, a);
}
```

```cpp
#include <hip/hip_runtime.h>
#include <cstdio>
#include <cstdint>
__device__ __forceinline__ int tid_of(int wv) { int t; asm volatile("v_mbcnt_lo_u32_b32 %0, -1, 0\n\tv_mbcnt_hi_u32_b32 %0, -1, %0\n\tv_lshl_add_u32 %0, %1, 6, %0" : "=&v"(t) : "s"(wv)); return t; }
__device__ __forceinline__ void half_swap(float& a, float& b) { asm("s_nop 1\n\tv_permlane32_swap_b32 %0, %1" : "+v"(a), "+v"(b)); }
template <int K> __device__ __forceinline__ float lane_xor(float v) { static_assert(K >= 1 && K <= 16, "lane_xor: within 32 lanes"); return __builtin_bit_cast(float, __builtin_amdgcn_ds_swizzle(__builtin_bit_cast(int, v), (K << 10) | 0x1f)); }
__device__ __forceinline__ float wave_sum(float v) {
    v += lane_xor<1>(v); v += lane_xor<2>(v); v += lane_xor<4>(v); v += lane_xor<8>(v); v += lane_xor<16>(v);
    float a = v, b = v; half_swap(a, b);
    return a + b;
}
namespace pg8 {
#define PG8_LAS __attribute__((address_space(3)))
typedef unsigned short bf16_t;
typedef short bf16x8 __attribute__((ext_vector_type(8)));
typedef float f32x4 __attribute__((ext_vector_type(4)));
typedef unsigned u32x4 __attribute__((ext_vector_type(4)));
constexpr int BM = 256, BK = 64, HALF = 128, HTB = HALF * BK * 2  , STAGE_BYTES = 8 * HTB, NXCD = 8, WGM = 8;

__host__ __device__ __forceinline__ int lds_byte(int r, int c) { const int st = (r >> 4) * 2 + (c >> 5), rr = r & 15, cc = c & 31, ob = rr * 64 + cc * 2; return st * 1024 + (ob ^ (((ob >> 9) & 1) << 5)); }
__host__ __device__ __forceinline__ void stage_rc(int b, int& R, int& C) { const int st = b / 1024, sb = b % 1024, swz = sb ^ (((sb >> 9) & 1) << 5); R = (st >> 1) * 16 + swz / 64; C = (st & 1) * 32 + (swz % 64) / 2; }
__host__ __device__ __forceinline__ int perm32(int rho) { const int n = rho >> 4, i = rho & 15; return 8 * (i >> 2) + 4 * n + (i & 3); }

struct Unit { int pm, pn; };
struct Gemm { const bf16_t* A; const bf16_t* Bt; int M, N, K; };

struct StaticOrder {
    int nM, nN, nwg, G, c;
    __host__ __device__ void init(int M, int N, int G_, int c_) { nM = M / BM; nN = N / BM; nwg = nM * nN; G = G_; c = c_; }
    __host__ __device__ bool next(int i, Unit& u) const {
        const long L = (long)i * G + c; if (L >= nwg) return false;
        int wgid = (int)L; { const int q = nwg / NXCD, r = nwg % NXCD, xcd = wgid % NXCD, off = wgid / NXCD; wgid = (xcd < r ? xcd * (q + 1) : r * (q + 1) + (xcd - r) * q) + off; }
        const int nig = WGM * nN, gid = wgid / nig, fm = gid * WGM, gsz = (nM - fm) < WGM ? (nM - fm) : WGM;
        u.pm = fm + ((wgid % nig) % gsz); u.pn = (wgid % nig) / gsz; return true;
    }
    __device__ __forceinline__ void a_ready(const Unit&) const {}
    __device__ __forceinline__ void done(const Unit&) const {}
};
__device__ __forceinline__ unsigned cvt_pk_bf16(float lo, float hi) { unsigned r; asm volatile("v_cvt_pk_bf16_f32 %0, %1, %2" : "=v"(r) : "v"(lo), "v"(hi)); return r; }
typedef float f32x2 __attribute__((ext_vector_type(2)));
__device__ __forceinline__ f32x2 gelu_pk(f32x2 v) {
    const f32x2 av = __builtin_elementwise_abs(v), d = av * 0.2316418882f + 1.0f;
    f32x2 t; t.x = __builtin_amdgcn_rcpf(d.x); t.y = __builtin_amdgcn_rcpf(d.y);
    f32x2 q = t * 0.5307027145f + (-0.7265760135f); q = q * t + 0.7107068705f; q = q * t + (-0.142248368f); q = q * t + 0.127414796f; q = q * t;
    const f32x2 s = (v * v) * (-0.72134752044f);
    f32x2 e; e.x = __builtin_amdgcn_exp2f(s.x); e.y = __builtin_amdgcn_exp2f(s.y);
    const f32x2 m = v * (q * e), r = v - m;
    f32x2 o; o.x = v.x < 0.f ? m.x : r.x; o.y = v.y < 0.f ? m.y : r.y; return o;
}

struct EpiIn {
    static constexpr bool PERM = true, AFTER_DRAIN = false;
    bf16_t* O; long ldc; long gelu_from_pn; const unsigned long long* rowss; float inv_k, eps;
    __device__ __forceinline__ void operator()(const f32x4 (&acc)[2][2][4][2], const Unit& u, int wr, int wc, int fr, int fq) const {
        const int row0 = u.pm * BM + wr * 64 + fr; const int col0 = u.pn * BM + wc * 32 + 8 * fq;
        const bool act = u.pn >= (int)gelu_from_pn;
#pragma unroll
        for (int ai = 0; ai < 2; ++ai)
#pragma unroll
            for (int m = 0; m < 4; ++m) { bf16_t* rowp = O + (size_t)(row0 + ai * HALF + m * 16) * (size_t)ldc + col0;
                const float rs = __builtin_amdgcn_rsqf((float)rowss[row0 + ai * HALF + m * 16] * inv_k + eps);
#pragma unroll
                for (int bj = 0; bj < 2; ++bj) { f32x4 v0 = acc[ai][bj][m][0] * rs, v1 = acc[ai][bj][m][1] * rs;
                    if (act) { f32x2 a = gelu_pk((f32x2){v0[0], v0[1]}), b = gelu_pk((f32x2){v0[2], v0[3]}), c = gelu_pk((f32x2){v1[0], v1[1]}), d = gelu_pk((f32x2){v1[2], v1[3]});
                        v0 = (f32x4){a.x, a.y, b.x, b.y}; v1 = (f32x4){c.x, c.y, d.x, d.y}; }
                    u32x4 w; w.x = cvt_pk_bf16(v0[0], v0[1]); w.y = cvt_pk_bf16(v0[2], v0[3]); w.z = cvt_pk_bf16(v1[0], v1[1]); w.w = cvt_pk_bf16(v1[2], v1[3]);
                    *(u32x4*)(rowp + bj * HALF) = w; } }
    }
};
struct EpiBf {
    static constexpr bool PERM = true, AFTER_DRAIN = false;
    bf16_t* O; long ldc;
    __device__ __forceinline__ void operator()(const f32x4 (&acc)[2][2][4][2], const Unit& u, int wr, int wc, int fr, int fq) const {
        const int row0 = u.pm * BM + wr * 64 + fr; const int col0 = u.pn * BM + wc * 32 + 8 * fq;
#pragma unroll
        for (int ai = 0; ai < 2; ++ai)
#pragma unroll
            for (int m = 0; m < 4; ++m) { bf16_t* rowp = O + (size_t)(row0 + ai * HALF + m * 16) * (size_t)ldc + col0;
#pragma unroll
                for (int bj = 0; bj < 2; ++bj) { const f32x4 v0 = acc[ai][bj][m][0], v1 = acc[ai][bj][m][1];
                    u32x4 w; w.x = cvt_pk_bf16(v0[0], v0[1]); w.y = cvt_pk_bf16(v0[2], v0[3]); w.z = cvt_pk_bf16(v1[0], v1[1]); w.w = cvt_pk_bf16(v1[2], v1[3]);
                    *(u32x4*)(rowp + bj * HALF) = w; } }
    }
};
typedef int i32x4 __attribute__((ext_vector_type(4)));
__device__ __forceinline__ f32x4 mma1(bf16x8 w, bf16x8 a, f32x4 c) { return __builtin_amdgcn_mfma_f32_16x16x32_bf16(w, a, c, 0, 0, 0); }
__device__ __forceinline__ i32x4 mma1(bf16x8 w, bf16x8 a, i32x4 c) { return __builtin_amdgcn_mfma_i32_16x16x64_i8(__builtin_bit_cast(i32x4, w), __builtin_bit_cast(i32x4, a), c, 0, 0, 0); }
template <class E, class = void> struct ARow4Of { static constexpr bool v = false; };
template <class E> struct ARow4Of<E, decltype((void)E::AROW4)> { static constexpr bool v = E::AROW4; };
template <class E, class = void> struct AccOf { typedef f32x4 type; };
template <class E> struct AccOf<E, decltype((void)sizeof(typename E::AccT))> { typedef typename E::AccT type; };
template <int CTRL> __device__ __forceinline__ float dpp_z(float src) { return __builtin_bit_cast(float, __builtin_amdgcn_update_dpp(0, __builtin_bit_cast(int, src), CTRL, 0xf, 0xf, true)); }
template <int CTRL> __device__ __forceinline__ float dpp_f(float oldv, float src) { return __builtin_bit_cast(float, __builtin_amdgcn_update_dpp(__builtin_bit_cast(int, oldv), __builtin_bit_cast(int, src), CTRL, 0xf, 0xf, false)); }
struct EpiConv {
    static constexpr bool PERM = true, AFTER_DRAIN = false;
    bf16_t* ACT; float* U4; const float* cw; const float* cb; long dff; const unsigned long long* rowss; float inv_k, eps;
    __device__ __forceinline__ void operator()(f32x4 (&acc)[2][2][4][2], const Unit& u, int wr, int wc, int fr, int fq) const {
#pragma unroll
        for (int ai = 0; ai < 2; ++ai)
#pragma unroll
            for (int m = 0; m < 4; ++m) { const float rs = __builtin_amdgcn_rsqf((float)rowss[u.pm * BM + ai * HALF + wr * 64 + m * 16 + fr] * inv_k + eps);
#pragma unroll
                for (int bj = 0; bj < 2; ++bj)
#pragma unroll
                    for (int n = 0; n < 2; ++n) acc[ai][bj][m][n] = acc[ai][bj][m][n] * rs; }
        body(acc, u, wr, wc, fr, fq);
    }
    __device__ __forceinline__ void body(f32x4 (&acc)[2][2][4][2], const Unit& u, int wr, int wc, int fr, int fq) const {
        const int ch0 = u.pn * 128 + wc * 32 + 8 * fq;
        const int n2 = 2 * (int)dff;
        { const int slot = (fr < 2) ? fr : fr - 12;
          if (fr < 2 || fr >= 14) {
#pragma unroll
              for (int ai = 0; ai < 2; ++ai) { float* p = U4 + ((size_t)(u.pm * 4 + ai * 2 + wr) * 4 + slot) * (size_t)n2 + ch0;
#pragma unroll
                  for (int bj = 0; bj < 2; ++bj)
#pragma unroll
                      for (int n = 0; n < 2; ++n) *(f32x4*)(p + bj * dff + 4 * n) = (fr < 2) ? acc[ai][bj][0][n] : acc[ai][bj][3][n]; } } }
#pragma unroll
        for (int bj = 0; bj < 2; ++bj) {
            const float* wp = cw + bj * dff + ch0; const float* bp = cb + bj * dff + ch0;
            f32x4 w0[2], w1[2], w2[2], bb[2], w0z[2], w1z[2];
#pragma unroll
            for (int n = 0; n < 2; ++n) { w0[n] = *(const f32x4*)(wp + 4 * n); w1[n] = *(const f32x4*)(wp + n2 + 4 * n); w2[n] = *(const f32x4*)(wp + 2 * (size_t)n2 + 4 * n); bb[n] = *(const f32x4*)(bp + 4 * n);
                w0z[n] = fr < 2 ? w0[n] : (f32x4){0.f, 0.f, 0.f, 0.f}; w1z[n] = fr == 0 ? w1[n] : (f32x4){0.f, 0.f, 0.f, 0.f}; }
#pragma unroll
            for (int ai = 0; ai < 2; ++ai)
#pragma unroll
                for (int m = 3; m >= 0; --m)
#pragma unroll
                    for (int n = 0; n < 2; ++n) { const f32x4 x = acc[ai][bj][m][n]; f32x4 y;
#pragma unroll
                        for (int e = 0; e < 4; ++e) y[e] = fmaf(w2[n][e], x[e], bb[n][e]);
                        if (m > 0) { const f32x4 xp = acc[ai][bj][m - 1][n];
                            asm volatile("s_nop 1\n\t"
                                "v_fmac_f32_dpp %0, %4, %12 row_shr:1 row_mask:0xf bank_mask:0xf\n\tv_fmac_f32_dpp %1, %5, %13 row_shr:1 row_mask:0xf bank_mask:0xf\n\tv_fmac_f32_dpp %2, %6, %14 row_shr:1 row_mask:0xf bank_mask:0xf\n\tv_fmac_f32_dpp %3, %7, %15 row_shr:1 row_mask:0xf bank_mask:0xf\n\t"
                                "v_fmac_f32_dpp %0, %4, %16 row_shr:2 row_mask:0xf bank_mask:0xf\n\tv_fmac_f32_dpp %1, %5, %17 row_shr:2 row_mask:0xf bank_mask:0xf\n\tv_fmac_f32_dpp %2, %6, %18 row_shr:2 row_mask:0xf bank_mask:0xf\n\tv_fmac_f32_dpp %3, %7, %19 row_shr:2 row_mask:0xf bank_mask:0xf\n\t"
                                "v_fmac_f32_dpp %0, %8, %20 row_ror:1 row_mask:0xf bank_mask:0xf\n\tv_fmac_f32_dpp %1, %9, %21 row_ror:1 row_mask:0xf bank_mask:0xf\n\tv_fmac_f32_dpp %2, %10, %22 row_ror:1 row_mask:0xf bank_mask:0xf\n\tv_fmac_f32_dpp %3, %11, %23 row_ror:1 row_mask:0xf bank_mask:0xf\n\t"
                                "v_fmac_f32_dpp %0, %8, %24 row_ror:2 row_mask:0xf bank_mask:0xf\n\tv_fmac_f32_dpp %1, %9, %25 row_ror:2 row_mask:0xf bank_mask:0xf\n\tv_fmac_f32_dpp %2, %10, %26 row_ror:2 row_mask:0xf bank_mask:0xf\n\tv_fmac_f32_dpp %3, %11, %27 row_ror:2 row_mask:0xf bank_mask:0xf"
                                : "+v"(y[0]), "+v"(y[1]), "+v"(y[2]), "+v"(y[3])
                                : "v"(x[0]), "v"(x[1]), "v"(x[2]), "v"(x[3]), "v"(xp[0]), "v"(xp[1]), "v"(xp[2]), "v"(xp[3]),
                                  "v"(w1[n][0]), "v"(w1[n][1]), "v"(w1[n][2]), "v"(w1[n][3]), "v"(w0[n][0]), "v"(w0[n][1]), "v"(w0[n][2]), "v"(w0[n][3]),
                                  "v"(w1z[n][0]), "v"(w1z[n][1]), "v"(w1z[n][2]), "v"(w1z[n][3]), "v"(w0z[n][0]), "v"(w0z[n][1]), "v"(w0z[n][2]), "v"(w0z[n][3])); }
                        else {
                            asm volatile("s_nop 1\n\t"
                                "v_fmac_f32_dpp %0, %4, %8 row_shr:1 row_mask:0xf bank_mask:0xf\n\tv_fmac_f32_dpp %1, %5, %9 row_shr:1 row_mask:0xf bank_mask:0xf\n\tv_fmac_f32_dpp %2, %6, %10 row_shr:1 row_mask:0xf bank_mask:0xf\n\tv_fmac_f32_dpp %3, %7, %11 row_shr:1 row_mask:0xf bank_mask:0xf\n\t"
                                "v_fmac_f32_dpp %0, %4, %12 row_shr:2 row_mask:0xf bank_mask:0xf\n\tv_fmac_f32_dpp %1, %5, %13 row_shr:2 row_mask:0xf bank_mask:0xf\n\tv_fmac_f32_dpp %2, %6, %14 row_shr:2 row_mask:0xf bank_mask:0xf\n\tv_fmac_f32_dpp %3, %7, %15 row_shr:2 row_mask:0xf bank_mask:0xf"
                                : "+v"(y[0]), "+v"(y[1]), "+v"(y[2]), "+v"(y[3])
                                : "v"(x[0]), "v"(x[1]), "v"(x[2]), "v"(x[3]),
                                  "v"(w1[n][0]), "v"(w1[n][1]), "v"(w1[n][2]), "v"(w1[n][3]), "v"(w0[n][0]), "v"(w0[n][1]), "v"(w0[n][2]), "v"(w0[n][3])); }
                        acc[ai][bj][m][n] = y; }
        }
        const int row0 = u.pm * BM + wr * 64 + fr;
#pragma unroll
        for (int ai = 0; ai < 2; ++ai)
#pragma unroll
            for (int m = 0; m < 4; ++m) { float r[8];
#pragma unroll
                for (int n = 0; n < 2; ++n)
#pragma unroll
                    for (int e = 0; e < 4; ++e) { const float g = acc[ai][0][m][n][e]; r[4 * n + e] = g * __builtin_amdgcn_rcpf(1.f + __builtin_amdgcn_exp2f(-1.4426950408889634f * g)) * acc[ai][1][m][n][e]; }
                u32x4 w; w.x = cvt_pk_bf16(r[0], r[1]); w.y = cvt_pk_bf16(r[2], r[3]); w.z = cvt_pk_bf16(r[4], r[5]); w.w = cvt_pk_bf16(r[6], r[7]);
                *(u32x4*)(ACT + (size_t)(row0 + ai * HALF + m * 16) * (size_t)dff + ch0) = w; }
    }
};
struct EpiConv4 {
    EpiConv c;
    __device__ __forceinline__ void body(f32x4 (&acc)[2][2][4][2], const Unit& u, int wr, int wc, int fr, int fq) const {
        const int ch0 = u.pn * 128 + wc * 32 + 8 * fq; const int n2 = 2 * (int)c.dff;
        if (fr == 0 || fr == 15) {
#pragma unroll
            for (int ai = 0; ai < 2; ++ai)
#pragma unroll
                for (int s = 0; s < 2; ++s) { float* p = c.U4 + ((size_t)(u.pm * 4 + ai * 2 + wr) * 4 + (fr == 0 ? s : 2 + s)) * (size_t)n2 + ch0;
#pragma unroll
                    for (int bj = 0; bj < 2; ++bj)
#pragma unroll
                        for (int n = 0; n < 2; ++n) *(f32x4*)(p + bj * c.dff + 4 * n) = (fr == 0) ? acc[ai][bj][s][n] : acc[ai][bj][2 + s][n]; } }
#pragma unroll
        for (int bj = 0; bj < 2; ++bj) {
            const float* wp = c.cw + bj * c.dff + ch0; const float* bp = c.cb + bj * c.dff + ch0;
#pragma unroll
            for (int n = 0; n < 2; ++n) { const f32x4 w0 = *(const f32x4*)(wp + 4 * n), w1 = *(const f32x4*)(wp + n2 + 4 * n), w2 = *(const f32x4*)(wp + 2 * (size_t)n2 + 4 * n), bb = *(const f32x4*)(bp + 4 * n);
#pragma unroll
                for (int ai = 0; ai < 2; ++ai) { const f32x4 x0 = acc[ai][bj][0][n], x1 = acc[ai][bj][1][n], x2 = acc[ai][bj][2][n], x3 = acc[ai][bj][3][n];
                    const f32x4 y3 = w0 * x1 + (w1 * x2 + (w2 * x3 + bb)), y2 = w0 * x0 + (w1 * x1 + (w2 * x2 + bb)); f32x4 y1 = w1 * x0 + (w2 * x1 + bb), y0 = w2 * x0 + bb;
                    asm volatile("s_nop 1\n\t"
                        "v_fmac_f32_dpp %4, %12, %16 row_shr:1 row_mask:0xf bank_mask:0xf\n\tv_fmac_f32_dpp %5, %13, %17 row_shr:1 row_mask:0xf bank_mask:0xf\n\tv_fmac_f32_dpp %6, %14, %18 row_shr:1 row_mask:0xf bank_mask:0xf\n\tv_fmac_f32_dpp %7, %15, %19 row_shr:1 row_mask:0xf bank_mask:0xf\n\t"
                        "v_fmac_f32_dpp %0, %12, %20 row_shr:1 row_mask:0xf bank_mask:0xf\n\tv_fmac_f32_dpp %1, %13, %21 row_shr:1 row_mask:0xf bank_mask:0xf\n\tv_fmac_f32_dpp %2, %14, %22 row_shr:1 row_mask:0xf bank_mask:0xf\n\tv_fmac_f32_dpp %3, %15, %23 row_shr:1 row_mask:0xf bank_mask:0xf\n\t"
                        "v_fmac_f32_dpp %0, %8, %16 row_shr:1 row_mask:0xf bank_mask:0xf\n\tv_fmac_f32_dpp %1, %9, %17 row_shr:1 row_mask:0xf bank_mask:0xf\n\tv_fmac_f32_dpp %2, %10, %18 row_shr:1 row_mask:0xf bank_mask:0xf\n\tv_fmac_f32_dpp %3, %11, %19 row_shr:1 row_mask:0xf bank_mask:0xf"
                        : "+v"(y0[0]), "+v"(y0[1]), "+v"(y0[2]), "+v"(y0[3]), "+v"(y1[0]), "+v"(y1[1]), "+v"(y1[2]), "+v"(y1[3])
                        : "v"(x2[0]), "v"(x2[1]), "v"(x2[2]), "v"(x2[3]), "v"(x3[0]), "v"(x3[1]), "v"(x3[2]), "v"(x3[3]),
                          "v"(w0[0]), "v"(w0[1]), "v"(w0[2]), "v"(w0[3]), "v"(w1[0]), "v"(w1[1]), "v"(w1[2]), "v"(w1[3]));
                    acc[ai][bj][0][n] = y0; acc[ai][bj][1][n] = y1; acc[ai][bj][2][n] = y2; acc[ai][bj][3][n] = y3; } }
        }
        const int row0 = u.pm * BM + wr * 64 + 4 * fr;
#pragma unroll
        for (int ai = 0; ai < 2; ++ai)
#pragma unroll
            for (int m = 0; m < 4; ++m) { float r[8];
#pragma unroll
                for (int n = 0; n < 2; ++n)
#pragma unroll
                    for (int e = 0; e < 4; ++e) { const float g = acc[ai][0][m][n][e]; r[4 * n + e] = g * __builtin_amdgcn_rcpf(1.f + __builtin_amdgcn_exp2f(-1.4426950408889634f * g)) * acc[ai][1][m][n][e]; }
                u32x4 w; w.x = cvt_pk_bf16(r[0], r[1]); w.y = cvt_pk_bf16(r[2], r[3]); w.z = cvt_pk_bf16(r[4], r[5]); w.w = cvt_pk_bf16(r[6], r[7]);
                *(u32x4*)(c.ACT + (size_t)(row0 + ai * HALF + m) * (size_t)c.dff + ch0) = w; }
    }
};
struct EpiIn8 {
    static constexpr bool PERM = true, AFTER_DRAIN = false; typedef i32x4 AccT;
    EpiIn core; const float* sA; const float* sB;
    __device__ __forceinline__ void operator()(i32x4 (&acc)[2][2][4][2], const Unit& u, int wr, int wc, int fr, int fq) const {
        f32x4 cs[2][2];
#pragma unroll
        for (int bj = 0; bj < 2; ++bj)
#pragma unroll
            for (int n = 0; n < 2; ++n) cs[bj][n] = *(const f32x4*)(sB + u.pn * BM + bj * HALF + wc * 32 + 8 * fq + 4 * n);
        f32x4 af[2][2][4][2];
#pragma unroll
        for (int ai = 0; ai < 2; ++ai)
#pragma unroll
            for (int m = 0; m < 4; ++m) { const float rf = sA[u.pm * BM + ai * HALF + wr * 64 + m * 16 + fr];
#pragma unroll
                for (int bj = 0; bj < 2; ++bj)
#pragma unroll
                    for (int n = 0; n < 2; ++n) af[ai][bj][m][n] = __builtin_convertvector(acc[ai][bj][m][n], f32x4) * rf * cs[bj][n]; }
        core(af, u, wr, wc, fr, fq);
    }
};
struct EpiConv8 {
    static constexpr bool PERM = true, AFTER_DRAIN = false, AROW4 = true; typedef i32x4 AccT;
    EpiConv core; const float* sA; const float* sB;
    __device__ __forceinline__ void operator()(i32x4 (&acc)[2][2][4][2], const Unit& u, int wr, int wc, int fr, int fq) const {
        f32x4 cs[2][2];
#pragma unroll
        for (int bj = 0; bj < 2; ++bj)
#pragma unroll
            for (int n = 0; n < 2; ++n) cs[bj][n] = *(const f32x4*)(sB + u.pn * BM + bj * HALF + wc * 32 + 8 * fq + 4 * n);
        f32x4 af[2][2][4][2];
#pragma unroll
        for (int ai = 0; ai < 2; ++ai)
#pragma unroll
            for (int m = 0; m < 4; ++m) { const int row = u.pm * BM + ai * HALF + wr * 64 + 4 * fr + m;
                const float rf = sA[row] * __builtin_amdgcn_rsqf((float)core.rowss[row] * core.inv_k + core.eps);
#pragma unroll
                for (int bj = 0; bj < 2; ++bj)
#pragma unroll
                    for (int n = 0; n < 2; ++n) af[ai][bj][m][n] = __builtin_convertvector(acc[ai][bj][m][n], f32x4) * rf * cs[bj][n]; }
        EpiConv4{core}.body(af, u, wr, wc, fr, fq);
    }
};
struct EpiRes {
    static constexpr bool PERM = true, AFTER_DRAIN = false;
    bf16_t* xb; unsigned long long* rowss; long ldc;
    __device__ __forceinline__ void operator()(const f32x4 (&acc)[2][2][4][2], const Unit& u, int wr, int wc, int fr, int fq) const {
        const int row0 = u.pm * BM + wr * 64 + fr, col0 = u.pn * BM + wc * 32 + 8 * fq;
#pragma unroll
        for (int ai = 0; ai < 2; ++ai) {
            u32x4 bs[4][2];
#pragma unroll
            for (int m = 0; m < 4; ++m)
#pragma unroll
                for (int bj = 0; bj < 2; ++bj) bs[m][bj] = *(const u32x4*)(xb + (size_t)(row0 + ai * HALF + m * 16) * (size_t)ldc + col0 + bj * HALF);
#pragma unroll
            for (int m = 0; m < 4; ++m) { const int row = row0 + ai * HALF + m * 16; float ss = 0.f;
#pragma unroll
                for (int bj = 0; bj < 2; ++bj) { const u32x4 b = bs[m][bj]; const f32x4 a0 = acc[ai][bj][m][0], a1 = acc[ai][bj][m][1];
                    const float v0 = __builtin_bit_cast(float, b.x << 16) + a0[0], v1 = __builtin_bit_cast(float, b.x & 0xffff0000u) + a0[1], v2 = __builtin_bit_cast(float, b.y << 16) + a0[2], v3 = __builtin_bit_cast(float, b.y & 0xffff0000u) + a0[3];
                    const float v4 = __builtin_bit_cast(float, b.z << 16) + a1[0], v5 = __builtin_bit_cast(float, b.z & 0xffff0000u) + a1[1], v6 = __builtin_bit_cast(float, b.w << 16) + a1[2], v7 = __builtin_bit_cast(float, b.w & 0xffff0000u) + a1[3];
                    ss += ((v0 * v0 + v1 * v1) + (v2 * v2 + v3 * v3)) + ((v4 * v4 + v5 * v5) + (v6 * v6 + v7 * v7));
                    u32x4 w; w.x = cvt_pk_bf16(v0, v1); w.y = cvt_pk_bf16(v2, v3); w.z = cvt_pk_bf16(v4, v5); w.w = cvt_pk_bf16(v6, v7);
                    *(u32x4*)(xb + (size_t)row * (size_t)ldc + col0 + bj * HALF) = w; }
                ss += __builtin_bit_cast(float, __builtin_amdgcn_ds_swizzle(__builtin_bit_cast(int, ss), (16 << 10) | 0x1f));
                { float sa = ss, sb = ss; asm("s_nop 1\n\tv_permlane32_swap_b32 %0, %1" : "+v"(sa), "+v"(sb)); ss = sa + sb; }
                if (fq == 0) __hip_atomic_fetch_add(rowss + row, (unsigned long long)(long long)__builtin_rintf(ss * 16777216.f), __ATOMIC_RELAXED, __HIP_MEMORY_SCOPE_AGENT); }
        }
    }
};

template <class Epi, class Sched, bool ALIGN_EPI = false, bool SP2 = false>
__device__ __forceinline__ void gemm_phase(PG8_LAS unsigned char* lds, const Gemm g, const Sched& S, const Epi& E, const int wv) {
    const int tid_o = tid_of(wv);
    const int tid = tid_o, wid = __builtin_amdgcn_readfirstlane(tid >> 6), lane = tid & 63, wr = wid >> 2, wc = wid & 3, fr = lane & 15, fq = lane >> 4;
    const int K = g.K, nt = K / BK;
    unsigned voffA[2], voffB[2];
#pragma unroll
    for (int i = 0; i < 2; ++i) { int R, C; stage_rc(tid * 16 + i * 8192, R, C); const int Rb = Epi::PERM ? ((R & ~31) + perm32(R & 31)) : R;
        const int Ra = ARow4Of<Epi>::v ? ((R & ~63) + 4 * (R & 15) + ((R & 63) >> 4)) : R;
        voffA[i] = (unsigned)(Ra * K + C) * 2u; voffB[i] = (unsigned)(Rb * K + C) * 2u; }
    const size_t kstep = (size_t)(BK * 2);
    const size_t hstep = (size_t)HALF * K * 2;
    const size_t tstep = 2 * hstep;
    const unsigned ldsw = (unsigned)wid * 1024u;
    const int aoff = lds_byte(wr * 64 + fr, fq * 8), boff = lds_byte(wc * 32 + fr, fq * 8);
#define PG8_SA(b, h) (((b) * 2 + (h)) * HTB)
#define PG8_SB(b, h) ((4 + (b) * 2 + (h)) * HTB)
#define PG8_STAGE(bufoff, gbase, voff) do { _Pragma("unroll") for (int _i = 0; _i < 2; ++_i) \
        __builtin_amdgcn_global_load_lds((const unsigned*)((const char*)(gbase) + (voff)[_i]), (PG8_LAS unsigned*)(lds + (bufoff) + ldsw + _i * 8192), 16, 0, 0); } while (0)
#define PG8_LDA(dst, b, h) do { _Pragma("unroll") for (int m = 0; m < 4; ++m) _Pragma("unroll") for (int k = 0; k < 2; ++k) dst[m][k] = *(const PG8_LAS bf16x8*)(lds + PG8_SA(b, h) + aoff + m * 2048 + k * 1024); } while (0)
#define PG8_LDB(dst, b, h) do { _Pragma("unroll") for (int n = 0; n < 2; ++n) _Pragma("unroll") for (int k = 0; k < 2; ++k) dst[n][k] = *(const PG8_LAS bf16x8*)(lds + PG8_SB(b, h) + boff + n * 2048 + k * 1024); } while (0)
#define PG8_MMA(ai, bj, At, Bt) do { __builtin_amdgcn_s_setprio(1); _Pragma("unroll") for (int m = 0; m < 4; ++m) _Pragma("unroll") for (int n = 0; n < 2; ++n) _Pragma("unroll") for (int k = 0; k < 2; ++k) \
        acc[ai][bj][m][n] = mma1(Bt[n][k], At[m][k], acc[ai][bj][m][n]); __builtin_amdgcn_s_setprio(0); } while (0)
#define PG8_WAIT_V(n) asm volatile("s_waitcnt vmcnt(" #n ")" ::: "memory")
#define PG8_WAIT_L(n) asm volatile("s_waitcnt lgkmcnt(" #n ")" ::: "memory")
#define PG8_BAR __builtin_amdgcn_s_barrier()
#define PG8_SCHED __builtin_amdgcn_sched_barrier(0)
    Unit cur, nxt; int ui = 0;
    if (!S.next(0, cur)) return;
    typedef typename AccOf<Epi>::type AccT;
    AccT acc[2][2][4][2];
#pragma unroll
    for (int a = 0; a < 2; ++a)
#pragma unroll
        for (int b = 0; b < 2; ++b)
#pragma unroll
            for (int m = 0; m < 4; ++m)
#pragma unroll
                for (int n = 0; n < 2; ++n) acc[a][b][m][n] = (AccT){0, 0, 0, 0};
    bf16x8 At[4][2], B0[2][2], B1[2][2];
    const char* cA = (const char*)g.A + (size_t)cur.pm * tstep; const char* cB = (const char*)g.Bt + (size_t)cur.pn * tstep;
    S.a_ready(cur);
    if constexpr (SP2) {
        PG8_STAGE(PG8_SB(0, 0), cB, voffB); PG8_STAGE(PG8_SB(0, 1), cB + hstep, voffB); PG8_STAGE(PG8_SA(0, 0), cA, voffA); PG8_STAGE(PG8_SA(0, 1), cA + hstep, voffA);
        if (wr == 1) PG8_BAR;
        PG8_WAIT_V(2); PG8_BAR;
        PG8_STAGE(PG8_SB(1, 0), cB + kstep, voffB); PG8_STAGE(PG8_SA(1, 0), cA + kstep, voffA); PG8_STAGE(PG8_SB(1, 1), cB + hstep + kstep, voffB);
        PG8_WAIT_V(6); PG8_BAR;
    } else {
        PG8_STAGE(PG8_SB(0, 0), cB, voffB); PG8_STAGE(PG8_SA(0, 0), cA, voffA); PG8_STAGE(PG8_SB(0, 1), cB + hstep, voffB); PG8_STAGE(PG8_SA(0, 1), cA + hstep, voffA);
        if (wr == 1) PG8_BAR;
        PG8_WAIT_V(4); PG8_BAR;
        PG8_STAGE(PG8_SB(1, 0), cB + kstep, voffB); PG8_STAGE(PG8_SA(1, 0), cA + kstep, voffA); PG8_STAGE(PG8_SB(1, 1), cB + hstep + kstep, voffB);
        PG8_WAIT_V(6); PG8_BAR;
    }
    for (;;) {
        const bool has_next = S.next(ui + 1, nxt);
        const char* nA = has_next ? (const char*)g.A + (size_t)nxt.pm * tstep : cA; const char* nB = has_next ? (const char*)g.Bt + (size_t)nxt.pn * tstep : cB;
        for (int t = 0; t < nt; t += 2) {
            const bool last = (t == nt - 2);
            const char* a1 = cA + (size_t)(t + 1) * kstep;
            const char* a2 = last ? nA : cA + (size_t)(t + 2) * kstep; const char* b2 = last ? nB : cB + (size_t)(t + 2) * kstep;
            const char* a3 = a2 + kstep; const char* b3 = b2 + kstep;
            if (last && has_next) S.a_ready(nxt);
            if constexpr (SP2) {
            PG8_LDB(B0, 0, 0); PG8_LDB(B1, 0, 1); PG8_SCHED; PG8_LDA(At, 0, 0); PG8_STAGE(PG8_SA(1, 1), a1 + hstep, voffA);
            PG8_WAIT_V(8); PG8_WAIT_L(0); PG8_BAR; PG8_MMA(0, 0, At, B0); PG8_MMA(0, 1, At, B1); PG8_BAR; PG8_SCHED;
            PG8_LDA(At, 0, 1); PG8_STAGE(PG8_SB(0, 0), b2, voffB); PG8_STAGE(PG8_SB(0, 1), b2 + hstep, voffB); PG8_STAGE(PG8_SA(0, 0), a2, voffA);
            PG8_WAIT_V(8); PG8_WAIT_L(0); PG8_BAR; PG8_MMA(1, 0, At, B0); PG8_MMA(1, 1, At, B1); PG8_BAR; PG8_SCHED;
            PG8_LDB(B0, 1, 0); PG8_LDB(B1, 1, 1); PG8_SCHED; PG8_LDA(At, 1, 0); PG8_STAGE(PG8_SA(0, 1), a2 + hstep, voffA);
            PG8_WAIT_V(8); PG8_WAIT_L(0); PG8_BAR; PG8_MMA(0, 0, At, B0); PG8_MMA(0, 1, At, B1); PG8_BAR; PG8_SCHED;
            PG8_LDA(At, 1, 1); PG8_STAGE(PG8_SB(1, 0), b3, voffB); PG8_STAGE(PG8_SB(1, 1), b3 + hstep, voffB); PG8_STAGE(PG8_SA(1, 0), a3, voffA);
            PG8_WAIT_V(8); PG8_WAIT_L(0); PG8_BAR; PG8_MMA(1, 0, At, B0); PG8_MMA(1, 1, At, B1); PG8_BAR; PG8_SCHED;
            } else {
            PG8_LDB(B0, 0, 0); PG8_SCHED; PG8_LDA(At, 0, 0); PG8_STAGE(PG8_SA(1, 1), a1 + hstep, voffA);
            PG8_WAIT_L(8); PG8_BAR; PG8_WAIT_L(0); PG8_MMA(0, 0, At, B0); PG8_BAR; PG8_SCHED;
            PG8_LDB(B1, 0, 1); PG8_STAGE(PG8_SB(0, 0), b2, voffB);
            PG8_BAR; PG8_WAIT_L(0); PG8_MMA(0, 1, At, B1); PG8_BAR;
            PG8_LDA(At, 0, 1); PG8_STAGE(PG8_SA(0, 0), a2, voffA);
            PG8_BAR; PG8_WAIT_L(0); PG8_MMA(1, 0, At, B0); PG8_BAR; PG8_SCHED;
            PG8_STAGE(PG8_SB(0, 1), b2 + hstep, voffB);
            PG8_WAIT_V(6); PG8_BAR; PG8_MMA(1, 1, At, B1); PG8_BAR;
            PG8_LDB(B0, 1, 0); PG8_SCHED; PG8_LDA(At, 1, 0); PG8_STAGE(PG8_SA(0, 1), a2 + hstep, voffA);
            PG8_WAIT_L(8); PG8_BAR; PG8_WAIT_L(0); PG8_MMA(0, 0, At, B0); PG8_BAR; PG8_SCHED;
            PG8_LDB(B1, 1, 1); PG8_STAGE(PG8_SB(1, 0), b3, voffB);
            PG8_BAR; PG8_WAIT_L(0); PG8_MMA(0, 1, At, B1); PG8_BAR;
            PG8_LDA(At, 1, 1); PG8_STAGE(PG8_SA(1, 0), a3, voffA);
            PG8_BAR; PG8_WAIT_L(0); PG8_MMA(1, 0, At, B0); PG8_BAR; PG8_SCHED;
            PG8_STAGE(PG8_SB(1, 1), b3 + hstep, voffB);
            PG8_WAIT_V(6); PG8_BAR; PG8_MMA(1, 1, At, B1); PG8_BAR;
            }
        }
        if constexpr (ALIGN_EPI) { if (wr == 0) PG8_BAR; }
        if constexpr (!Epi::AFTER_DRAIN) { E(acc, cur, wr, wc, fr, fq); S.done(cur); }
        if (!has_next) break;
#pragma unroll
        for (int a = 0; a < 2; ++a)
#pragma unroll
            for (int b = 0; b < 2; ++b)
#pragma unroll
                for (int m = 0; m < 4; ++m)
#pragma unroll
                    for (int n = 0; n < 2; ++n) acc[a][b][m][n] = (AccT){0, 0, 0, 0};
        cur = nxt; cA = nA; cB = nB; ++ui;
        if constexpr (ALIGN_EPI) { if (wr == 1) PG8_BAR; }
    }
    PG8_WAIT_V(0);
    if constexpr (!ALIGN_EPI) { if (wr == 0) PG8_BAR; }
    PG8_BAR;
    if constexpr (Epi::AFTER_DRAIN) { E.fused(acc, cur, wr, wc, fr, fq, lds, wid, lane); S.done(cur); }
#undef PG8_SA
#undef PG8_SB
#undef PG8_STAGE
#undef PG8_LDA
#undef PG8_LDB
#undef PG8_MMA
#undef PG8_WAIT_V
#undef PG8_WAIT_L
#undef PG8_BAR
#undef PG8_SCHED
}
}
#define LAS __attribute__((address_space(3)))
#define XB_TMO      128
#define XB_XCNT(j)  (256  + 64 * (j))
#define XB_XSUB(j)  (1280 + 64 * (j))
#define XB_XGEN(j)  (2304 + 64 * (j))
#define XB_TOP      3328
#define XB_TOPGEN   3392
#define XCD_BAR_WORDS 3456
#define XB_SPIN_CAP (1u << 18)

__device__ __forceinline__ unsigned xb_ld(unsigned* p)              { return __hip_atomic_load(p, __ATOMIC_RELAXED, __HIP_MEMORY_SCOPE_AGENT); }
__device__ __forceinline__ unsigned xb_add(unsigned* p, unsigned v) { return __hip_atomic_fetch_add(p, v, __ATOMIC_RELAXED, __HIP_MEMORY_SCOPE_AGENT); }
__device__ __forceinline__ unsigned xb_xcc_id() { return (unsigned)__builtin_amdgcn_s_getreg((3 << 11) | 20) & 0xFu; }
#define XB_SPIN(cond, bar) do { unsigned _sp = 0; while (cond) { __builtin_amdgcn_s_sleep(1); \
    if ((++_sp & 255u) == 0u) { if (xb_ld(&(bar)[XB_TMO])) break; if (_sp > XB_SPIN_CAP) { atomicAdd(&(bar)[XB_TMO], 1u); break; } } } } while (0)

struct XcdBarrier {
    unsigned* bar; unsigned x;
    volatile LAS unsigned* st;
};

__device__ __forceinline__ XcdBarrier xcd_barrier_post(unsigned* bar, volatile LAS unsigned* st, const int wv) {
    XcdBarrier b; b.bar = bar; b.x = (unsigned)__builtin_amdgcn_readfirstlane((int)xb_xcc_id()); b.st = st;
    if (tid_of(wv) == 0) (void)xb_add(&bar[XB_XCNT(b.x)], 1u);
    return b;
}
__device__ __forceinline__ void xcd_barrier_complete(unsigned* bar, unsigned x, unsigned& nloc, unsigned& nx) {
    const unsigned G = gridDim.x * gridDim.y * gridDim.z;
    unsigned sum, cnt, mine, sp = 0u;
    for (;;) {
        sum = 0u; cnt = 0u; mine = 0u;
#pragma unroll
        for (unsigned j = 0; j < 16; ++j) { const unsigned c = xb_ld(&bar[XB_XCNT(j)]); sum += c; cnt += (c > 0u) ? 1u : 0u; mine = (j == x) ? c : mine; }
        if (sum == G) break;
        __builtin_amdgcn_s_sleep(1);
        if ((++sp & 255u) == 0u) { if (xb_ld(&bar[XB_TMO])) break; if (sp > XB_SPIN_CAP) { atomicAdd(&bar[XB_TMO], 1u); break; } }
    }
    nloc = mine > 0u ? mine : 1u; nx = cnt > 0u ? cnt : 1u;
}

__device__ __forceinline__ void xcd_barrier(const XcdBarrier& b, const int wv) {
    asm volatile("s_waitcnt vmcnt(0)" ::: "memory");
    __syncthreads();
    if (tid_of(wv) == 0) {
        unsigned* bar = b.bar; unsigned bx = b.x; asm volatile("" : "+s"(bx));
        __builtin_amdgcn_s_waitcnt(0);
        unsigned nloc = b.st[0], nx = b.st[1];
        if (nloc == 0u) { xcd_barrier_complete(bar, bx, nloc, nx); b.st[0] = nloc; b.st[1] = nx; }
        const unsigned old = xb_add(&bar[XB_XSUB(bx)], 1u);
        const unsigned gen = old / nloc;
        if (old + 1u == (gen + 1u) * nloc) {
            __builtin_amdgcn_fence(__ATOMIC_RELEASE, "agent");
            asm volatile("s_waitcnt vmcnt(0)" ::: "memory");
            const unsigned og = xb_add(&bar[XB_TOP], 1u);
            const unsigned tg = og / nx;
            if (og + 1u == (tg + 1u) * nx) xb_add(&bar[XB_TOPGEN], 1u);
            else XB_SPIN(xb_ld(&bar[XB_TOPGEN]) == tg, bar);
            __builtin_amdgcn_fence(__ATOMIC_ACQUIRE, "agent");
            xb_add(&bar[XB_XGEN(bx)], 1u);
            asm volatile("s_waitcnt vmcnt(0)" ::: "memory");
        } else {
            XB_SPIN(xb_ld(&bar[XB_XGEN(bx)]) == gen, bar);
            __builtin_amdgcn_fence(__ATOMIC_ACQUIRE, "agent");
            asm volatile("s_waitcnt vmcnt(0)" ::: "memory");
        }
    }
    __syncthreads();
}

namespace attn {
constexpr int D = 128;
constexpr float THR = 8.f;
constexpr bool WSKIP = true;
constexpr float SCALE = 0.08838834764831845f;
constexpr int NW = 8, QBLK = 32, KVBLK = 64, QB = NW * QBLK;
constexpr int SHM_V = KVBLK * D * 2, SHM_K = KVBLK * D * 2;
constexpr int LDS_BYTES = 2 * SHM_V + 2 * SHM_K + NW * 64 * 4;
typedef short bf16x8 __attribute__((ext_vector_type(8)));
typedef short s16x4 __attribute__((ext_vector_type(4)));
typedef float f32x16 __attribute__((ext_vector_type(16)));
typedef float f32x4 __attribute__((ext_vector_type(4)));
typedef unsigned u32x4 __attribute__((ext_vector_type(4)));
template <class A, class Bt> struct same_t { static constexpr bool v = false; };
template <class A> struct same_t<A, A> { static constexpr bool v = true; };

#define KSWZ(row, colB) ((row) * 256 + ((colB) ^ (((row) & 7) << 4)))
#define SBAR() __builtin_amdgcn_sched_barrier(0)
__device__ __forceinline__ int v_st(int k, int c) { const int kk = (k & ~0xC) | ((k & 4) << 1) | ((k & 8) >> 1); return ((kk >> 3) * 4 + (c >> 5)) * 512 + ((kk & 7) * 32 + (c & 31)) * 2; }
__device__ __forceinline__ int v_rd_base(int lane) { return ((lane & 3) << 3) | (((lane >> 2) & 3) << 6) | (((lane >> 4) & 1) << 5) | (((lane >> 5) & 1) << 8); }
constexpr int v_rd_off(int d0, int ks, int half) { return d0 * 512 + ks * 4096 + half * 2048; }
__device__ __forceinline__ int crow(int r, int hi) { return (r & 3) + 8 * (r >> 2) + 4 * hi; }
__device__ __forceinline__ unsigned cvtpk(float lo, float hi) {
    unsigned r; asm volatile("v_cvt_pk_bf16_f32 %0, %1, %2" : "=v"(r) : "v"(lo), "v"(hi)); return r;
}
__device__ __forceinline__ bf16x8 pack8(f32x4 a, f32x4 b) {
    u32x4 w = {cvtpk(a[0], a[1]), cvtpk(a[2], a[3]), cvtpk(b[0], b[1]), cvtpk(b[2], b[3])};
    return *reinterpret_cast<bf16x8*>(&w);
}
template <class T> __device__ __forceinline__ bf16x8 load8(const T* p) {
    if constexpr (same_t<T, float>::v) { return pack8(*(const f32x4*)p, *(const f32x4*)(p + 4)); }
    else { return *reinterpret_cast<const bf16x8*>(p); }
}
__device__ __forceinline__ void mask_tile(f32x16& p0, f32x16& p1, int dq, unsigned W) {
    const float NEG = -__builtin_inff();
#pragma unroll
    for (int r = 0; r < 16; ++r) {
        const int c = (r & 3) + 8 * (r >> 2);
        if ((unsigned)(dq - c) >= W) p0[r] = NEG;
        if ((unsigned)(dq - c - 32) >= W) p1[r] = NEG;
    }
}
__device__ __forceinline__ void partialSM(f32x16& p0, f32x16& p1, float& m_reg, float& mn, float& alpha) {
    float pmax = p0[0]; for (int r = 1; r < 16; ++r) pmax = fmaxf(pmax, p0[r]); for (int r = 0; r < 16; ++r) pmax = fmaxf(pmax, p1[r]);
    { float pa_ = pmax, pb_ = pmax; half_swap(pa_, pb_); pmax = fmaxf(pa_, pb_); }
    constexpr float C2 = 1.4426950408889634f * SCALE;
    if (__builtin_expect(__all((pmax - m_reg) * SCALE <= THR), 1)) { mn = m_reg; alpha = 1.f; }
    else { mn = fmaxf(m_reg, pmax); alpha = __builtin_amdgcn_exp2f((m_reg - mn) * C2); m_reg = mn; }
    const float mnL = -mn * C2;
    for (int r = 0; r < 16; ++r) p0[r] = fmaf(p0[r], C2, mnL); for (int r = 0; r < 16; ++r) p1[r] = fmaf(p1[r], C2, mnL);
    for (int r = 0; r < 16; ++r) p0[r] = __builtin_amdgcn_exp2f(p0[r]);
}
__device__ __forceinline__ void finishSM(f32x16& p0, f32x16& p1, float alpha, float& l_reg, bf16x8& pa0, bf16x8& pa1, bf16x8& pa2, bf16x8& pa3) {
    for (int r = 0; r < 16; ++r) p1[r] = __builtin_amdgcn_exp2f(p1[r]);
    float ps = 0; for (int r = 0; r < 16; ++r) ps += p0[r]; for (int r = 0; r < 16; ++r) ps += p1[r];
    { float pa_ = ps, pb_ = ps; half_swap(pa_, pb_); ps = pa_ + pb_; }
    l_reg = l_reg * alpha + ps;
#define PK4(P, B_, OUT) do { unsigned a0 = cvtpk(P[B_+0], P[B_+1]), a1 = cvtpk(P[B_+2], P[B_+3]);                          \
        unsigned b0 = cvtpk(P[B_+4], P[B_+5]), b1 = cvtpk(P[B_+6], P[B_+7]);                                             \
        auto r0 = __builtin_amdgcn_permlane32_swap(a0, b0, false, false); auto r1 = __builtin_amdgcn_permlane32_swap(a1, b1, false, false); \
        u32x4 w = {r0[0], r1[0], r0[1], r1[1]}; OUT = *reinterpret_cast<bf16x8*>(&w); } while (0)
    PK4(p0, 0, pa0); PK4(p0, 8, pa1); PK4(p1, 0, pa2); PK4(p1, 8, pa3);
#undef PK4
}
template <int KB, bool SK>
__device__ __forceinline__ void qkt(f32x16& p0, f32x16& p1, const char* K_lds, int r32, int hi, const bf16x8* qr, bool act, float e0, float beta) {
    if (SK && !act) { const float NEG = -__builtin_inff();
#pragma unroll
        for (int r = 0; r < 16; ++r) { p0[r] = NEG; p1[r] = NEG; } return; }
    { const float b8 = 8.f * beta, b32 = 32.f * beta;
      p0[0] = e0; p0[1] = p0[0] + beta; p0[2] = p0[1] + beta; p0[3] = p0[2] + beta;
#pragma unroll
      for (int r = 4; r < 16; ++r) p0[r] = p0[r - 4] + b8;
#pragma unroll
      for (int r = 0; r < 16; ++r) p1[r] = p0[r] + b32; }
    const char* kb[4];
#pragma unroll
    for (int dd = 0; dd < 4; ++dd) kb[dd] = K_lds + KB * SHM_K + KSWZ(r32, (dd * 16 + hi * 8) * 2);
#pragma unroll
    for (int d0 = 0; d0 < 8; ++d0) { const char* a = kb[d0 & 3] + (d0 >> 2) * 128;
        bf16x8 b0 = *reinterpret_cast<const bf16x8*>(a);
        bf16x8 b1 = *reinterpret_cast<const bf16x8*>(a + 32 * 256);
        p0 = __builtin_amdgcn_mfma_f32_32x32x16_bf16(b0, qr[d0], p0, 0, 0, 0);
        p1 = __builtin_amdgcn_mfma_f32_32x32x16_bf16(b1, qr[d0], p1, 0, 0, 0); }
}
template <int VB, bool SK>
__device__ __forceinline__ void pv_tile(f32x16* o, int vb0, bf16x8 pa0, bf16x8 pa1, bf16x8 pa2, bf16x8 pa3, bool act) {
    if (SK && !act) return;
#define TRRD(dst, off) asm volatile("ds_read_b64_tr_b16 %0, %1 offset:%2" : "=&v"(dst) : "v"(vb0), "i"(off) : "memory")
#define PV_D0(d0) do { s16x4 l0, l1, l2, l3, h0, h1, h2, h3; constexpr int b_ = VB * SHM_V + v_rd_off(d0, 0, 0);     \
        TRRD(l0, b_); TRRD(h0, b_ + 2048); TRRD(l1, b_ + 4096); TRRD(h1, b_ + 6144); TRRD(l2, b_ + 8192); TRRD(h2, b_ + 10240); TRRD(l3, b_ + 12288); TRRD(h3, b_ + 14336); \
        asm volatile("s_waitcnt lgkmcnt(0)" ::: "memory"); SBAR();                 \
        o[d0] = __builtin_amdgcn_mfma_f32_32x32x16_bf16(pa0, (bf16x8){l0[0], l0[1], l0[2], l0[3], h0[0], h0[1], h0[2], h0[3]}, o[d0], 0, 0, 0);   \
        o[d0] = __builtin_amdgcn_mfma_f32_32x32x16_bf16(pa1, (bf16x8){l1[0], l1[1], l1[2], l1[3], h1[0], h1[1], h1[2], h1[3]}, o[d0], 0, 0, 0);   \
        o[d0] = __builtin_amdgcn_mfma_f32_32x32x16_bf16(pa2, (bf16x8){l2[0], l2[1], l2[2], l2[3], h2[0], h2[1], h2[2], h2[3]}, o[d0], 0, 0, 0);   \
        o[d0] = __builtin_amdgcn_mfma_f32_32x32x16_bf16(pa3, (bf16x8){l3[0], l3[1], l3[2], l3[3], h3[0], h3[1], h3[2], h3[3]}, o[d0], 0, 0, 0); } while (0)
    PV_D0(0); PV_D0(1); PV_D0(2); PV_D0(3);
#undef PV_D0
#undef TRRD
}

template <class TIn, class TOut> struct BlockRef { const TIn* Q; const TIn* K; const TIn* V; TOut* O; float* L; int P0; int pitch; int opitch; int lpitch; float beta; };
template <class TIn> struct Seam {
    bf16x8 qr[8];
    bf16x8 st_v0, st_v1, st_k0, st_k1; f32x4 sf0, sf1, sf2, sf3;
    f32x4 tq[16];
};
__device__ __forceinline__ int swa_jlo(int P0, int W) { const int lowk = P0 - W + 1; return lowk > 0 ? lowk / KVBLK : 0; }
#define ROW(p, pt, k0, rr) ((p) + (size_t)((k0) + (rr)) * (size_t)(pt) + sc)
#define VMW() asm volatile("s_waitcnt vmcnt(0)" ::: "memory")
#define VMWN(n) asm volatile("s_waitcnt vmcnt(%0)" :: "i"(n) : "memory")
#define SLOAD_H(Kp, Vp, pt, k0) do { S.st_v0 = load8<TIn>(ROW(Vp, pt, k0, sr)); S.st_v1 = load8<TIn>(ROW(Vp, pt, k0, 32 + sr));              \
                         S.st_k0 = load8<TIn>(ROW(Kp, pt, k0, sr)); S.st_k1 = load8<TIn>(ROW(Kp, pt, k0, 32 + sr)); } while (0)
#define SWRITE_HK(bf) do { *(bf16x8*)(K_lds + (bf) * SHM_K + kws) = S.st_k0; *(bf16x8*)(K_lds + (bf) * SHM_K + kws + 32 * 256) = S.st_k1; } while (0)
#define SWRITE_HV(bf) do { *(bf16x8*)(V_lds + (bf) * SHM_V + vst0) = S.st_v0; *(bf16x8*)(V_lds + (bf) * SHM_V + vst1) = S.st_v1; } while (0)
#define SWRITE_H(bf) do { SWRITE_HV(bf); SWRITE_HK(bf); } while (0)
#define SLOAD_F(p, k0) do { S.sf0 = *(const f32x4*)ROW(p, D, k0, sr); S.sf1 = *(const f32x4*)(ROW(p, D, k0, sr) + 4);                \
                            S.sf2 = *(const f32x4*)ROW(p, D, k0, 32 + sr); S.sf3 = *(const f32x4*)(ROW(p, D, k0, 32 + sr) + 4); } while (0)
#define SWRITE_KF(bf) do { *(bf16x8*)(K_lds + (bf) * SHM_K + kws) = pack8(S.sf0, S.sf1); *(bf16x8*)(K_lds + (bf) * SHM_K + kws + 32 * 256) = pack8(S.sf2, S.sf3); } while (0)
#define SWRITE_VF(bf) do { *(bf16x8*)(V_lds + (bf) * SHM_V + vst0) = pack8(S.sf0, S.sf1); *(bf16x8*)(V_lds + (bf) * SHM_V + vst1) = pack8(S.sf2, S.sf3); } while (0)
template <class TIn, class TOut>
__device__ __forceinline__ void causal_swa_prime(const BlockRef<TIn, TOut>& cur, int W, char* lds, Seam<TIn>& S, const int wv) {
    constexpr bool F32 = same_t<TIn, float>::v;
    const int tid = tid_of(wv), wid = __builtin_amdgcn_readfirstlane(tid >> 6), lane = tid & 63, r32 = lane & 31, hi = lane >> 5;
    const int sr = tid >> 4, sc = (tid & 15) * 8, kws = KSWZ(sr, sc * 2); char* K_lds = lds + 2 * SHM_V;
    const int kb0 = swa_jlo(cur.P0, W) * KVBLK;
    for (int d0 = 0; d0 < 8; ++d0) S.qr[d0] = load8<TIn>(cur.Q + (size_t)(wid * QBLK + r32) * (size_t)cur.pitch + d0 * 16 + hi * 8);
    if constexpr (F32) { SLOAD_F((const float*)cur.K, kb0); VMW(); SWRITE_KF(0); SBAR(); SLOAD_F((const float*)cur.V, kb0); }
    else { SLOAD_H(cur.K, cur.V, cur.pitch, kb0); VMW(); SWRITE_HK(0); }
    __syncthreads();
}
template <class TIn, class TOut>
__device__ __forceinline__ void causal_swa_block(const BlockRef<TIn, TOut>& cur, const BlockRef<TIn, TOut>& nxt, int skv, int W, char* lds, Seam<TIn>& S, const int wv) {
    constexpr bool F32 = same_t<TIn, float>::v;
    const int tid = tid_of(wv), wid = __builtin_amdgcn_readfirstlane(tid >> 6), lane = tid & 63, r32 = lane & 31, hi = lane >> 5;
    const int j_lo = swa_jlo(cur.P0, W);
    int j_hi = (cur.P0 + QB - 1) / KVBLK + 1; if (j_hi > skv / KVBLK) j_hi = skv / KVBLK;
    const int NT = j_hi - j_lo;
    const int kbn = swa_jlo(nxt.P0, W) * KVBLK;
    const int qlo = cur.P0 + wid * QBLK, qm = qlo + r32 - 4 * hi;
    char* V_lds = lds; char* K_lds = lds + 2 * SHM_V;
    float* ws = (float*)(lds + 2 * SHM_V + 2 * SHM_K) + wid * 64; float* li_l = ws, * al_l = ws + 32;
    float m_reg = -1e30f, l_reg = 0; f32x16 o[4] = {};
    const int sr = tid >> 4, sc = (tid & 15) * 8, vst0 = v_st(sr, sc), vst1 = v_st(32 + sr, sc), kws = KSWZ(sr, sc * 2);
    const int vb0 = (int)(uintptr_t)V_lds + v_rd_base(lane);
    const TIn* Kh = cur.K; const TIn* Vh = cur.V; const int pch = cur.pitch; const float beta = cur.beta;
#define RESC(a) do { if (__any((a) < 1.f)) { if (hi == 0) al_l[r32] = (a); asm volatile("s_waitcnt lgkmcnt(0)" ::: "memory");              \
                     for (int d_ = 0; d_ < 4; ++d_) for (int r = 0; r < 16; ++r) o[d_][r] *= al_l[crow(r, hi)]; } } while (0)
#define KBASE(t) ((j_lo + (t)) * KVBLK)
#define ACT(t) (KBASE(t) <= qlo + QBLK - 1 && KBASE(t) + KVBLK - 1 >= qlo - W + 1)
#define MASKT(P0_, P1_, t) do { const int kb_ = KBASE(t); if ((!SK || ACT(t)) && (kb_ + KVBLK - 1 > qlo || kb_ <= qlo + QBLK - 1 - W)) mask_tile(P0_, P1_, qm - kb_, (unsigned)W); } while (0)
    constexpr int NQL = F32 ? 16 : 8;
    constexpr bool SK = WSKIP && !F32;
#define SEAM_K0() do { VMWN(NQL); if constexpr (F32) { SWRITE_KF(0); SBAR(); SLOAD_F((const float*)nxt.V, kbn); } else { SWRITE_HK(0); } SBAR(); } while (0)
    f32x16 pA0, pA1, pB0, pB1; float mnA, mnB, alA, alB; bf16x8 pa0, pa1, pa2, pa3;
    if constexpr (F32) { VMW(); SWRITE_VF(0); SBAR(); } else { SWRITE_HV(0); SBAR(); }
    if (NT > 1) { if constexpr (F32) SLOAD_F((const float*)Kh, KBASE(1)); else SLOAD_H(Kh, Vh, pch, KBASE(1)); }
    SBAR(); qkt<0, SK>(pA0, pA1, K_lds, r32, hi, S.qr, ACT(0), -beta * (float)(qm - KBASE(0)), beta);
    if constexpr (F32) { if (NT > 1) { VMW(); SWRITE_KF(1); SBAR(); SLOAD_F((const float*)Vh, KBASE(1)); } }
    MASKT(pA0, pA1, 0); partialSM(pA0, pA1, m_reg, mnA, alA);
    if (NT > 1) { VMW(); if constexpr (F32) { SWRITE_VF(1); SBAR(); if (NT > 2) SLOAD_F((const float*)Kh, KBASE(2)); } else SWRITE_H(1); }
    __syncthreads();
#define HALF_STEP(PX0, PX1, mnX, alX, PY0, PY1, alY, t, KB, VB, SB) do {                                                      \
        SBAR(); qkt<KB, SK>(PX0, PX1, K_lds, r32, hi, S.qr, ACT(t), -beta * (float)(qm - KBASE(t)), beta);                                             \
        finishSM(PY0, PY1, alY, l_reg, pa0, pa1, pa2, pa3); SBAR();                                                           \
        if ((t) + 1 < NT) { if constexpr (F32) { VMW(); SWRITE_KF(SB); SBAR(); SLOAD_F((const float*)Vh, KBASE((t) + 1)); }  \
                            else { SLOAD_H(Kh, Vh, pch, KBASE((t) + 1)); } SBAR(); }                                               \
        pv_tile<VB, SK>(o, vb0, pa0, pa1, pa2, pa3, ACT((t) - 1)); MASKT(PX0, PX1, (t)); partialSM(PX0, PX1, m_reg, mnX, alX);                                        \
        __syncthreads();                                                                                                      \
        if ((t) + 1 < NT) { VMW(); if constexpr (F32) { SWRITE_VF(SB); SBAR(); if ((t) + 2 < NT) SLOAD_F((const float*)Kh, KBASE((t) + 2)); } \
                            else { SWRITE_H(SB); } }                                                                          \
        RESC(alX); __syncthreads(); } while (0)
    for (int t = 1; t + 1 < NT; t += 2) {
        HALF_STEP(pB0, pB1, mnB, alB, pA0, pA1, alA, t, 1, 0, 0);
        HALF_STEP(pA0, pA1, mnA, alA, pB0, pB1, alB, t + 1, 0, 1, 1);
    }
    const bool even = (NT & 1) == 0;
    if (even) { SBAR(); qkt<1, SK>(pB0, pB1, K_lds, r32, hi, S.qr, ACT(NT - 1), -beta * (float)(qm - KBASE(NT - 1)), beta); SBAR(); }
#define QROW(e) (nxt.Q + (size_t)(wid * QBLK + r32) * D + ((e) >> 1) * 16 + hi * 8 + ((e) & 1) * 4)
    if constexpr (F32) { SLOAD_F((const float*)nxt.K, kbn); SBAR();
#pragma unroll
        for (int e = 0; e < 8; ++e) S.tq[e] = *(const f32x4*)QROW(e); }
    else { SLOAD_H(nxt.K, nxt.V, nxt.pitch, kbn); SBAR();
#pragma unroll
        for (int d0 = 0; d0 < 8; ++d0) S.qr[d0] = load8<TIn>(nxt.Q + (size_t)(wid * QBLK + r32) * (size_t)nxt.pitch + d0 * 16 + hi * 8); }
    SBAR();
    finishSM(pA0, pA1, alA, l_reg, pa0, pa1, pa2, pa3); SBAR();
    if constexpr (F32) {
#pragma unroll
        for (int e = 8; e < 16; ++e) S.tq[e] = *(const f32x4*)QROW(e); SBAR(); }
#undef QROW
    pv_tile<0, SK>(o, vb0, pa0, pa1, pa2, pa3, ACT(even ? NT - 2 : NT - 1));
    if (even) { MASKT(pB0, pB1, NT - 1); partialSM(pB0, pB1, m_reg, mnB, alB); __syncthreads(); RESC(alB);
        finishSM(pB0, pB1, alB, l_reg, pa0, pa1, pa2, pa3); SBAR(); pv_tile<1, SK>(o, vb0, pa0, pa1, pa2, pa3, ACT(NT - 1)); }
    SBAR(); SEAM_K0();
    if (hi == 0) { li_l[r32] = l_reg; cur.L[(size_t)(wid * QBLK + r32) * (size_t)cur.lpitch] = m_reg * SCALE + __logf(l_reg); }
    asm volatile("s_waitcnt lgkmcnt(0)" ::: "memory");
    float rli[16];
#pragma unroll
    for (int r = 0; r < 16; ++r) rli[r] = __builtin_amdgcn_rcpf(li_l[crow(r, hi)]);
    TOut* Ow = cur.O + (size_t)(wid * QBLK) * (size_t)cur.opitch; const size_t opch = (size_t)cur.opitch;
    if constexpr (same_t<TOut, float>::v) {
#pragma unroll
        for (int r = 0; r < 16; ++r) { const int orow = crow(r, hi);
#pragma unroll
            for (int d0 = 0; d0 < 4; ++d0) Ow[(size_t)orow * opch + d0 * 32 + r32] = o[d0][r] * rli[r]; }
    } else {
        constexpr int EST = 72, ETILE = D * EST;
        char* T = lds + LDS_BYTES + wid * ETILE;
#pragma unroll
        for (int d0 = 0; d0 < 4; ++d0)
#pragma unroll
            for (int rr = 0; rr < 4; ++rr) { typedef unsigned u32x2 __attribute__((ext_vector_type(2))); u32x2 w;
                w.x = cvtpk(o[d0][4 * rr] * rli[4 * rr], o[d0][4 * rr + 1] * rli[4 * rr + 1]); w.y = cvtpk(o[d0][4 * rr + 2] * rli[4 * rr + 2], o[d0][4 * rr + 3] * rli[4 * rr + 3]);
                *(u32x2*)(T + (32 * d0 + r32) * EST + (8 * rr + 4 * hi) * 2) = w; }
        asm volatile("s_waitcnt lgkmcnt(0)" ::: "memory");
        { const int g = (lane >> 4) & 1, i16 = lane & 15, q = i16 >> 2, p = i16 & 3;
          const int abase = (int)(uintptr_t)T + (8 * hi + q) * EST + (16 * g + 4 * p) * 2;
          TOut* orow = Ow + (size_t)(16 * g + i16) * opch + 8 * hi;
#pragma unroll
          for (int t = 0; t < 8; ++t) { s16x4 lo, hh;
              asm volatile("ds_read_b64_tr_b16 %0, %1 offset:%2" : "=&v"(lo) : "v"(abase), "i"(16 * t * EST) : "memory");
              asm volatile("ds_read_b64_tr_b16 %0, %1 offset:%2" : "=&v"(hh) : "v"(abase), "i"(16 * t * EST + 4 * EST) : "memory");
              asm volatile("s_waitcnt lgkmcnt(0)" : "+v"(lo), "+v"(hh) :: "memory");
              const bf16x8 ov = {lo[0], lo[1], lo[2], lo[3], hh[0], hh[1], hh[2], hh[3]};
              *(bf16x8*)(orow + 16 * t) = ov; } }
    }
    if constexpr (F32) {
#pragma unroll
        for (int d0 = 0; d0 < 8; ++d0) S.qr[d0] = pack8(S.tq[2 * d0], S.tq[2 * d0 + 1]); }
    __syncthreads();
#undef RESC
#undef KBASE
#undef ACT
#undef MASKT
#undef SEAM_K0
#undef HALF_STEP
}
#undef ROW
#undef VMW
#undef VMWN
#undef SLOAD_H
#undef SWRITE_HK
#undef SWRITE_HV
#undef SWRITE_H
#undef SLOAD_F
#undef SWRITE_KF
#undef SWRITE_VF

#undef KSWZ
#undef SBAR
}

typedef unsigned short bf16;
typedef unsigned v4u __attribute__((ext_vector_type(4)));
typedef float f32x4 __attribute__((ext_vector_type(4)));
constexpr int D_MODEL = 4096, BATCH = 2, SEQ = 4096, DEPTH = 2, HEAD_DIM = 128, D_ATTN = 2048, D_SGU = 2048, NH = 16, NG = 16, CHUNK = 128;
constexpr int N_IN = 10240, D_FF = 11008, N_UP = 2 * D_FF, M_TOK = BATCH * SEQ;
constexpr float NORM_EPS = 1e-6f;
constexpr int ZQ = 0, ZK = 2048, ZV = 4096, ZU = 6144, ZV2 = 8192;
constexpr int NWAVES = 8, NTHREADS = 512;
constexpr int NQ8 = 8192;
constexpr int RING_BYTES = 131072, MISC_OFF = 140 * 1024, LDS_BYTES = 147456;
constexpr size_t MiB = 1u << 20;
constexpr size_t SZ_WIN = (size_t)N_IN * D_MODEL * 2, SZ_WOUT = (size_t)D_MODEL * D_MODEL * 2, SZ_WUP = (size_t)N_UP * D_MODEL * 2, SZ_WDN = (size_t)D_MODEL * D_FF * 2;
constexpr size_t OFF_CTL = 0, OFF_RS = 16384, RS_BYTES = (size_t)M_TOK * 8, CTL_BYTES = OFF_RS + 5 * RS_BYTES;
constexpr size_t OFF_WIN = 1 * MiB, OFF_WOUT = OFF_WIN + 2 * SZ_WIN, OFF_WUP = OFF_WOUT + 2 * SZ_WOUT, OFF_WDN = OFF_WUP + 2 * SZ_WUP, OFF_H = OFF_WDN + 2 * SZ_WDN;
constexpr size_t OFF_Z = OFF_H + (size_t)M_TOK * D_MODEL * 2, OFF_MX = OFF_Z + (size_t)M_TOK * N_IN * 2, OFF_UP = OFF_MX + (size_t)M_TOK * D_MODEL * 2;
constexpr size_t OFF_ACT = OFF_UP + (size_t)M_TOK * N_UP * 2, OFF_OC = OFF_ACT + (size_t)M_TOK * D_FF * 2, OFF_LSE = OFF_OC + (size_t)3 * M_TOK * D_ATTN * 2, OFF_U4 = OFF_LSE + (size_t)3 * M_TOK * NH * 4, OFF_SB = OFF_U4 + (size_t)(M_TOK / 64) * 4 * N_UP * 4, OFF_SA = OFF_SB + (size_t)DEPTH * N_UP * 4, OFF_XQ = OFF_SA + (size_t)M_TOK * 4, WS_END = OFF_XQ + (size_t)M_TOK * D_MODEL;
constexpr size_t OFF_WINQ = OFF_UP, OFF_SBIN = OFF_WINQ + (size_t)DEPTH * NQ8 * D_MODEL;
static_assert(OFF_SBIN + (size_t)DEPTH * NQ8 * 4 <= OFF_ACT, "int8 input-projection weights fit");
static_assert(CTL_BYTES <= OFF_WIN && XCD_BAR_WORDS * 4 <= OFF_RS, "barrier words inside the memset region");

__device__ __forceinline__ unsigned f2bf(float f) { unsigned u = __builtin_bit_cast(unsigned, f); return (u + 0x7fffu + ((u >> 16) & 1u)) >> 16; }
__device__ __forceinline__ unsigned pk2(float lo, float hi) { return f2bf(lo) | (f2bf(hi) << 16); }
__device__ __forceinline__ float bf2f(unsigned short b) { return __builtin_bit_cast(float, (unsigned)b << 16); }
__device__ __forceinline__ float bflo(unsigned w) { return __builtin_bit_cast(float, w << 16); }
__device__ __forceinline__ float bfhi(unsigned w) { return __builtin_bit_cast(float, w & 0xffff0000u); }
#define LDS_WAIT() asm volatile("s_waitcnt lgkmcnt(0)" ::: "memory")

constexpr int CVT_STRIDE = 192, CVT_TILE = 64 * CVT_STRIDE;
struct CvtRegs { f32x4 v[16]; };
__device__ __forceinline__ void cvt_item_kn(int item, int nblk, int kbw, int& kb, int& nb) { const int nbw = 32 / kbw, st = item >> 5, w = item & 31, nst = nblk / nbw; const int sk = st / nst, sn = st - sk * nst; kb = kbw * sk + (w % kbw); nb = nbw * sn + (w / kbw); }
__device__ __forceinline__ void cvt_load(CvtRegs& R, const float* W, int N, int item, int lane, int nblk, int kbw) {
    int kb, nb; cvt_item_kn(item, nblk, kbw, kb, nb); const float* p = W + (size_t)(64 * kb + (lane >> 4)) * N + 64 * nb + 4 * (lane & 15);
#pragma unroll
    for (int i = 0; i < 16; ++i) R.v[i] = *(const f32x4*)(p + (size_t)(4 * i) * N);
}
__device__ __forceinline__ void cvt_store(const CvtRegs& R, int K, int N, bf16* WT, LAS unsigned char* tile, int item, int lane, int nblk, int kbw, bool glu, const float* gk) {
    int kb, nb; cvt_item_kn(item, nblk, kbw, kb, nb); const int k0 = 64 * kb, n0 = 64 * nb;
    const int half = N / 2, r0 = glu ? ((n0 < half) ? 256 * (n0 >> 7) + (n0 & 127) : 256 * ((n0 - half) >> 7) + 128 + ((n0 - half) & 127)) : n0;
    { LAS unsigned char* wp = tile + (lane >> 4) * CVT_STRIDE + 8 * (lane & 15);
#pragma unroll
      for (int i = 0; i < 16; ++i) { const float gg = gk ? gk[k0 + 4 * i + (lane >> 4)] : 1.f; const f32x4 x = R.v[i] * gg;
          typedef unsigned u32x2 __attribute__((ext_vector_type(2))); u32x2 w; w.x = pk2(x.x, x.y); w.y = pk2(x.z, x.w); *(LAS u32x2*)(wp + 4 * i * CVT_STRIDE) = w; } }
    LDS_WAIT();
    { const int hh = lane >> 5, g = (lane >> 4) & 1, i16 = lane & 15, q = i16 >> 2, p = i16 & 3;
      const int abase = (int)(uintptr_t)tile + (8 * hh + q) * CVT_STRIDE + (16 * g + 4 * p) * 2;
      bf16* orow = WT + (size_t)(r0 + 16 * g + i16) * K + k0 + 8 * hh;
#pragma unroll
      for (int nb2 = 0; nb2 < 2; ++nb2)
#pragma unroll
          for (int t = 0; t < 4; ++t) { typedef short s16x4 __attribute__((ext_vector_type(4))); s16x4 lo, hi;
              asm volatile("ds_read_b64_tr_b16 %0, %1 offset:%2" : "=&v"(lo) : "v"(abase), "i"(16 * t * CVT_STRIDE + 64 * nb2) : "memory");
              asm volatile("ds_read_b64_tr_b16 %0, %1 offset:%2" : "=&v"(hi) : "v"(abase), "i"(16 * t * CVT_STRIDE + 4 * CVT_STRIDE + 64 * nb2) : "memory");
              asm volatile("s_waitcnt lgkmcnt(0)" : "+v"(lo), "+v"(hi) :: "memory");
              typedef short s16x8 __attribute__((ext_vector_type(8))); const s16x8 o = {lo[0], lo[1], lo[2], lo[3], hi[0], hi[1], hi[2], hi[3]};
              *(s16x8*)(orow + (size_t)(32 * nb2) * K + 16 * t) = o; } }
    LDS_WAIT();
}
__device__ __forceinline__ void phase_convert(const float* W, int K, int N, bf16* WT, LAS unsigned char* lds, int gw, int NGW, int wave, int lane, const float* gk, bool glu = false, int ld = 0) {
    LAS unsigned char* tile = lds + wave * CVT_TILE;
    const int nblk = N / 64, items = (K / 64) * nblk, kbw = ((K / 64) % 8 == 0) ? 8 : 4; if (ld == 0) ld = N;
    int it = gw; if (it >= items) return;
    CvtRegs A, B; cvt_load(A, W, ld, it, lane, nblk, kbw);
    for (;;) {
        const int it1 = it + NGW; const bool h1 = it1 < items; if (h1) cvt_load(B, W, ld, it1, lane, nblk, kbw);
        cvt_store(A, K, N, WT, tile, it, lane, nblk, kbw, glu, gk);
        if (!h1) break;
        const int it2 = it1 + NGW; const bool h2 = it2 < items; if (h2) cvt_load(A, W, ld, it2, lane, nblk, kbw);
        cvt_store(B, K, N, WT, tile, it1, lane, nblk, kbw, glu, gk);
        if (!h2) break;
        it = it2;
    }
}
__device__ __forceinline__ int glu_row(int n, int N) { const int half = N / 2; return (n < half) ? 256 * (n >> 7) + (n & 127) : 256 * ((n - half) >> 7) + 128 + ((n - half) & 127); }
constexpr int ST_STRIDE = 528, ST_TILE = 32 * ST_STRIDE, ST_RED = NWAVES * ST_TILE;
static_assert(ST_RED + 2048 <= MISC_OFF, "strip tiles below the control words");
__device__ __forceinline__ unsigned pkbf(float lo, float hi) { unsigned r; asm("v_cvt_pk_bf16_f32 %0, %1, %2" : "=v"(r) : "v"(lo), "v"(hi)); return r; }
__device__ __forceinline__ void strip8(const float* W, int N, int n0, int r0, const float* gk, signed char* WQ, float* sB, LAS unsigned char* lds, int par, int wave, int lane) {
    const int a = lane & 7, b = lane >> 3, kw = 512 * wave;
    const float* p = W + (size_t)(kw + 4 * b) * N + n0 + 4 * a;
    const float* gp = gk + kw + 4 * b;
    unsigned P[16][4][2];
    f32x4 mx = {0.f, 0.f, 0.f, 0.f};
    f32x4 S[2][8], Gn[2][2];
#define ST_LOAD(buf, bi) do { _Pragma("unroll") for (int q = 0; q < 8; ++q) S[buf][q] = *(const f32x4*)(p + (size_t)(32 * (2 * (bi) + (q >> 2)) + (q & 3)) * N); \
        Gn[buf][0] = *(const f32x4*)(gp + 64 * (bi)); Gn[buf][1] = *(const f32x4*)(gp + 64 * (bi) + 32); } while (0)
    ST_LOAD(0, 0);
#pragma unroll
    for (int bi = 0; bi < 8; ++bi) {
        if (bi < 7) { if (bi & 1) ST_LOAD(0, bi + 1); else ST_LOAD(1, bi + 1); }
        __builtin_amdgcn_sched_barrier(0);
#pragma unroll
        for (int mm = 0; mm < 2; ++mm) { const int m = 2 * bi + mm; f32x4 x[4];
#pragma unroll
            for (int c = 0; c < 4; ++c) { x[c] = S[bi & 1][4 * mm + c] * Gn[bi & 1][mm][c];
                mx.x = fmaxf(mx.x, fabsf(x[c].x)); mx.y = fmaxf(mx.y, fabsf(x[c].y)); mx.z = fmaxf(mx.z, fabsf(x[c].z)); mx.w = fmaxf(mx.w, fabsf(x[c].w)); }
#pragma unroll
            for (int e = 0; e < 4; ++e) { P[m][e][0] = pkbf(x[0][e], x[1][e]); P[m][e][1] = pkbf(x[2][e], x[3][e]); } }
        __builtin_amdgcn_sched_barrier(0);
    }
#undef ST_LOAD
    LAS float* red = (LAS float*)(lds + ST_RED + par * 1024);
#pragma unroll
    for (int e = 0; e < 4; ++e) { float v = mx[e]; v = fmaxf(v, lane_xor<8>(v)); v = fmaxf(v, lane_xor<16>(v)); float va = v, vb = v; half_swap(va, vb); mx[e] = fmaxf(va, vb); }
    if (b == 0) *(LAS f32x4*)(red + wave * 32 + 4 * a) = mx;
    __syncthreads();
    f32x4 cm = *(LAS f32x4*)(red + 4 * a);
#pragma unroll
    for (int w2 = 1; w2 < NWAVES; ++w2) { const f32x4 o = *(LAS f32x4*)(red + w2 * 32 + 4 * a); cm.x = fmaxf(cm.x, o.x); cm.y = fmaxf(cm.y, o.y); cm.z = fmaxf(cm.z, o.z); cm.w = fmaxf(cm.w, o.w); }
    f32x4 inv;
#pragma unroll
    for (int e = 0; e < 4; ++e) { cm[e] = bflo(pkbf(cm[e], cm[e])); inv[e] = cm[e] > 0.f ? 127.f / cm[e] : 0.f; }
    if (wave == 0 && b == 0) *(f32x4*)(sB + r0 + 4 * a) = cm * (1.f / 127.f);
    LAS unsigned char* tile = lds + wave * ST_TILE;
    { LAS unsigned char* wp = tile + (4 * a) * ST_STRIDE + 4 * b;
#pragma unroll
      for (int m = 0; m < 16; ++m)
#pragma unroll
          for (int e = 0; e < 4; ++e) { const unsigned w0 = P[m][e][0], w1 = P[m][e][1];
              const unsigned t0 = __builtin_bit_cast(unsigned, __builtin_fmaf(bflo(w0), inv[e], 12582912.f)), t1 = __builtin_bit_cast(unsigned, __builtin_fmaf(bfhi(w0), inv[e], 12582912.f));
              const unsigned t2 = __builtin_bit_cast(unsigned, __builtin_fmaf(bflo(w1), inv[e], 12582912.f)), t3 = __builtin_bit_cast(unsigned, __builtin_fmaf(bfhi(w1), inv[e], 12582912.f));
              *(LAS unsigned*)(wp + e * ST_STRIDE + 32 * m) = __builtin_amdgcn_perm(t1, t0, 0x0c0c0400u) | __builtin_amdgcn_perm(t3, t2, 0x04000c0cu); } }
    LDS_WAIT();
    { signed char* orow = WQ + (size_t)(r0 + (lane >> 5)) * D_MODEL + kw + 16 * (lane & 31); LAS unsigned char* rp = tile + (lane >> 5) * ST_STRIDE + 16 * (lane & 31);
#pragma unroll
      for (int i = 0; i < 16; ++i) { const v4u v = *(LAS v4u*)(rp + 2 * i * ST_STRIDE); *(v4u*)(orow + (size_t)(2 * i) * D_MODEL) = v; } }
    LDS_WAIT();
}
__device__ __forceinline__ void phase_strips8(const float* Wup, const float* gup, signed char* WQup, float* sBup, const float* Win, const float* gin, signed char* WQin, float* sBin, LAS unsigned char* lds, int blk, int G, int wave, int lane) {
    constexpr int SPL = N_UP / 32, SPI = NQ8 / 32;
    int par = 0;
    for (int s = blk; s < DEPTH * (SPL + SPI); s += G, par ^= 1) {
        if (s < DEPTH * SPL) { const int cl = s >= SPL ? 1 : 0, n0 = 32 * (s - cl * SPL);
            strip8(Wup + (size_t)cl * D_MODEL * N_UP, N_UP, n0, glu_row(n0, N_UP), gup + (size_t)cl * D_MODEL, WQup + (size_t)cl * N_UP * D_MODEL, sBup + (size_t)cl * N_UP, lds, par, wave, lane); }
        else { const int s2 = s - DEPTH * SPL, cl = s2 >= SPI ? 1 : 0, n0 = 32 * (s2 - cl * SPI);
            strip8(Win + (size_t)cl * D_MODEL * N_IN, N_IN, n0, n0, gin + (size_t)cl * D_MODEL, WQin + (size_t)cl * NQ8 * D_MODEL, sBin + (size_t)cl * NQ8, lds, par, wave, lane); }
    }
}
struct QRow { v4u x[8]; };
__device__ __forceinline__ void qrow_load(QRow& R, const bf16* xb, int row, int lane) { const v4u* xr = (const v4u*)(xb + (size_t)row * D_MODEL) + lane;
#pragma unroll
    for (int j = 0; j < 8; ++j) R.x[j] = xr[64 * j]; }
__device__ __forceinline__ void qrow_store(const QRow& R, signed char* xq, float* sA, int row, int lane) {
    float mx = 0.f;
#pragma unroll
    for (int j = 0; j < 8; ++j) { const unsigned* w = (const unsigned*)&R.x[j];
#pragma unroll
        for (int e = 0; e < 4; ++e) mx = fmaxf(mx, fmaxf(fabsf(bflo(w[e])), fabsf(bfhi(w[e])))); }
    mx = fmaxf(mx, lane_xor<1>(mx)); mx = fmaxf(mx, lane_xor<2>(mx)); mx = fmaxf(mx, lane_xor<4>(mx)); mx = fmaxf(mx, lane_xor<8>(mx)); mx = fmaxf(mx, lane_xor<16>(mx));
    { float ma = mx, mb = mx; half_swap(ma, mb); mx = fmaxf(ma, mb); }
    const float inv = mx > 0.f ? 127.f / mx : 0.f;
    if (lane == 0) sA[row] = mx * (1.f / 127.f);
    typedef unsigned u32x2 __attribute__((ext_vector_type(2)));
    u32x2* o8 = (u32x2*)(xq + (size_t)row * D_MODEL) + lane;
#pragma unroll
    for (int j = 0; j < 8; ++j) { const unsigned* w = (const unsigned*)&R.x[j]; unsigned t[8];
#pragma unroll
        for (int e = 0; e < 4; ++e) { t[2 * e] = __builtin_bit_cast(unsigned, __builtin_fmaf(bflo(w[e]), inv, 12582912.f)); t[2 * e + 1] = __builtin_bit_cast(unsigned, __builtin_fmaf(bfhi(w[e]), inv, 12582912.f)); }
        u32x2 pk; pk.x = __builtin_amdgcn_perm(t[1], t[0], 0x0c0c0400u) | __builtin_amdgcn_perm(t[3], t[2], 0x04000c0cu); pk.y = __builtin_amdgcn_perm(t[5], t[4], 0x0c0c0400u) | __builtin_amdgcn_perm(t[7], t[6], 0x04000c0cu);
        o8[64 * j] = pk; }
}
__device__ __forceinline__ void phase_quant_rows(const bf16* xb, signed char* xq, float* sA, int gw, int NGW, int lane) {
    int row = gw; if (row >= M_TOK) return;
    QRow A, B; qrow_load(A, xb, row, lane);
    for (;;) {
        const int r1 = row + NGW; const bool h1 = r1 < M_TOK; if (h1) qrow_load(B, xb, r1, lane);
        qrow_store(A, xq, sA, row, lane);
        if (!h1) break;
        const int r2 = r1 + NGW; const bool h2 = r2 < M_TOK; if (h2) qrow_load(A, xb, r2, lane);
        qrow_store(B, xq, sA, r1, lane);
        if (!h2) break;
        row = r2;
    }
}
__device__ __forceinline__ void phase_xprep(const float* x, bf16* xb, unsigned long long* rowss, signed char* xq, float* sA, int gw, int NGW, int lane) {
    for (int row = gw; row < M_TOK; row += NGW) {
        const f32x4* xr = (const f32x4*)(x + (size_t)row * D_MODEL) + lane; float s = 0.f, mx = 0.f; unsigned w[16][2];
#pragma unroll
        for (int j = 0; j < 16; ++j) { const f32x4 v = xr[64 * j]; s += (v.x * v.x + v.y * v.y) + (v.z * v.z + v.w * v.w);
            w[j][0] = pk2(v.x, v.y); w[j][1] = pk2(v.z, v.w);
            mx = fmaxf(fmaxf(mx, fmaxf(fabsf(bflo(w[j][0])), fabsf(bfhi(w[j][0])))), fmaxf(fabsf(bflo(w[j][1])), fabsf(bfhi(w[j][1]))));
            unsigned long long* o8 = (unsigned long long*)(xb + (size_t)row * D_MODEL) + lane + 64 * j; *o8 = (unsigned long long)w[j][0] | ((unsigned long long)w[j][1] << 32); }
        s = wave_sum(s);
        if (lane == 0) rowss[row] = (unsigned long long)(long long)__builtin_rintf(s * 16777216.f);
        mx = fmaxf(mx, lane_xor<1>(mx)); mx = fmaxf(mx, lane_xor<2>(mx)); mx = fmaxf(mx, lane_xor<4>(mx)); mx = fmaxf(mx, lane_xor<8>(mx)); mx = fmaxf(mx, lane_xor<16>(mx));
        { float ma = mx, mb = mx; half_swap(ma, mb); mx = fmaxf(ma, mb); }
        const float inv = mx > 0.f ? 127.f / mx : 0.f;
        if (lane == 0) sA[row] = mx * (1.f / 127.f);
        unsigned* o4 = (unsigned*)(xq + (size_t)row * D_MODEL) + lane;
#pragma unroll
        for (int j = 0; j < 16; ++j) { const int q0 = (int)__builtin_rintf(bflo(w[j][0]) * inv), q1 = (int)__builtin_rintf(bfhi(w[j][0]) * inv), q2 = (int)__builtin_rintf(bflo(w[j][1]) * inv), q3 = (int)__builtin_rintf(bfhi(w[j][1]) * inv);
            o4[64 * j] = ((unsigned)q0 & 0xffu) | (((unsigned)q1 & 0xffu) << 8) | (((unsigned)q2 & 0xffu) << 16) | ((unsigned)q3 << 24); }
    }
}
struct FRow { uint2 x[16]; };
__device__ __forceinline__ void frow_load(FRow& R, const bf16* xb, int row, int lane) { const uint2* xr = (const uint2*)(xb + (size_t)row * D_MODEL) + lane;
#pragma unroll
    for (int k = 0; k < 16; ++k) R.x[k] = xr[64 * k]; }
__device__ __forceinline__ void frow_store(const FRow& R, float* out, const unsigned long long* rowss, const float* g, int row, int lane) {
    const float rstd = rsqrtf((float)rowss[row] * (1.f / (16777216.f * D_MODEL)) + NORM_EPS);
    f32x4* orow = (f32x4*)(out + (size_t)row * D_MODEL) + lane; const f32x4* gr = (const f32x4*)g + lane;
#pragma unroll
    for (int k = 0; k < 16; ++k) { const f32x4 ga = gr[64 * k];
        orow[64 * k] = (f32x4){bflo(R.x[k].x) * rstd * ga.x, bfhi(R.x[k].x) * rstd * ga.y, bflo(R.x[k].y) * rstd * ga.z, bfhi(R.x[k].y) * rstd * ga.w}; }
}
__device__ __forceinline__ void phase_final(const bf16* xb, float* out, const unsigned long long* rowss, const float* g, int gw, int NGW, int lane) {
    int row = gw; if (row >= M_TOK) return;
    FRow A, B; frow_load(A, xb, row, lane);
    for (;;) {
        const int r1 = row + NGW; const bool h1 = r1 < M_TOK; if (h1) frow_load(B, xb, r1, lane);
        frow_store(A, out, rowss, g, row, lane);
        if (!h1) break;
        const int r2 = r1 + NGW; const bool h2 = r2 < M_TOK; if (h2) frow_load(A, xb, r2, lane);
        frow_store(B, out, rowss, g, r1, lane);
        if (!h2) break;
        row = r2;
    }
}
constexpr int SGU_STRIDE = 320, SGU_SLOT = CHUNK * SGU_STRIDE;
typedef short sg_bf16x8 __attribute__((ext_vector_type(8)));
typedef short sg_s16x4 __attribute__((ext_vector_type(4)));
typedef float sg_f32x16 __attribute__((ext_vector_type(16)));
__device__ __forceinline__ void phase_sgu(const bf16* Z, const float* sgug, const float* Ws, const float* bs, const float* mixg, bf16* Mx, LAS unsigned char* lds, int blk, int G, int tid, int wv) {
    const int lane = tid & 63, h = lane >> 5, l31 = lane & 31;
    const int uh = wv >> 2, tt = wv & 3;
    const int srow = tid >> 2, sq = tid & 3;
    for (int wq = blk; wq < 256; wq += G) {
        const int g = wq & 15, cq = wq >> 4;
        sg_bf16x8 wf[8];
        { const int t = 32 * tt + l31; const float* wrow = Ws + ((size_t)g * CHUNK + t) * CHUNK;
#pragma unroll
          for (int ks = 0; ks < 8; ++ks) { wf[ks] = sg_bf16x8{0, 0, 0, 0, 0, 0, 0, 0};
              if (ks <= 2 * tt + 1) { const int s0 = 16 * ks + 8 * h; const f32x4 a = *(const f32x4*)(wrow + s0), b = *(const f32x4*)(wrow + s0 + 4);
                  float v[8] = {a.x, a.y, a.z, a.w, b.x, b.y, b.z, b.w};
#pragma unroll
                  for (int e = 0; e < 8; ++e) v[e] = (s0 + e <= t) ? v[e] : 0.f;
                  v4u pk; pk.x = pk2(v[0], v[1]); pk.y = pk2(v[2], v[3]); pk.z = pk2(v[4], v[5]); pk.w = pk2(v[6], v[7]); wf[ks] = __builtin_bit_cast(sg_bf16x8, pk); } } }
        const float bias_t = bs[g * CHUNK + 32 * tt + l31];
        f32x4 sgv[8];
#pragma unroll
        for (int e = 0; e < 8; ++e) sgv[e] = *(const f32x4*)(sgug + g * 128 + sq * 32 + 4 * e);
        for (int rnd = 0; rnd < 2; ++rnd) {
            uint2 uu[4][4];
            { const bf16* up0 = Z + (size_t)((4 * cq + 2 * rnd + uh) * CHUNK + 32 * tt + l31) * N_IN + ZU + g * 128 + 4 * h;
#pragma unroll
              for (int ct = 0; ct < 4; ++ct)
#pragma unroll
                  for (int rq = 0; rq < 4; ++rq) uu[ct][rq] = *(const uint2*)(up0 + 32 * ct + 8 * rq); }
#pragma unroll
            for (int ub = 0; ub < 2; ++ub) { const int row0 = (4 * cq + 2 * rnd + ub) * CHUNK;
                const v4u* vp = (const v4u*)(Z + (size_t)(row0 + srow) * N_IN + ZV2 + g * 128 + sq * 32);
                v4u raw[4]; float x[32]; float ss = 0.f;
#pragma unroll
                for (int e = 0; e < 4; ++e) raw[e] = vp[e];
#pragma unroll
                for (int e = 0; e < 4; ++e) { x[8 * e + 0] = bflo(raw[e].x); x[8 * e + 1] = bfhi(raw[e].x); x[8 * e + 2] = bflo(raw[e].y); x[8 * e + 3] = bfhi(raw[e].y);
                    x[8 * e + 4] = bflo(raw[e].z); x[8 * e + 5] = bfhi(raw[e].z); x[8 * e + 6] = bflo(raw[e].w); x[8 * e + 7] = bfhi(raw[e].w); }
#pragma unroll
                for (int e = 0; e < 32; ++e) ss += x[e] * x[e];
                ss += lane_xor<1>(ss); ss += lane_xor<2>(ss);
                const float rstd = rsqrtf(ss * (1.f / 128.f) + NORM_EPS);
                LAS v4u* dst = (LAS v4u*)(lds + ub * SGU_SLOT + srow * SGU_STRIDE + sq * 64);
#pragma unroll
                for (int e = 0; e < 4; ++e) { v4u o; const f32x4 s0 = sgv[2 * e], s1 = sgv[2 * e + 1];
                    o.x = pk2(x[8 * e + 0] * rstd * s0.x, x[8 * e + 1] * rstd * s0.y); o.y = pk2(x[8 * e + 2] * rstd * s0.z, x[8 * e + 3] * rstd * s0.w);
                    o.z = pk2(x[8 * e + 4] * rstd * s1.x, x[8 * e + 5] * rstd * s1.y); o.w = pk2(x[8 * e + 6] * rstd * s1.z, x[8 * e + 7] * rstd * s1.w); dst[e] = o; } }
            __syncthreads();
            sg_f32x16 acc[4];
#pragma unroll
            for (int ct = 0; ct < 4; ++ct) acc[ct] = sg_f32x16{};
            { const int g4 = lane >> 4, i16 = lane & 15, q = i16 >> 2, p = i16 & 3;
              const int abase = (int)(uintptr_t)(lds + uh * SGU_SLOT) + (8 * h + q) * SGU_STRIDE + (16 * (g4 & 1) + 4 * p) * 2;
#pragma unroll
              for (int ks = 0; ks < 8; ++ks) {
                  if (ks <= 2 * tt + 1) {
#pragma unroll
                      for (int ct = 0; ct < 4; ++ct) { sg_s16x4 lo, hi;
                          asm volatile("ds_read_b64_tr_b16 %0, %1 offset:%2" : "=&v"(lo) : "v"(abase), "i"(16 * ks * SGU_STRIDE + ct * 64) : "memory");
                          asm volatile("ds_read_b64_tr_b16 %0, %1 offset:%2" : "=&v"(hi) : "v"(abase), "i"(16 * ks * SGU_STRIDE + 4 * SGU_STRIDE + ct * 64) : "memory");
                          asm volatile("s_waitcnt lgkmcnt(0)" ::: "memory"); __builtin_amdgcn_sched_barrier(0);
                          acc[ct] = __builtin_amdgcn_mfma_f32_32x32x16_bf16((sg_bf16x8){lo[0], lo[1], lo[2], lo[3], hi[0], hi[1], hi[2], hi[3]}, wf[ks], acc[ct], 0, 0, 0); } } } }
            { const int row = (4 * cq + 2 * rnd + uh) * CHUNK + 32 * tt + l31;
              const float* mg = mixg + D_ATTN + g * 128 + 4 * h;
              float ss = 0.f;
#pragma unroll
              for (int ct = 0; ct < 4; ++ct)
#pragma unroll
                  for (int rq = 0; rq < 4; ++rq) { const uint2 uv = uu[ct][rq];
                      const float u0 = bflo(uv.x), u1 = bfhi(uv.x), u2 = bflo(uv.y), u3 = bfhi(uv.y);
                      float o0 = u0 * (acc[ct][4 * rq + 0] + bias_t), o1 = u1 * (acc[ct][4 * rq + 1] + bias_t), o2 = u2 * (acc[ct][4 * rq + 2] + bias_t), o3 = u3 * (acc[ct][4 * rq + 3] + bias_t);
                      acc[ct][4 * rq + 0] = o0; acc[ct][4 * rq + 1] = o1; acc[ct][4 * rq + 2] = o2; acc[ct][4 * rq + 3] = o3; ss += (o0 * o0 + o1 * o1) + (o2 * o2 + o3 * o3); }
              { float sa = ss, sb = ss; half_swap(sa, sb); ss = sa + sb; }
              const float rstd = rsqrtf(ss * (1.f / 128.f) + NORM_EPS);
              bf16* op = Mx + (size_t)row * D_MODEL + D_ATTN + g * 128 + 4 * h;
#pragma unroll
              for (int ct = 0; ct < 4; ++ct)
#pragma unroll
                  for (int rq = 0; rq < 4; ++rq) { const f32x4 mm = *(const f32x4*)(mg + 32 * ct + 8 * rq);
                      uint2 w; w.x = pk2(acc[ct][4 * rq + 0] * rstd * mm.x, acc[ct][4 * rq + 1] * rstd * mm.y); w.y = pk2(acc[ct][4 * rq + 2] * rstd * mm.z, acc[ct][4 * rq + 3] * rstd * mm.w);
                      *(uint2*)(op + 32 * ct + 8 * rq) = w; } }
            __syncthreads();
        }
    }
}
__device__ __forceinline__ void phase_convfix(const float* U4, const float* cw, const float* cb, bf16* ACT, size_t gtid, size_t nthreads) {
    constexpr int per_row = D_FF / 8, NB = M_TOK / 64; const size_t total = (size_t)NB * per_row;
    for (size_t i = gtid; i < total; i += nthreads) {
        const int blk64 = (int)(i / per_row), c = (int)(i % per_row) * 8;
        if ((blk64 & (SEQ / 64 - 1)) == 0) continue;
        const float* um2 = U4 + ((size_t)(blk64 - 1) * 4 + 2) * N_UP; const float* um1 = um2 + N_UP; const float* u0 = U4 + (size_t)blk64 * 4 * N_UP; const float* u1 = u0 + N_UP;
        float y0[2][8], y1[2][8];
#pragma unroll
        for (int hv = 0; hv < 2; ++hv)
#pragma unroll
            for (int q = 0; q < 2; ++q) { const int cc = hv * D_FF + c + 4 * q;
                const f32x4 a = *(const f32x4*)(um2 + cc), b = *(const f32x4*)(um1 + cc), x0 = *(const f32x4*)(u0 + cc), x1 = *(const f32x4*)(u1 + cc);
                const f32x4 w0 = *(const f32x4*)(cw + cc), w1 = *(const f32x4*)(cw + N_UP + cc), w2 = *(const f32x4*)(cw + 2 * N_UP + cc), bb = *(const f32x4*)(cb + cc);
#pragma unroll
                for (int e = 0; e < 4; ++e) { y0[hv][4 * q + e] = fmaf(w0[e], a[e], fmaf(w1[e], b[e], fmaf(w2[e], x0[e], bb[e]))); y1[hv][4 * q + e] = fmaf(w0[e], b[e], fmaf(w1[e], x0[e], fmaf(w2[e], x1[e], bb[e]))); } }
        float r0[8], r1[8];
#pragma unroll
        for (int e = 0; e < 8; ++e) { const float g0 = y0[0][e], g1 = y1[0][e]; r0[e] = g0 / (1.f + __expf(-g0)) * y0[1][e]; r1[e] = g1 / (1.f + __expf(-g1)) * y1[1][e]; }
        v4u o; o.x = pk2(r0[0], r0[1]); o.y = pk2(r0[2], r0[3]); o.z = pk2(r0[4], r0[5]); o.w = pk2(r0[6], r0[7]);
        *(v4u*)(ACT + (size_t)(blk64 * 64) * D_FF + c) = o;
        o.x = pk2(r1[0], r1[1]); o.y = pk2(r1[2], r1[3]); o.z = pk2(r1[4], r1[5]); o.w = pk2(r1[6], r1[7]);
        *(v4u*)(ACT + (size_t)(blk64 * 64 + 1) * D_FF + c) = o;
    }
}
typedef attn::BlockRef<bf16, bf16> ABlock;
__device__ __forceinline__ ABlock attn_ref(int L, const bf16* Z, bf16* OC, float* LSE) {
    const int c = L >> 9, x = L & 511; const int bh = (x & 7) + 8 * ((x >> 3) & 3), bi = x >> 5;
    const int d = (c == 0) ? 1 : ((c == 1) ? 4 : 16);
    const int r = (c == 0) ? 0 : ((c == 1) ? (bi >> 2) : bi), qb = (c == 0) ? bi : ((c == 1) ? (bi & 3) : 0);
    const int b = bh >> 4, h = bh & 15; const int P0 = qb * attn::QB;
    const size_t row0 = (size_t)b * SEQ + r, rowq = row0 + (size_t)P0 * d;
    ABlock R;
    R.Q = Z + rowq * N_IN + ZQ + h * HEAD_DIM; R.K = Z + row0 * N_IN + ZK + h * HEAD_DIM; R.V = Z + row0 * N_IN + ZV + h * HEAD_DIM;
    R.O = OC + (size_t)c * M_TOK * D_ATTN + rowq * D_ATTN + h * HEAD_DIM; R.L = LSE + (size_t)c * M_TOK * NH + rowq * NH + h;
    R.P0 = P0; R.pitch = d * N_IN; R.opitch = d * D_ATTN; R.lpitch = d * NH;
    { const int j2 = 6 - h + ((c == 0) ? 0 : ((c == 1) ? 4 : 8)); const int n = j2 >> 1;
      R.beta = __builtin_bit_cast(float, (unsigned)(((127 + n) << 23) | ((j2 & 1) ? 0x3504F3 : 0))); }
    return R;
}
__device__ __forceinline__ int attn_skv(int L) { return (L < 512) ? SEQ : ((L < 1024) ? SEQ / 4 : SEQ / 16); }
__device__ __forceinline__ void phase_attn(const bf16* Z, bf16* OC, float* LSE, char* lds, int blk, int G, const int wv) {
    constexpr int TOTAL = 3 * 512, W = 129;
    int L = blk; if (L >= TOTAL) return;
    ABlock cur = attn_ref(L, Z, OC, LSE);
    attn::Seam<bf16> S;
    attn::causal_swa_prime<bf16, bf16>(cur, W, lds, S, wv);
    for (;;) {
        const int Ln = L + G; const bool last = Ln >= TOTAL;
        const ABlock nxt = last ? cur : attn_ref(Ln, Z, OC, LSE);
        attn::causal_swa_block<bf16, bf16>(cur, nxt, attn_skv(L), W, lds, S, wv);
        if (last) break;
        cur = nxt; L = Ln;
    }
}
__device__ __forceinline__ void phase_combine(const bf16* OC, const float* LSE, const float* mixg, bf16* Mx, int gw, int NGW, int lane) {
    const int hq = gw & 3, h = hq * 4 + (lane >> 4), col = h * HEAD_DIM + 8 * (lane & 15);
    const f32x4 g0 = *(const f32x4*)(mixg + col), g1 = *(const f32x4*)(mixg + col + 4);
    constexpr size_t SO = (size_t)M_TOK * D_ATTN, SL = (size_t)M_TOK * NH;
    for (int row = gw >> 2; row < M_TOK; row += 2 * (NGW >> 2)) {
        const int row2 = row + (NGW >> 2); const bool two = row2 < M_TOK; const int rb = two ? row2 : row;
        v4u a[2][3]; float ls[2][3];
#pragma unroll
        for (int u = 0; u < 2; ++u) { const int r = u ? rb : row;
#pragma unroll
            for (int c = 0; c < 3; ++c) { a[u][c] = *(const v4u*)(OC + c * SO + (size_t)r * D_ATTN + col); ls[u][c] = LSE[c * SL + (size_t)r * NH + h]; } }
#pragma unroll
        for (int u = 0; u < 2; ++u) { const int r = u ? rb : row;
            const float mx = fmaxf(ls[u][0], fmaxf(ls[u][1], ls[u][2])); float w0 = __expf(ls[u][0] - mx), w1 = __expf(ls[u][1] - mx), w2 = __expf(ls[u][2] - mx); const float inv = 1.f / (w0 + w1 + w2);
            w0 *= inv; w1 *= inv; w2 *= inv;
            float o[8]; const unsigned* pa = (const unsigned*)&a[u][0]; const unsigned* pb = (const unsigned*)&a[u][1]; const unsigned* pc = (const unsigned*)&a[u][2]; float ss = 0.f;
#pragma unroll
            for (int e = 0; e < 4; ++e) { o[2 * e] = w0 * bflo(pa[e]) + w1 * bflo(pb[e]) + w2 * bflo(pc[e]); o[2 * e + 1] = w0 * bfhi(pa[e]) + w1 * bfhi(pb[e]) + w2 * bfhi(pc[e]); ss += o[2 * e] * o[2 * e] + o[2 * e + 1] * o[2 * e + 1]; }
            ss += lane_xor<1>(ss); ss += lane_xor<2>(ss); ss += lane_xor<4>(ss); ss += lane_xor<8>(ss);
            const float rstd = rsqrtf(ss * (1.f / HEAD_DIM) + NORM_EPS);
            v4u w; w.x = pk2(o[0] * rstd * g0.x, o[1] * rstd * g0.y); w.y = pk2(o[2] * rstd * g0.z, o[3] * rstd * g0.w); w.z = pk2(o[4] * rstd * g1.x, o[5] * rstd * g1.y); w.w = pk2(o[6] * rstd * g1.z, o[7] * rstd * g1.w);
            if (u == 0 || two) *(v4u*)(Mx + (size_t)r * D_MODEL + col) = w; }
    }
}

struct Args { const float* in[14]; float* out; unsigned char* ws; };
typedef const __attribute__((address_space(4))) Args* KArgs;
__global__ void __launch_bounds__(NTHREADS, 2) mega_fwd(Args args) {
    extern __shared__ __attribute__((aligned(16))) unsigned char lds_raw[];
    LAS unsigned char* lds = (LAS unsigned char*)lds_raw;
    volatile LAS unsigned* MISC = (volatile LAS unsigned*)(lds + MISC_OFF);
    const int wv = __builtin_amdgcn_readfirstlane((int)(threadIdx.x >> 6));
    { const int t0 = tid_of(wv); if (t0 < 32) MISC[t0] = 0u; }
    __syncthreads();
#define PHASE_BEGIN() KArgs ka = (KArgs)__builtin_amdgcn_kernarg_segment_ptr(); asm volatile("" : "+s"(ka)); unsigned char* const ws = ka->ws; int wvp = wv; asm volatile("" : "+s"(wvp)); \
    const int tid = tid_of(wvp); const int lane = tid & 63, wave = wvp; int blk_o = blockIdx.x; asm volatile("" : "+s"(blk_o)); int lyr = l; asm volatile("" : "+s"(lyr)); \
    const int G = gridDim.x, blk = blk_o, gw = blk * NWAVES + wave, NGW = G * NWAVES; (void)lane; (void)gw; (void)NGW; (void)blk; (void)G; (void)tid; (void)ws; (void)lyr
#define WSP(T, off) ((T*)(ws + (off)))
#define GRID_BARRIER() do { KArgs kb = (KArgs)__builtin_amdgcn_kernarg_segment_ptr(); asm volatile("" : "+s"(kb)); XcdBarrier bar; bar.bar = (unsigned*)(kb->ws + OFF_CTL); bar.x = xcc; bar.st = MISC + 8; xcd_barrier(bar, wv); } while (0)
    const unsigned xcc = xcd_barrier_post((unsigned*)(args.ws + OFF_CTL), MISC + 8, wv).x;

    { const int l = 0; PHASE_BEGIN();
      phase_xprep(ka->in[0], WSP(bf16, OFF_H), WSP(unsigned long long, OFF_RS), WSP(signed char, OFF_XQ), WSP(float, OFF_SA), gw, NGW, lane);
      phase_strips8(ka->in[9], ka->in[8], WSP(signed char, OFF_WUP), WSP(float, OFF_SB), ka->in[2], ka->in[1], WSP(signed char, OFF_WINQ), WSP(float, OFF_SBIN), lds, blk, G, wave, lane); }
    __syncthreads();
    { const int l = 0; PHASE_BEGIN();
      for (int cl = 0; cl < DEPTH; ++cl) {
        phase_convert(ka->in[2] + (size_t)cl * D_MODEL * N_IN + NQ8, D_MODEL, N_IN - NQ8, WSP(bf16, OFF_WIN) + (size_t)cl * N_IN * D_MODEL + (size_t)NQ8 * D_MODEL, lds, gw, NGW, wave, lane, ka->in[1] + (size_t)cl * D_MODEL, false, N_IN);
        phase_convert(ka->in[7] + (size_t)cl * D_MODEL * D_MODEL, D_MODEL, D_MODEL, WSP(bf16, OFF_WOUT) + (size_t)cl * D_MODEL * D_MODEL, lds, gw, NGW, wave, lane, nullptr);
        phase_convert(ka->in[12] + (size_t)cl * D_FF * D_MODEL, D_FF, D_MODEL, WSP(bf16, OFF_WDN) + (size_t)cl * D_MODEL * D_FF, lds, gw, NGW, wave, lane, nullptr);
      } }
    GRID_BARRIER();

    for (int l = 0; l < DEPTH; ++l) {
        { PHASE_BEGIN();
          pg8::Gemm g{(const bf16*)WSP(signed char, OFF_XQ), (const bf16*)(WSP(signed char, OFF_WINQ) + (size_t)lyr * NQ8 * D_MODEL), M_TOK, NQ8, D_MODEL / 2}; pg8::StaticOrder S; S.init(M_TOK, NQ8, G, blk);
          pg8::EpiIn8 E{pg8::EpiIn{WSP(bf16, OFF_Z), (long)N_IN, 24, WSP(unsigned long long, OFF_RS) + (size_t)(2 * lyr) * M_TOK, 1.f / (16777216.f * D_MODEL), NORM_EPS}, WSP(float, OFF_SA), WSP(float, OFF_SBIN) + (size_t)lyr * NQ8};
          pg8::gemm_phase<pg8::EpiIn8, pg8::StaticOrder, true, true>(lds, g, S, E, wvp); }
        __syncthreads();
        { PHASE_BEGIN();
          pg8::Gemm g{WSP(bf16, OFF_H), WSP(bf16, OFF_WIN) + (size_t)lyr * N_IN * D_MODEL + (size_t)NQ8 * D_MODEL, M_TOK, N_IN - NQ8, D_MODEL}; pg8::StaticOrder S; S.init(M_TOK, N_IN - NQ8, G, blk);
          pg8::EpiIn E{WSP(bf16, OFF_Z) + NQ8, (long)N_IN, 24 - NQ8 / 256, WSP(unsigned long long, OFF_RS) + (size_t)(2 * lyr) * M_TOK, 1.f / (16777216.f * D_MODEL), NORM_EPS};
          pg8::gemm_phase<pg8::EpiIn, pg8::StaticOrder, true, true>(lds, g, S, E, wvp); }
        GRID_BARRIER();
        { PHASE_BEGIN();
          phase_attn(WSP(bf16, OFF_Z), WSP(bf16, OFF_OC), WSP(float, OFF_LSE), (char*)lds_raw, blk, G, wvp); }
        __syncthreads();
        { PHASE_BEGIN();
          phase_sgu(WSP(bf16, OFF_Z), ka->in[3] + (size_t)lyr * D_SGU, ka->in[4] + (size_t)lyr * NG * CHUNK * CHUNK, ka->in[5] + (size_t)lyr * NG * CHUNK, ka->in[6] + (size_t)lyr * D_MODEL, WSP(bf16, OFF_MX), lds, blk, G, tid, wvp); }
        GRID_BARRIER();
        { PHASE_BEGIN(); phase_combine(WSP(bf16, OFF_OC), WSP(float, OFF_LSE), ka->in[6] + (size_t)lyr * D_MODEL, WSP(bf16, OFF_MX), gw, NGW, lane); }
        GRID_BARRIER();
        { PHASE_BEGIN();
          pg8::Gemm g{WSP(bf16, OFF_MX), WSP(bf16, OFF_WOUT) + (size_t)lyr * D_MODEL * D_MODEL, M_TOK, D_MODEL, D_MODEL}; pg8::StaticOrder S; S.init(M_TOK, D_MODEL, G, blk);
          pg8::EpiRes E{WSP(bf16, OFF_H), WSP(unsigned long long, OFF_RS) + (size_t)(2 * lyr + 1) * M_TOK, (long)D_MODEL};
          pg8::gemm_phase<pg8::EpiRes, pg8::StaticOrder, true, true>(lds, g, S, E, wvp); }
        GRID_BARRIER();
        { PHASE_BEGIN(); phase_quant_rows(WSP(bf16, OFF_H), WSP(signed char, OFF_XQ), WSP(float, OFF_SA), gw, NGW, lane); }
        GRID_BARRIER();
        { PHASE_BEGIN();
          pg8::Gemm g{(const bf16*)WSP(signed char, OFF_XQ), (const bf16*)(WSP(signed char, OFF_WUP) + (size_t)lyr * N_UP * D_MODEL), M_TOK, N_UP, D_MODEL / 2}; pg8::StaticOrder S; S.init(M_TOK, N_UP, G, blk);
          pg8::EpiConv8 E{pg8::EpiConv{WSP(bf16, OFF_ACT), WSP(float, OFF_U4), ka->in[10] + (size_t)lyr * 3 * N_UP, ka->in[11] + (size_t)lyr * N_UP, (long)D_FF, WSP(unsigned long long, OFF_RS) + (size_t)(2 * lyr + 1) * M_TOK, 1.f / (16777216.f * D_MODEL), NORM_EPS},
                            WSP(float, OFF_SA), WSP(float, OFF_SB) + (size_t)lyr * N_UP};
          pg8::gemm_phase<pg8::EpiConv8, pg8::StaticOrder, true, true>(lds, g, S, E, wvp); }
        GRID_BARRIER();
        { PHASE_BEGIN(); phase_convfix(WSP(float, OFF_U4), ka->in[10] + (size_t)lyr * 3 * N_UP, ka->in[11] + (size_t)lyr * N_UP, WSP(bf16, OFF_ACT), (size_t)blk * NTHREADS + tid, (size_t)G * NTHREADS); }
        GRID_BARRIER();
        { PHASE_BEGIN();
          pg8::Gemm g{WSP(bf16, OFF_ACT), WSP(bf16, OFF_WDN) + (size_t)lyr * D_MODEL * D_FF, M_TOK, D_MODEL, D_FF}; pg8::StaticOrder S; S.init(M_TOK, D_MODEL, G, blk);
          pg8::EpiRes E{WSP(bf16, OFF_H), WSP(unsigned long long, OFF_RS) + (size_t)(2 * lyr + 2) * M_TOK, (long)D_MODEL};
          pg8::gemm_phase<pg8::EpiRes, pg8::StaticOrder, true, true>(lds, g, S, E, wvp); }
        GRID_BARRIER();
        if (l + 1 < DEPTH) {
            { PHASE_BEGIN(); phase_quant_rows(WSP(bf16, OFF_H), WSP(signed char, OFF_XQ), WSP(float, OFF_SA), gw, NGW, lane); }
            GRID_BARRIER();
        }
    }
    { const int l = 0; PHASE_BEGIN(); phase_final(WSP(bf16, OFF_H), ka->out, WSP(unsigned long long, OFF_RS) + (size_t)(2 * DEPTH) * M_TOK, ka->in[13], gw, NGW, lane); }
#undef PHASE_BEGIN
#undef WSP
#undef GRID_BARRIER
}

extern "C" void kernel_launch(void* const* d_in, const int* in_sizes, int n_in, void* d_out, int out_size, void* d_ws, size_t ws_size, hipStream_t stream) {
    static int grid = 0;
    if (grid == 0) {
        if (n_in != 14 || out_size != M_TOK * D_MODEL || ws_size < WS_END) { fprintf(stderr, "kernel_launch: unexpected shapes (n_in %d out %d ws %zu need %zu)\n", n_in, out_size, ws_size, (size_t)WS_END); grid = -1; return; }
        int dev = 0, cus = 0, per_cu = 0;
        if (hipGetDevice(&dev) != hipSuccess || hipDeviceGetAttribute(&cus, hipDeviceAttributeMultiprocessorCount, dev) != hipSuccess) { grid = -1; return; }
        if (hipFuncSetAttribute((const void*)mega_fwd, hipFuncAttributeMaxDynamicSharedMemorySize, LDS_BYTES) != hipSuccess) { fprintf(stderr, "kernel_launch: hipFuncSetAttribute failed\n"); grid = -1; return; }
        if (hipOccupancyMaxActiveBlocksPerMultiprocessor(&per_cu, (const void*)mega_fwd, NTHREADS, LDS_BYTES) != hipSuccess || per_cu < 1) { fprintf(stderr, "kernel_launch: occupancy query says %d blocks per CU\n", per_cu); grid = -1; (void)hipGetLastError(); return; }
        grid = cus;
    }
    if (grid < 0) return;
    (void)hipMemsetAsync((char*)d_ws + OFF_CTL, 0, CTL_BYTES, stream);
    Args a{};
    for (int i = 0; i < 14; ++i) a.in[i] = (const float*)d_in[i];
    a.out = (float*)d_out; a.ws = (unsigned char*)d_ws;
    hipLaunchKernelGGL(mega_fwd, dim3(grid), dim3(NTHREADS), LDS_BYTES, stream, a);
}
```

```cpp
#include <hip/hip_runtime.h>
#include <cstdio>
#include <cstdint>
__device__ __forceinline__ int tid_of(int wv) { int t; asm volatile("v_mbcnt_lo_u32_b32 %0, -1, 0\n\tv_mbcnt_hi_u32_b32 %0, -1, %0\n\tv_lshl_add_u32 %0, %1, 6, %0" : "=&v"(t) : "s"(wv)); return t; }
__device__ __forceinline__ void half_swap(float& a, float& b) { asm("s_nop 1\n\tv_permlane32_swap_b32 %0, %1" : "+v"(a), "+v"(b)); }
template <int K> __device__ __forceinline__ float lane_xor(float v) { static_assert(K >= 1 && K <= 16, "lane_xor: within 32 lanes"); return __builtin_bit_cast(float, __builtin_amdgcn_ds_swizzle(__builtin_bit_cast(int, v), (K << 10) | 0x1f)); }
__device__ __forceinline__ float wave_sum(float v) {
    v += lane_xor<1>(v); v += lane_xor<2>(v); v += lane_xor<4>(v); v += lane_xor<8>(v); v += lane_xor<16>(v);
    float a = v, b = v; half_swap(a, b);
    return a + b;
}
namespace pg8 {
#define PG8_LAS __attribute__((address_space(3)))
typedef unsigned short bf16_t;
typedef short bf16x8 __attribute__((ext_vector_type(8)));
typedef float f32x4 __attribute__((ext_vector_type(4)));
typedef unsigned u32x4 __attribute__((ext_vector_type(4)));
constexpr int BM = 256, BK = 64, HALF = 128, HTB = HALF * BK * 2  , STAGE_BYTES = 8 * HTB, NXCD = 8, WGM = 8;

__host__ __device__ __forceinline__ int lds_byte(int r, int c) { const int st = (r >> 4) * 2 + (c >> 5), rr = r & 15, cc = c & 31, ob = rr * 64 + cc * 2; return st * 1024 + (ob ^ (((ob >> 9) & 1) << 5)); }
__host__ __device__ __forceinline__ void stage_rc(int b, int& R, int& C) { const int st = b / 1024, sb = b % 1024, swz = sb ^ (((sb >> 9) & 1) << 5); R = (st >> 1) * 16 + swz / 64; C = (st & 1) * 32 + (swz % 64) / 2; }
__host__ __device__ __forceinline__ int perm32(int rho) { const int n = rho >> 4, i = rho & 15; return 8 * (i >> 2) + 4 * n + (i & 3); }

struct Unit { int pm, pn; };
struct Gemm { const bf16_t* A; const bf16_t* Bt; int M, N, K; };

struct StaticOrder {
    int nM, nN, nwg, G, c;
    __host__ __device__ void init(int M, int N, int G_, int c_) { nM = M / BM; nN = N / BM; nwg = nM * nN; G = G_; c = c_; }
    __host__ __device__ bool next(int i, Unit& u) const {
        const long L = (long)i * G + c; if (L >= nwg) return false;
        int wgid = (int)L; { const int q = nwg / NXCD, r = nwg % NXCD, xcd = wgid % NXCD, off = wgid / NXCD; wgid = (xcd < r ? xcd * (q + 1) : r * (q + 1) + (xcd - r) * q) + off; }
        const int nig = WGM * nN, gid = wgid / nig, fm = gid * WGM, gsz = (nM - fm) < WGM ? (nM - fm) : WGM;
        u.pm = fm + ((wgid % nig) % gsz); u.pn = (wgid % nig) / gsz; return true;
    }
    __device__ __forceinline__ void a_ready(const Unit&) const {}
    __device__ __forceinline__ void done(const Unit&) const {}
};
__device__ __forceinline__ unsigned cvt_pk_bf16(float lo, float hi) { unsigned r; asm volatile("v_cvt_pk_bf16_f32 %0, %1, %2" : "=v"(r) : "v"(lo), "v"(hi)); return r; }
typedef float f32x2 __attribute__((ext_vector_type(2)));
__device__ __forceinline__ f32x2 gelu_pk(f32x2 v) {
    const f32x2 av = __builtin_elementwise_abs(v), d = av * 0.2316418882f + 1.0f;
    f32x2 t; t.x = __builtin_amdgcn_rcpf(d.x); t.y = __builtin_amdgcn_rcpf(d.y);
    f32x2 q = t * 0.5307027145f + (-0.7265760135f); q = q * t + 0.7107068705f; q = q * t + (-0.142248368f); q = q * t + 0.127414796f; q = q * t;
    const f32x2 s = (v * v) * (-0.72134752044f);
    f32x2 e; e.x = __builtin_amdgcn_exp2f(s.x); e.y = __builtin_amdgcn_exp2f(s.y);
    const f32x2 m = v * (q * e), r = v - m;
    f32x2 o; o.x = v.x < 0.f ? m.x : r.x; o.y = v.y < 0.f ? m.y : r.y; return o;
}

struct EpiIn {
    static constexpr bool PERM = true, AFTER_DRAIN = false;
    bf16_t* O; long ldc; long gelu_from_pn; const unsigned long long* rowss; float inv_k, eps;
    __device__ __forceinline__ void operator()(const f32x4 (&acc)[2][2][4][2], const Unit& u, int wr, int wc, int fr, int fq) const {
        const int row0 = u.pm * BM + wr * 64 + fr; const int col0 = u.pn * BM + wc * 32 + 8 * fq;
        const bool act = u.pn >= (int)gelu_from_pn;
#pragma unroll
        for (int ai = 0; ai < 2; ++ai)
#pragma unroll
            for (int m = 0; m < 4; ++m) { bf16_t* rowp = O + (size_t)(row0 + ai * HALF + m * 16) * (size_t)ldc + col0;
                const float rs = __builtin_amdgcn_rsqf((float)rowss[row0 + ai * HALF + m * 16] * inv_k + eps);
#pragma unroll
                for (int bj = 0; bj < 2; ++bj) { f32x4 v0 = acc[ai][bj][m][0] * rs, v1 = acc[ai][bj][m][1] * rs;
                    if (act) { f32x2 a = gelu_pk((f32x2){v0[0], v0[1]}), b = gelu_pk((f32x2){v0[2], v0[3]}), c = gelu_pk((f32x2){v1[0], v1[1]}), d = gelu_pk((f32x2){v1[2], v1[3]});
                        v0 = (f32x4){a.x, a.y, b.x, b.y}; v1 = (f32x4){c.x, c.y, d.x, d.y}; }
                    u32x4 w; w.x = cvt_pk_bf16(v0[0], v0[1]); w.y = cvt_pk_bf16(v0[2], v0[3]); w.z = cvt_pk_bf16(v1[0], v1[1]); w.w = cvt_pk_bf16(v1[2], v1[3]);
                    *(u32x4*)(rowp + bj * HALF) = w; } }
    }
};
struct EpiBf {
    static constexpr bool PERM = true, AFTER_DRAIN = false;
    bf16_t* O; long ldc;
    __device__ __forceinline__ void operator()(const f32x4 (&acc)[2][2][4][2], const Unit& u, int wr, int wc, int fr, int fq) const {
        const int row0 = u.pm * BM + wr * 64 + fr; const int col0 = u.pn * BM + wc * 32 + 8 * fq;
#pragma unroll
        for (int ai = 0; ai < 2; ++ai)
#pragma unroll
            for (int m = 0; m < 4; ++m) { bf16_t* rowp = O + (size_t)(row0 + ai * HALF + m * 16) * (size_t)ldc + col0;
#pragma unroll
                for (int bj = 0; bj < 2; ++bj) { const f32x4 v0 = acc[ai][bj][m][0], v1 = acc[ai][bj][m][1];
                    u32x4 w; w.x = cvt_pk_bf16(v0[0], v0[1]); w.y = cvt_pk_bf16(v0[2], v0[3]); w.z = cvt_pk_bf16(v1[0], v1[1]); w.w = cvt_pk_bf16(v1[2], v1[3]);
                    *(u32x4*)(rowp + bj * HALF) = w; } }
    }
};
typedef int i32x4 __attribute__((ext_vector_type(4)));
__device__ __forceinline__ f32x4 mma1(bf16x8 w, bf16x8 a, f32x4 c) { return __builtin_amdgcn_mfma_f32_16x16x32_bf16(w, a, c, 0, 0, 0); }
__device__ __forceinline__ i32x4 mma1(bf16x8 w, bf16x8 a, i32x4 c) { return __builtin_amdgcn_mfma_i32_16x16x64_i8(__builtin_bit_cast(i32x4, w), __builtin_bit_cast(i32x4, a), c, 0, 0, 0); }
template <class E, class = void> struct ARow4Of { static constexpr bool v = false; };
template <class E> struct ARow4Of<E, decltype((void)E::AROW4)> { static constexpr bool v = E::AROW4; };
template <class E, class = void> struct AccOf { typedef f32x4 type; };
template <class E> struct AccOf<E, decltype((void)sizeof(typename E::AccT))> { typedef typename E::AccT type; };
template <int CTRL> __device__ __forceinline__ float dpp_z(float src) { return __builtin_bit_cast(float, __builtin_amdgcn_update_dpp(0, __builtin_bit_cast(int, src), CTRL, 0xf, 0xf, true)); }
template <int CTRL> __device__ __forceinline__ float dpp_f(float oldv, float src) { return __builtin_bit_cast(float, __builtin_amdgcn_update_dpp(__builtin_bit_cast(int, oldv), __builtin_bit_cast(int, src), CTRL, 0xf, 0xf, false)); }
struct EpiConv {
    static constexpr bool PERM = true, AFTER_DRAIN = false;
    bf16_t* ACT; float* U4; const float* cw; const float* cb; long dff; const unsigned long long* rowss; float inv_k, eps;
    __device__ __forceinline__ void operator()(f32x4 (&acc)[2][2][4][2], const Unit& u, int wr, int wc, int fr, int fq) const {
#pragma unroll
        for (int ai = 0; ai < 2; ++ai)
#pragma unroll
            for (int m = 0; m < 4; ++m) { const float rs = __builtin_amdgcn_rsqf((float)rowss[u.pm * BM + ai * HALF + wr * 64 + m * 16 + fr] * inv_k + eps);
#pragma unroll
                for (int bj = 0; bj < 2; ++bj)
#pragma unroll
                    for (int n = 0; n < 2; ++n) acc[ai][bj][m][n] = acc[ai][bj][m][n] * rs; }
        body(acc, u, wr, wc, fr, fq);
    }
    __device__ __forceinline__ void body(f32x4 (&acc)[2][2][4][2], const Unit& u, int wr, int wc, int fr, int fq) const {
        const int ch0 = u.pn * 128 + wc * 32 + 8 * fq;
        const int n2 = 2 * (int)dff;
        { const int slot = (fr < 2) ? fr : fr - 12;
          if (fr < 2 || fr >= 14) {
#pragma unroll
              for (int ai = 0; ai < 2; ++ai) { float* p = U4 + ((size_t)(u.pm * 4 + ai * 2 + wr) * 4 + slot) * (size_t)n2 + ch0;
#pragma unroll
                  for (int bj = 0; bj < 2; ++bj)
#pragma unroll
                      for (int n = 0; n < 2; ++n) *(f32x4*)(p + bj * dff + 4 * n) = (fr < 2) ? acc[ai][bj][0][n] : acc[ai][bj][3][n]; } } }
#pragma unroll
        for (int bj = 0; bj < 2; ++bj) {
            const float* wp = cw + bj * dff + ch0; const float* bp = cb + bj * dff + ch0;
            f32x4 w0[2], w1[2], w2[2], bb[2], w0z[2], w1z[2];
#pragma unroll
            for (int n = 0; n < 2; ++n) { w0[n] = *(const f32x4*)(wp + 4 * n); w1[n] = *(const f32x4*)(wp + n2 + 4 * n); w2[n] = *(const f32x4*)(wp + 2 * (size_t)n2 + 4 * n); bb[n] = *(const f32x4*)(bp + 4 * n);
                w0z[n] = fr < 2 ? w0[n] : (f32x4){0.f, 0.f, 0.f, 0.f}; w1z[n] = fr == 0 ? w1[n] : (f32x4){0.f, 0.f, 0.f, 0.f}; }
#pragma unroll
            for (int ai = 0; ai < 2; ++ai)
#pragma unroll
                for (int m = 3; m >= 0; --m)
#pragma unroll
                    for (int n = 0; n < 2; ++n) { const f32x4 x = acc[ai][bj][m][n]; f32x4 y;
#pragma unroll
                        for (int e = 0; e < 4; ++e) y[e] = fmaf(w2[n][e], x[e], bb[n][e]);
                        if (m > 0) { const f32x4 xp = acc[ai][bj][m - 1][n];
                            asm volatile("s_nop 1\n\t"
                                "v_fmac_f32_dpp %0, %4, %12 row_shr:1 row_mask:0xf bank_mask:0xf\n\tv_fmac_f32_dpp %1, %5, %13 row_shr:1 row_mask:0xf bank_mask:0xf\n\tv_fmac_f32_dpp %2, %6, %14 row_shr:1 row_mask:0xf bank_mask:0xf\n\tv_fmac_f32_dpp %3, %7, %15 row_shr:1 row_mask:0xf bank_mask:0xf\n\t"
                                "v_fmac_f32_dpp %0, %4, %16 row_shr:2 row_mask:0xf bank_mask:0xf\n\tv_fmac_f32_dpp %1, %5, %17 row_shr:2 row_mask:0xf bank_mask:0xf\n\tv_fmac_f32_dpp %2, %6, %18 row_shr:2 row_mask:0xf bank_mask:0xf\n\tv_fmac_f32_dpp %3, %7, %19 row_shr:2 row_mask:0xf bank_mask:0xf\n\t"
                                "v_fmac_f32_dpp %0, %8, %20 row_ror:1 row_mask:0xf bank_mask:0xf\n\tv_fmac_f32_dpp %1, %9, %21 row_ror:1 row_mask:0xf bank_mask:0xf\n\tv_fmac_f32_dpp %2, %10, %22 row_ror:1 row_mask:0xf bank_mask:0xf\n\tv_fmac_f32_dpp %3, %11, %23 row_ror:1 row_mask:0xf bank_mask:0xf\n\t"
                                "v_fmac_f32_dpp %0, %8, %24 row_ror:2 row_mask:0xf bank_mask:0xf\n\tv_fmac_f32_dpp %1, %9, %25 row_ror:2 row_mask:0xf bank_mask:0xf\n\tv_fmac_f32_dpp %2, %10, %26 row_ror:2 row_mask:0xf bank_mask:0xf\n\tv_fmac_f32_dpp %3, %11, %27 row_ror:2 row_mask:0xf bank_mask:0xf"
                                : "+v"(y[0]), "+v"(y[1]), "+v"(y[2]), "+v"(y[3])
                                : "v"(x[0]), "v"(x[1]), "v"(x[2]), "v"(x[3]), "v"(xp[0]), "v"(xp[1]), "v"(xp[2]), "v"(xp[3]),
                                  "v"(w1[n][0]), "v"(w1[n][1]), "v"(w1[n][2]), "v"(w1[n][3]), "v"(w0[n][0]), "v"(w0[n][1]), "v"(w0[n][2]), "v"(w0[n][3]),
                                  "v"(w1z[n][0]), "v"(w1z[n][1]), "v"(w1z[n][2]), "v"(w1z[n][3]), "v"(w0z[n][0]), "v"(w0z[n][1]), "v"(w0z[n][2]), "v"(w0z[n][3])); }
                        else {
                            asm volatile("s_nop 1\n\t"
                                "v_fmac_f32_dpp %0, %4, %8 row_shr:1 row_mask:0xf bank_mask:0xf\n\tv_fmac_f32_dpp %1, %5, %9 row_shr:1 row_mask:0xf bank_mask:0xf\n\tv_fmac_f32_dpp %2, %6, %10 row_shr:1 row_mask:0xf bank_mask:0xf\n\tv_fmac_f32_dpp %3, %7, %11 row_shr:1 row_mask:0xf bank_mask:0xf\n\t"
                                "v_fmac_f32_dpp %0, %4, %12 row_shr:2 row_mask:0xf bank_mask:0xf\n\tv_fmac_f32_dpp %1, %5, %13 row_shr:2 row_mask:0xf bank_mask:0xf\n\tv_fmac_f32_dpp %2, %6, %14 row_shr:2 row_mask:0xf bank_mask:0xf\n\tv_fmac_f32_dpp %3, %7, %15 row_shr:2 row_mask:0xf bank_mask:0xf"
                                : "+v"(y[0]), "+v"(y[1]), "+v"(y[2]), "+v"(y[3])
                                : "v"(x[0]), "v"(x[1]), "v"(x[2]), "v"(x[3]),
                                  "v"(w1[n][0]), "v"(w1[n][1]), "v"(w1[n][2]), "v"(w1[n][3]), "v"(w0[n][0]), "v"(w0[n][1]), "v"(w0[n][2]), "v"(w0[n][3])); }
                        acc[ai][bj][m][n] = y; }
        }
        const int row0 = u.pm * BM + wr * 64 + fr;
#pragma unroll
        for (int ai = 0; ai < 2; ++ai)
#pragma unroll
            for (int m = 0; m < 4; ++m) { float r[8];
#pragma unroll
                for (int n = 0; n < 2; ++n)
#pragma unroll
                    for (int e = 0; e < 4; ++e) { const float g = acc[ai][0][m][n][e]; r[4 * n + e] = g * __builtin_amdgcn_rcpf(1.f + __builtin_amdgcn_exp2f(-1.4426950408889634f * g)) * acc[ai][1][m][n][e]; }
                u32x4 w; w.x = cvt_pk_bf16(r[0], r[1]); w.y = cvt_pk_bf16(r[2], r[3]); w.z = cvt_pk_bf16(r[4], r[5]); w.w = cvt_pk_bf16(r[6], r[7]);
                *(u32x4*)(ACT + (size_t)(row0 + ai * HALF + m * 16) * (size_t)dff + ch0) = w; }
    }
};
struct EpiConv4 {
    EpiConv c;
    __device__ __forceinline__ void body(f32x4 (&acc)[2][2][4][2], const Unit& u, int wr, int wc, int fr, int fq) const {
        const int ch0 = u.pn * 128 + wc * 32 + 8 * fq; const int n2 = 2 * (int)c.dff;
        if (fr == 0 || fr == 15) {
#pragma unroll
            for (int ai = 0; ai < 2; ++ai)
#pragma unroll
                for (int s = 0; s < 2; ++s) { float* p = c.U4 + ((size_t)(u.pm * 4 + ai * 2 + wr) * 4 + (fr == 0 ? s : 2 + s)) * (size_t)n2 + ch0;
#pragma unroll
                    for (int bj = 0; bj < 2; ++bj)
#pragma unroll
                        for (int n = 0; n < 2; ++n) *(f32x4*)(p + bj * c.dff + 4 * n) = (fr == 0) ? acc[ai][bj][s][n] : acc[ai][bj][2 + s][n]; } }
#pragma unroll
        for (int bj = 0; bj < 2; ++bj) {
            const float* wp = c.cw + bj * c.dff + ch0; const float* bp = c.cb + bj * c.dff + ch0;
#pragma unroll
            for (int n = 0; n < 2; ++n) { const f32x4 w0 = *(const f32x4*)(wp + 4 * n), w1 = *(const f32x4*)(wp + n2 + 4 * n), w2 = *(const f32x4*)(wp + 2 * (size_t)n2 + 4 * n), bb = *(const f32x4*)(bp + 4 * n);
#pragma unroll
                for (int ai = 0; ai < 2; ++ai) { const f32x4 x0 = acc[ai][bj][0][n], x1 = acc[ai][bj][1][n], x2 = acc[ai][bj][2][n], x3 = acc[ai][bj][3][n];
                    const f32x4 y3 = w0 * x1 + (w1 * x2 + (w2 * x3 + bb)), y2 = w0 * x0 + (w1 * x1 + (w2 * x2 + bb)); f32x4 y1 = w1 * x0 + (w2 * x1 + bb), y0 = w2 * x0 + bb;
                    asm volatile("s_nop 1\n\t"
                        "v_fmac_f32_dpp %4, %12, %16 row_shr:1 row_mask:0xf bank_mask:0xf\n\tv_fmac_f32_dpp %5, %13, %17 row_shr:1 row_mask:0xf bank_mask:0xf\n\tv_fmac_f32_dpp %6, %14, %18 row_shr:1 row_mask:0xf bank_mask:0xf\n\tv_fmac_f32_dpp %7, %15, %19 row_shr:1 row_mask:0xf bank_mask:0xf\n\t"
                        "v_fmac_f32_dpp %0, %12, %20 row_shr:1 row_mask:0xf bank_mask:0xf\n\tv_fmac_f32_dpp %1, %13, %21 row_shr:1 row_mask:0xf bank_mask:0xf\n\tv_fmac_f32_dpp %2, %14, %22 row_shr:1 row_mask:0xf bank_mask:0xf\n\tv_fmac_f32_dpp %3, %15, %23 row_shr:1 row_mask:0xf bank_mask:0xf\n\t"
                        "v_fmac_f32_dpp %0, %8, %16 row_shr:1 row_mask:0xf bank_mask:0xf\n\tv_fmac_f32_dpp %1, %9, %17 row_shr:1 row_mask:0xf bank_mask:0xf\n\tv_fmac_f32_dpp %2, %10, %18 row_shr:1 row_mask:0xf bank_mask:0xf\n\tv_fmac_f32_dpp %3, %11, %19 row_shr:1 row_mask:0xf bank_mask:0xf"
                        : "+v"(y0[0]), "+v"(y0[1]), "+v"(y0[2]), "+v"(y0[3]), "+v"(y1[0]), "+v"(y1[1]), "+v"(y1[2]), "+v"(y1[3])
                        : "v"(x2[0]), "v"(x2[1]), "v"(x2[2]), "v"(x2[3]), "v"(x3[0]), "v"(x3[1]), "v"(x3[2]), "v"(x3[3]),
                          "v"(w0[0]), "v"(w0[1]), "v"(w0[2]), "v"(w0[3]), "v"(w1[0]), "v"(w1[1]), "v"(w1[2]), "v"(w1[3]));
                    acc[ai][bj][0][n] = y0; acc[ai][bj][1][n] = y1; acc[ai][bj][2][n] = y2; acc[ai][bj][3][n] = y3; } }
        }
        const int row0 = u.pm * BM + wr * 64 + 4 * fr;
#pragma unroll
        for (int ai = 0; ai < 2; ++ai)
#pragma unroll
            for (int m = 0; m < 4; ++m) { float r[8];
#pragma unroll
                for (int n = 0; n < 2; ++n)
#pragma unroll
                    for (int e = 0; e < 4; ++e) { const float g = acc[ai][0][m][n][e]; r[4 * n + e] = g * __builtin_amdgcn_rcpf(1.f + __builtin_amdgcn_exp2f(-1.4426950408889634f * g)) * acc[ai][1][m][n][e]; }
                u32x4 w; w.x = cvt_pk_bf16(r[0], r[1]); w.y = cvt_pk_bf16(r[2], r[3]); w.z = cvt_pk_bf16(r[4], r[5]); w.w = cvt_pk_bf16(r[6], r[7]);
                *(u32x4*)(c.ACT + (size_t)(row0 + ai * HALF + m) * (size_t)c.dff + ch0) = w; }
    }
};
struct EpiIn8 {
    static constexpr bool PERM = true, AFTER_DRAIN = false; typedef i32x4 AccT;
    EpiIn core; const float* sA; const float* sB;
    __device__ __forceinline__ void operator()(i32x4 (&acc)[2][2][4][2], const Unit& u, int wr, int wc, int fr, int fq) const {
        f32x4 cs[2][2];
#pragma unroll
        for (int bj = 0; bj < 2; ++bj)
#pragma unroll
            for (int n = 0; n < 2; ++n) cs[bj][n] = *(const f32x4*)(sB + u.pn * BM + bj * HALF + wc * 32 + 8 * fq + 4 * n);
        f32x4 af[2][2][4][2];
#pragma unroll
        for (int ai = 0; ai < 2; ++ai)
#pragma unroll
            for (int m = 0; m < 4; ++m) { const float rf = sA[u.pm * BM + ai * HALF + wr * 64 + m * 16 + fr];
#pragma unroll
                for (int bj = 0; bj < 2; ++bj)
#pragma unroll
                    for (int n = 0; n < 2; ++n) af[ai][bj][m][n] = __builtin_convertvector(acc[ai][bj][m][n], f32x4) * rf * cs[bj][n]; }
        core(af, u, wr, wc, fr, fq);
    }
};
struct EpiConv8 {
    static constexpr bool PERM = true, AFTER_DRAIN = false, AROW4 = true; typedef i32x4 AccT;
    EpiConv core; const float* sA; const float* sB;
    __device__ __forceinline__ void operator()(i32x4 (&acc)[2][2][4][2], const Unit& u, int wr, int wc, int fr, int fq) const {
        f32x4 cs[2][2];
#pragma unroll
        for (int bj = 0; bj < 2; ++bj)
#pragma unroll
            for (int n = 0; n < 2; ++n) cs[bj][n] = *(const f32x4*)(sB + u.pn * BM + bj * HALF + wc * 32 + 8 * fq + 4 * n);
        f32x4 af[2][2][4][2];
#pragma unroll
        for (int ai = 0; ai < 2; ++ai)
#pragma unroll
            for (int m = 0; m < 4; ++m) { const int row = u.pm * BM + ai * HALF + wr * 64 + 4 * fr + m;
                const float rf = sA[row] * __builtin_amdgcn_rsqf((float)core.rowss[row] * core.inv_k + core.eps);
#pragma unroll
                for (int bj = 0; bj < 2; ++bj)
#pragma unroll
                    for (int n = 0; n < 2; ++n) af[ai][bj][m][n] = __builtin_convertvector(acc[ai][bj][m][n], f32x4) * rf * cs[bj][n]; }
        EpiConv4{core}.body(af, u, wr, wc, fr, fq);
    }
};
struct EpiRes {
    static constexpr bool PERM = true, AFTER_DRAIN = false;
    bf16_t* xb; unsigned long long* rowss; long ldc;
    __device__ __forceinline__ void operator()(const f32x4 (&acc)[2][2][4][2], const Unit& u, int wr, int wc, int fr, int fq) const {
        const int row0 = u.pm * BM + wr * 64 + fr, col0 = u.pn * BM + wc * 32 + 8 * fq;
#pragma unroll
        for (int ai = 0; ai < 2; ++ai) {
            u32x4 bs[4][2];
#pragma unroll
            for (int m = 0; m < 4; ++m)
#pragma unroll
                for (int bj = 0; bj < 2; ++bj) bs[m][bj] = *(const u32x4*)(xb + (size_t)(row0 + ai * HALF + m * 16) * (size_t)ldc + col0 + bj * HALF);
#pragma unroll
            for (int m = 0; m < 4; ++m) { const int row = row0 + ai * HALF + m * 16; float ss = 0.f;
#pragma unroll
                for (int bj = 0; bj < 2; ++bj) { const u32x4 b = bs[m][bj]; const f32x4 a0 = acc[ai][bj][m][0], a1 = acc[ai][bj][m][1];
                    const float v0 = __builtin_bit_cast(float, b.x << 16) + a0[0], v1 = __builtin_bit_cast(float, b.x & 0xffff0000u) + a0[1], v2 = __builtin_bit_cast(float, b.y << 16) + a0[2], v3 = __builtin_bit_cast(float, b.y & 0xffff0000u) + a0[3];
                    const float v4 = __builtin_bit_cast(float, b.z << 16) + a1[0], v5 = __builtin_bit_cast(float, b.z & 0xffff0000u) + a1[1], v6 = __builtin_bit_cast(float, b.w << 16) + a1[2], v7 = __builtin_bit_cast(float, b.w & 0xffff0000u) + a1[3];
                    ss += ((v0 * v0 + v1 * v1) + (v2 * v2 + v3 * v3)) + ((v4 * v4 + v5 * v5) + (v6 * v6 + v7 * v7));
                    u32x4 w; w.x = cvt_pk_bf16(v0, v1); w.y = cvt_pk_bf16(v2, v3); w.z = cvt_pk_bf16(v4, v5); w.w = cvt_pk_bf16(v6, v7);
                    *(u32x4*)(xb + (size_t)row * (size_t)ldc + col0 + bj * HALF) = w; }
                ss += __builtin_bit_cast(float, __builtin_amdgcn_ds_swizzle(__builtin_bit_cast(int, ss), (16 << 10) | 0x1f));
                { float sa = ss, sb = ss; asm("s_nop 1\n\tv_permlane32_swap_b32 %0, %1" : "+v"(sa), "+v"(sb)); ss = sa + sb; }
                if (fq == 0) __hip_atomic_fetch_add(rowss + row, (unsigned long long)(long long)__builtin_rintf(ss * 16777216.f), __ATOMIC_RELAXED, __HIP_MEMORY_SCOPE_AGENT); }
        }
    }
};

template <class Epi, class Sched, bool ALIGN_EPI = false, bool SP2 = false>
__device__ __forceinline__ void gemm_phase(PG8_LAS unsigned char* lds, const Gemm g, const Sched& S, const Epi& E, const int wv) {
    const int tid_o = tid_of(wv);
    const int tid = tid_o, wid = __builtin_amdgcn_readfirstlane(tid >> 6), lane = tid & 63, wr = wid >> 2, wc = wid & 3, fr = lane & 15, fq = lane >> 4;
    const int K = g.K, nt = K / BK;
    unsigned voffA[2], voffB[2];
#pragma unroll
    for (int i = 0; i < 2; ++i) { int R, C; stage_rc(tid * 16 + i * 8192, R, C); const int Rb = Epi::PERM ? ((R & ~31) + perm32(R & 31)) : R;
        const int Ra = ARow4Of<Epi>::v ? ((R & ~63) + 4 * (R & 15) + ((R & 63) >> 4)) : R;
        voffA[i] = (unsigned)(Ra * K + C) * 2u; voffB[i] = (unsigned)(Rb * K + C) * 2u; }
    const size_t kstep = (size_t)(BK * 2);
    const size_t hstep = (size_t)HALF * K * 2;
    const size_t tstep = 2 * hstep;
    const unsigned ldsw = (unsigned)wid * 1024u;
    const int aoff = lds_byte(wr * 64 + fr, fq * 8), boff = lds_byte(wc * 32 + fr, fq * 8);
#define PG8_SA(b, h) (((b) * 2 + (h)) * HTB)
#define PG8_SB(b, h) ((4 + (b) * 2 + (h)) * HTB)
#define PG8_STAGE(bufoff, gbase, voff) do { _Pragma("unroll") for (int _i = 0; _i < 2; ++_i) \
        __builtin_amdgcn_global_load_lds((const unsigned*)((const char*)(gbase) + (voff)[_i]), (PG8_LAS unsigned*)(lds + (bufoff) + ldsw + _i * 8192), 16, 0, 0); } while (0)
#define PG8_LDA(dst, b, h) do { _Pragma("unroll") for (int m = 0; m < 4; ++m) _Pragma("unroll") for (int k = 0; k < 2; ++k) dst[m][k] = *(const PG8_LAS bf16x8*)(lds + PG8_SA(b, h) + aoff + m * 2048 + k * 1024); } while (0)
#define PG8_LDB(dst, b, h) do { _Pragma("unroll") for (int n = 0; n < 2; ++n) _Pragma("unroll") for (int k = 0; k < 2; ++k) dst[n][k] = *(const PG8_LAS bf16x8*)(lds + PG8_SB(b, h) + boff + n * 2048 + k * 1024); } while (0)
#define PG8_MMA(ai, bj, At, Bt) do { __builtin_amdgcn_s_setprio(1); _Pragma("unroll") for (int m = 0; m < 4; ++m) _Pragma("unroll") for (int n = 0; n < 2; ++n) _Pragma("unroll") for (int k = 0; k < 2; ++k) \
        acc[ai][bj][m][n] = mma1(Bt[n][k], At[m][k], acc[ai][bj][m][n]); __builtin_amdgcn_s_setprio(0); } while (0)
#define PG8_WAIT_V(n) asm volatile("s_waitcnt vmcnt(" #n ")" ::: "memory")
#define PG8_WAIT_L(n) asm volatile("s_waitcnt lgkmcnt(" #n ")" ::: "memory")
#define PG8_BAR __builtin_amdgcn_s_barrier()
#define PG8_SCHED __builtin_amdgcn_sched_barrier(0)
    Unit cur, nxt; int ui = 0;
    if (!S.next(0, cur)) return;
    typedef typename AccOf<Epi>::type AccT;
    AccT acc[2][2][4][2];
#pragma unroll
    for (int a = 0; a < 2; ++a)
#pragma unroll
        for (int b = 0; b < 2; ++b)
#pragma unroll
            for (int m = 0; m < 4; ++m)
#pragma unroll
                for (int n = 0; n < 2; ++n) acc[a][b][m][n] = (AccT){0, 0, 0, 0};
    bf16x8 At[4][2], B0[2][2], B1[2][2];
    const char* cA = (const char*)g.A + (size_t)cur.pm * tstep; const char* cB = (const char*)g.Bt + (size_t)cur.pn * tstep;
    S.a_ready(cur);
    if constexpr (SP2) {
        PG8_STAGE(PG8_SB(0, 0), cB, voffB); PG8_STAGE(PG8_SB(0, 1), cB + hstep, voffB); PG8_STAGE(PG8_SA(0, 0), cA, voffA); PG8_STAGE(PG8_SA(0, 1), cA + hstep, voffA);
        if (wr == 1) PG8_BAR;
        PG8_WAIT_V(2); PG8_BAR;
        PG8_STAGE(PG8_SB(1, 0), cB + kstep, voffB); PG8_STAGE(PG8_SA(1, 0), cA + kstep, voffA); PG8_STAGE(PG8_SB(1, 1), cB + hstep + kstep, voffB);
        PG8_WAIT_V(6); PG8_BAR;
    } else {
        PG8_STAGE(PG8_SB(0, 0), cB, voffB); PG8_STAGE(PG8_SA(0, 0), cA, voffA); PG8_STAGE(PG8_SB(0, 1), cB + hstep, voffB); PG8_STAGE(PG8_SA(0, 1), cA + hstep, voffA);
        if (wr == 1) PG8_BAR;
        PG8_WAIT_V(4); PG8_BAR;
        PG8_STAGE(PG8_SB(1, 0), cB + kstep, voffB); PG8_STAGE(PG8_SA(1, 0), cA + kstep, voffA); PG8_STAGE(PG8_SB(1, 1), cB + hstep + kstep, voffB);
        PG8_WAIT_V(6); PG8_BAR;
    }
    for (;;) {
        const bool has_next = S.next(ui + 1, nxt);
        const char* nA = has_next ? (const char*)g.A + (size_t)nxt.pm * tstep : cA; const char* nB = has_next ? (const char*)g.Bt + (size_t)nxt.pn * tstep : cB;
        for (int t = 0; t < nt; t += 2) {
            const bool last = (t == nt - 2);
            const char* a1 = cA + (size_t)(t + 1) * kstep;
            const char* a2 = last ? nA : cA + (size_t)(t + 2) * kstep; const char* b2 = last ? nB : cB + (size_t)(t + 2) * kstep;
            const char* a3 = a2 + kstep; const char* b3 = b2 + kstep;
            if (last && has_next) S.a_ready(nxt);
            if constexpr (SP2) {
            PG8_LDB(B0, 0, 0); PG8_LDB(B1, 0, 1); PG8_SCHED; PG8_LDA(At, 0, 0); PG8_STAGE(PG8_SA(1, 1), a1 + hstep, voffA);
            PG8_WAIT_V(8); PG8_WAIT_L(0); PG8_BAR; PG8_MMA(0, 0, At, B0); PG8_MMA(0, 1, At, B1); PG8_BAR; PG8_SCHED;
            PG8_LDA(At, 0, 1); PG8_STAGE(PG8_SB(0, 0), b2, voffB); PG8_STAGE(PG8_SB(0, 1), b2 + hstep, voffB); PG8_STAGE(PG8_SA(0, 0), a2, voffA);
            PG8_WAIT_V(8); PG8_WAIT_L(0); PG8_BAR; PG8_MMA(1, 0, At, B0); PG8_MMA(1, 1, At, B1); PG8_BAR; PG8_SCHED;
            PG8_LDB(B0, 1, 0); PG8_LDB(B1, 1, 1); PG8_SCHED; PG8_LDA(At, 1, 0); PG8_STAGE(PG8_SA(0, 1), a2 + hstep, voffA);
            PG8_WAIT_V(8); PG8_WAIT_L(0); PG8_BAR; PG8_MMA(0, 0, At, B0); PG8_MMA(0, 1, At, B1); PG8_BAR; PG8_SCHED;
            PG8_LDA(At, 1, 1); PG8_STAGE(PG8_SB(1, 0), b3, voffB); PG8_STAGE(PG8_SB(1, 1), b3 + hstep, voffB); PG8_STAGE(PG8_SA(1, 0), a3, voffA);
            PG8_WAIT_V(8); PG8_WAIT_L(0); PG8_BAR; PG8_MMA(1, 0, At, B0); PG8_MMA(1, 1, At, B1); PG8_BAR; PG8_SCHED;
            } else {
            PG8_LDB(B0, 0, 0); PG8_SCHED; PG8_LDA(At, 0, 0); PG8_STAGE(PG8_SA(1, 1), a1 + hstep, voffA);
            PG8_WAIT_L(8); PG8_BAR; PG8_WAIT_L(0); PG8_MMA(0, 0, At, B0); PG8_BAR; PG8_SCHED;
            PG8_LDB(B1, 0, 1); PG8_STAGE(PG8_SB(0, 0), b2, voffB);
            PG8_BAR; PG8_WAIT_L(0); PG8_MMA(0, 1, At, B1); PG8_BAR;
            PG8_LDA(At, 0, 1); PG8_STAGE(PG8_SA(0, 0), a2, voffA);
            PG8_BAR; PG8_WAIT_L(0); PG8_MMA(1, 0, At, B0); PG8_BAR; PG8_SCHED;
            PG8_STAGE(PG8_SB(0, 1), b2 + hstep, voffB);
            PG8_WAIT_V(6); PG8_BAR; PG8_MMA(1, 1, At, B1); PG8_BAR;
            PG8_LDB(B0, 1, 0); PG8_SCHED; PG8_LDA(At, 1, 0); PG8_STAGE(PG8_SA(0, 1), a2 + hstep, voffA);
            PG8_WAIT_L(8); PG8_BAR; PG8_WAIT_L(0); PG8_MMA(0, 0, At, B0); PG8_BAR; PG8_SCHED;
            PG8_LDB(B1, 1, 1); PG8_STAGE(PG8_SB(1, 0), b3, voffB);
            PG8_BAR; PG8_WAIT_L(0); PG8_MMA(0, 1, At, B1); PG8_BAR;
            PG8_LDA(At, 1, 1); PG8_STAGE(PG8_SA(1, 0), a3, voffA);
            PG8_BAR; PG8_WAIT_L(0); PG8_MMA(1, 0, At, B0); PG8_BAR; PG8_SCHED;
            PG8_STAGE(PG8_SB(1, 1), b3 + hstep, voffB);
            PG8_WAIT_V(6); PG8_BAR; PG8_MMA(1, 1, At, B1); PG8_BAR;
            }
        }
        if constexpr (ALIGN_EPI) { if (wr == 0) PG8_BAR; }
        if constexpr (!Epi::AFTER_DRAIN) { E(acc, cur, wr, wc, fr, fq); S.done(cur); }
        if (!has_next) break;
#pragma unroll
        for (int a = 0; a < 2; ++a)
#pragma unroll
            for (int b = 0; b < 2; ++b)
#pragma unroll
                for (int m = 0; m < 4; ++m)
#pragma unroll
                    for (int n = 0; n < 2; ++n) acc[a][b][m][n] = (AccT){0, 0, 0, 0};
        cur = nxt; cA = nA; cB = nB; ++ui;
        if constexpr (ALIGN_EPI) { if (wr == 1) PG8_BAR; }
    }
    PG8_WAIT_V(0);
    if constexpr (!ALIGN_EPI) { if (wr == 0) PG8_BAR; }
    PG8_BAR;
    if constexpr (Epi::AFTER_DRAIN) { E.fused(acc, cur, wr, wc, fr, fq, lds, wid, lane); S.done(cur); }
#undef PG8_SA
#undef PG8_SB
#undef PG8_STAGE
#undef PG8_LDA
#undef PG8_LDB
#undef PG8_MMA
#undef PG8_WAIT_V
#undef PG8_WAIT_L
#undef PG8_BAR
#undef PG8_SCHED
}
}
#define LAS __attribute__((address_space(3)))
#define XB_TMO      128
#define XB_XCNT(j)  (256  + 64 * (j))
#define XB_XSUB(j)  (1280 + 64 * (j))
#define XB_XGEN(j)  (2304 + 64 * (j))
#define XB_TOP      3328
#define XB_TOPGEN   3392
#define XCD_BAR_WORDS 3456
#define XB_SPIN_CAP (1u << 18)

__device__ __forceinline__ unsigned xb_ld(unsigned* p)              { return __hip_atomic_load(p, __ATOMIC_RELAXED, __HIP_MEMORY_SCOPE_AGENT); }
__device__ __forceinline__ unsigned xb_add(unsigned* p, unsigned v) { return __hip_atomic_fetch_add(p, v, __ATOMIC_RELAXED, __HIP_MEMORY_SCOPE_AGENT); }
__device__ __forceinline__ unsigned xb_xcc_id() { return (unsigned)__builtin_amdgcn_s_getreg((3 << 11) | 20) & 0xFu; }
#define XB_SPIN(cond, bar) do { unsigned _sp = 0; while (cond) { __builtin_amdgcn_s_sleep(1); \
    if ((++_sp & 255u) == 0u) { if (xb_ld(&(bar)[XB_TMO])) break; if (_sp > XB_SPIN_CAP) { atomicAdd(&(bar)[XB_TMO], 1u); break; } } } } while (0)

struct XcdBarrier {
    unsigned* bar; unsigned x;
    volatile LAS unsigned* st;
};

__device__ __forceinline__ XcdBarrier xcd_barrier_post(unsigned* bar, volatile LAS unsigned* st, const int wv) {
    XcdBarrier b; b.bar = bar; b.x = (unsigned)__builtin_amdgcn_readfirstlane((int)xb_xcc_id()); b.st = st;
    if (tid_of(wv) == 0) (void)xb_add(&bar[XB_XCNT(b.x)], 1u);
    return b;
}
__device__ __forceinline__ void xcd_barrier_complete(unsigned* bar, unsigned x, unsigned& nloc, unsigned& nx) {
    const unsigned G = gridDim.x * gridDim.y * gridDim.z;
    unsigned sum, cnt, mine, sp = 0u;
    for (;;) {
        sum = 0u; cnt = 0u; mine = 0u;
#pragma unroll
        for (unsigned j = 0; j < 16; ++j) { const unsigned c = xb_ld(&bar[XB_XCNT(j)]); sum += c; cnt += (c > 0u) ? 1u : 0u; mine = (j == x) ? c : mine; }
        if (sum == G) break;
        __builtin_amdgcn_s_sleep(1);
        if ((++sp & 255u) == 0u) { if (xb_ld(&bar[XB_TMO])) break; if (sp > XB_SPIN_CAP) { atomicAdd(&bar[XB_TMO], 1u); break; } }
    }
    nloc = mine > 0u ? mine : 1u; nx = cnt > 0u ? cnt : 1u;
}

__device__ __forceinline__ void xcd_barrier(const XcdBarrier& b, const int wv) {
    asm volatile("s_waitcnt vmcnt(0)" ::: "memory");
    __syncthreads();
    if (tid_of(wv) == 0) {
        unsigned* bar = b.bar; unsigned bx = b.x; asm volatile("" : "+s"(bx));
        __builtin_amdgcn_s_waitcnt(0);
        unsigned nloc = b.st[0], nx = b.st[1];
        if (nloc == 0u) { xcd_barrier_complete(bar, bx, nloc, nx); b.st[0] = nloc; b.st[1] = nx; }
        const unsigned old = xb_add(&bar[XB_XSUB(bx)], 1u);
        const unsigned gen = old / nloc;
        if (old + 1u == (gen + 1u) * nloc) {
            __builtin_amdgcn_fence(__ATOMIC_RELEASE, "agent");
            asm volatile("s_waitcnt vmcnt(0)" ::: "memory");
            const unsigned og = xb_add(&bar[XB_TOP], 1u);
            const unsigned tg = og / nx;
            if (og + 1u == (tg + 1u) * nx) xb_add(&bar[XB_TOPGEN], 1u);
            else XB_SPIN(xb_ld(&bar[XB_TOPGEN]) == tg, bar);
            __builtin_amdgcn_fence(__ATOMIC_ACQUIRE, "agent");
            xb_add(&bar[XB_XGEN(bx)], 1u);
            asm volatile("s_waitcnt vmcnt(0)" ::: "memory");
        } else {
            XB_SPIN(xb_ld(&bar[XB_XGEN(bx)]) == gen, bar);
            __builtin_amdgcn_fence(__ATOMIC_ACQUIRE, "agent");
            asm volatile("s_waitcnt vmcnt(0)" ::: "memory");
        }
    }
    __syncthreads();
}

namespace attn {
constexpr int D = 128;
constexpr float THR = 8.f;
constexpr bool WSKIP = true;
constexpr float SCALE = 0.08838834764831845f;
constexpr int NW = 8, QBLK = 32, KVBLK = 64, QB = NW * QBLK;
constexpr int SHM_V = KVBLK * D * 2, SHM_K = KVBLK * D * 2;
constexpr int LDS_BYTES = 2 * SHM_V + 2 * SHM_K + NW * 64 * 4;
typedef short bf16x8 __attribute__((ext_vector_type(8)));
typedef short s16x4 __attribute__((ext_vector_type(4)));
typedef float f32x16 __attribute__((ext_vector_type(16)));
typedef float f32x4 __attribute__((ext_vector_type(4)));
typedef unsigned u32x4 __attribute__((ext_vector_type(4)));
template <class A, class Bt> struct same_t { static constexpr bool v = false; };
template <class A> struct same_t<A, A> { static constexpr bool v = true; };

#define KSWZ(row, colB) ((row) * 256 + ((colB) ^ (((row) & 7) << 4)))
#define SBAR() __builtin_amdgcn_sched_barrier(0)
__device__ __forceinline__ int v_st(int k, int c) { const int kk = (k & ~0xC) | ((k & 4) << 1) | ((k & 8) >> 1); return ((kk >> 3) * 4 + (c >> 5)) * 512 + ((kk & 7) * 32 + (c & 31)) * 2; }
__device__ __forceinline__ int v_rd_base(int lane) { return ((lane & 3) << 3) | (((lane >> 2) & 3) << 6) | (((lane >> 4) & 1) << 5) | (((lane >> 5) & 1) << 8); }
constexpr int v_rd_off(int d0, int ks, int half) { return d0 * 512 + ks * 4096 + half * 2048; }
__device__ __forceinline__ int crow(int r, int hi) { return (r & 3) + 8 * (r >> 2) + 4 * hi; }
__device__ __forceinline__ unsigned cvtpk(float lo, float hi) {
    unsigned r; asm volatile("v_cvt_pk_bf16_f32 %0, %1, %2" : "=v"(r) : "v"(lo), "v"(hi)); return r;
}
__device__ __forceinline__ bf16x8 pack8(f32x4 a, f32x4 b) {
    u32x4 w = {cvtpk(a[0], a[1]), cvtpk(a[2], a[3]), cvtpk(b[0], b[1]), cvtpk(b[2], b[3])};
    return *reinterpret_cast<bf16x8*>(&w);
}
template <class T> __device__ __forceinline__ bf16x8 load8(const T* p) {
    if constexpr (same_t<T, float>::v) { return pack8(*(const f32x4*)p, *(const f32x4*)(p + 4)); }
    else { return *reinterpret_cast<const bf16x8*>(p); }
}
__device__ __forceinline__ void mask_tile(f32x16& p0, f32x16& p1, int dq, unsigned W) {
    const float NEG = -__builtin_inff();
#pragma unroll
    for (int r = 0; r < 16; ++r) {
        const int c = (r & 3) + 8 * (r >> 2);
        if ((unsigned)(dq - c) >= W) p0[r] = NEG;
        if ((unsigned)(dq - c - 32) >= W) p1[r] = NEG;
    }
}
__device__ __forceinline__ void partialSM(f32x16& p0, f32x16& p1, float& m_reg, float& mn, float& alpha) {
    float pmax = p0[0]; for (int r = 1; r < 16; ++r) pmax = fmaxf(pmax, p0[r]); for (int r = 0; r < 16; ++r) pmax = fmaxf(pmax, p1[r]);
    { float pa_ = pmax, pb_ = pmax; half_swap(pa_, pb_); pmax = fmaxf(pa_, pb_); }
    constexpr float C2 = 1.4426950408889634f * SCALE;
    if (__builtin_expect(__all((pmax - m_reg) * SCALE <= THR), 1)) { mn = m_reg; alpha = 1.f; }
    else { mn = fmaxf(m_reg, pmax); alpha = __builtin_amdgcn_exp2f((m_reg - mn) * C2); m_reg = mn; }
    const float mnL = -mn * C2;
    for (int r = 0; r < 16; ++r) p0[r] = fmaf(p0[r], C2, mnL); for (int r = 0; r < 16; ++r) p1[r] = fmaf(p1[r], C2, mnL);
    for (int r = 0; r < 16; ++r) p0[r] = __builtin_amdgcn_exp2f(p0[r]);
}
__device__ __forceinline__ void finishSM(f32x16& p0, f32x16& p1, float alpha, float& l_reg, bf16x8& pa0, bf16x8& pa1, bf16x8& pa2, bf16x8& pa3) {
    for (int r = 0; r < 16; ++r) p1[r] = __builtin_amdgcn_exp2f(p1[r]);
    float ps = 0; for (int r = 0; r < 16; ++r) ps += p0[r]; for (int r = 0; r < 16; ++r) ps += p1[r];
    { float pa_ = ps, pb_ = ps; half_swap(pa_, pb_); ps = pa_ + pb_; }
    l_reg = l_reg * alpha + ps;
#define PK4(P, B_, OUT) do { unsigned a0 = cvtpk(P[B_+0], P[B_+1]), a1 = cvtpk(P[B_+2], P[B_+3]);                          \
        unsigned b0 = cvtpk(P[B_+4], P[B_+5]), b1 = cvtpk(P[B_+6], P[B_+7]);                                             \
        auto r0 = __builtin_amdgcn_permlane32_swap(a0, b0, false, false); auto r1 = __builtin_amdgcn_permlane32_swap(a1, b1, false, false); \
        u32x4 w = {r0[0], r1[0], r0[1], r1[1]}; OUT = *reinterpret_cast<bf16x8*>(&w); } while (0)
    PK4(p0, 0, pa0); PK4(p0, 8, pa1); PK4(p1, 0, pa2); PK4(p1, 8, pa3);
#undef PK4
}
template <int KB, bool SK>
__device__ __forceinline__ void qkt(f32x16& p0, f32x16& p1, const char* K_lds, int r32, int hi, const bf16x8* qr, bool act, float e0, float beta) {
    if (SK && !act) { const float NEG = -__builtin_inff();
#pragma unroll
        for (int r = 0; r < 16; ++r) { p0[r] = NEG; p1[r] = NEG; } return; }
    { const float b8 = 8.f * beta, b32 = 32.f * beta;
      p0[0] = e0; p0[1] = p0[0] + beta; p0[2] = p0[1] + beta; p0[3] = p0[2] + beta;
#pragma unroll
      for (int r = 4; r < 16; ++r) p0[r] = p0[r - 4] + b8;
#pragma unroll
      for (int r = 0; r < 16; ++r) p1[r] = p0[r] + b32; }
    const char* kb[4];
#pragma unroll
    for (int dd = 0; dd < 4; ++dd) kb[dd] = K_lds + KB * SHM_K + KSWZ(r32, (dd * 16 + hi * 8) * 2);
#pragma unroll
    for (int d0 = 0; d0 < 8; ++d0) { const char* a = kb[d0 & 3] + (d0 >> 2) * 128;
        bf16x8 b0 = *reinterpret_cast<const bf16x8*>(a);
        bf16x8 b1 = *reinterpret_cast<const bf16x8*>(a + 32 * 256);
        p0 = __builtin_amdgcn_mfma_f32_32x32x16_bf16(b0, qr[d0], p0, 0, 0, 0);
        p1 = __builtin_amdgcn_mfma_f32_32x32x16_bf16(b1, qr[d0], p1, 0, 0, 0); }
}
template <int VB, bool SK>
__device__ __forceinline__ void pv_tile(f32x16* o, int vb0, bf16x8 pa0, bf16x8 pa1, bf16x8 pa2, bf16x8 pa3, bool act) {
    if (SK && !act) return;
#define TRRD(dst, off) asm volatile("ds_read_b64_tr_b16 %0, %1 offset:%2" : "=&v"(dst) : "v"(vb0), "i"(off) : "memory")
#define PV_D0(d0) do { s16x4 l0, l1, l2, l3, h0, h1, h2, h3; constexpr int b_ = VB * SHM_V + v_rd_off(d0, 0, 0);     \
        TRRD(l0, b_); TRRD(h0, b_ + 2048); TRRD(l1, b_ + 4096); TRRD(h1, b_ + 6144); TRRD(l2, b_ + 8192); TRRD(h2, b_ + 10240); TRRD(l3, b_ + 12288); TRRD(h3, b_ + 14336); \
        asm volatile("s_waitcnt lgkmcnt(0)" ::: "memory"); SBAR();                 \
        o[d0] = __builtin_amdgcn_mfma_f32_32x32x16_bf16(pa0, (bf16x8){l0[0], l0[1], l0[2], l0[3], h0[0], h0[1], h0[2], h0[3]}, o[d0], 0, 0, 0);   \
        o[d0] = __builtin_amdgcn_mfma_f32_32x32x16_bf16(pa1, (bf16x8){l1[0], l1[1], l1[2], l1[3], h1[0], h1[1], h1[2], h1[3]}, o[d0], 0, 0, 0);   \
        o[d0] = __builtin_amdgcn_mfma_f32_32x32x16_bf16(pa2, (bf16x8){l2[0], l2[1], l2[2], l2[3], h2[0], h2[1], h2[2], h2[3]}, o[d0], 0, 0, 0);   \
        o[d0] = __builtin_amdgcn_mfma_f32_32x32x16_bf16(pa3, (bf16x8){l3[0], l3[1], l3[2], l3[3], h3[0], h3[1], h3[2], h3[3]}, o[d0], 0, 0, 0); } while (0)
    PV_D0(0); PV_D0(1); PV_D0(2); PV_D0(3);
#undef PV_D0
#undef TRRD
}

template <class TIn, class TOut> struct BlockRef { const TIn* Q; const TIn* K; const TIn* V; TOut* O; float* L; int P0; int pitch; int opitch; int lpitch; float beta; };
template <class TIn> struct Seam {
    bf16x8 qr[8];
    bf16x8 st_v0, st_v1, st_k0, st_k1; f32x4 sf0, sf1, sf2, sf3;
    f32x4 tq[16];
};
__device__ __forceinline__ int swa_jlo(int P0, int W) { const int lowk = P0 - W + 1; return lowk > 0 ? lowk / KVBLK : 0; }
#define ROW(p, pt, k0, rr) ((p) + (size_t)((k0) + (rr)) * (size_t)(pt) + sc)
#define VMW() asm volatile("s_waitcnt vmcnt(0)" ::: "memory")
#define VMWN(n) asm volatile("s_waitcnt vmcnt(%0)" :: "i"(n) : "memory")
#define SLOAD_H(Kp, Vp, pt, k0) do { S.st_v0 = load8<TIn>(ROW(Vp, pt, k0, sr)); S.st_v1 = load8<TIn>(ROW(Vp, pt, k0, 32 + sr));              \
                         S.st_k0 = load8<TIn>(ROW(Kp, pt, k0, sr)); S.st_k1 = load8<TIn>(ROW(Kp, pt, k0, 32 + sr)); } while (0)
#define SWRITE_HK(bf) do { *(bf16x8*)(K_lds + (bf) * SHM_K + kws) = S.st_k0; *(bf16x8*)(K_lds + (bf) * SHM_K + kws + 32 * 256) = S.st_k1; } while (0)
#define SWRITE_HV(bf) do { *(bf16x8*)(V_lds + (bf) * SHM_V + vst0) = S.st_v0; *(bf16x8*)(V_lds + (bf) * SHM_V + vst1) = S.st_v1; } while (0)
#define SWRITE_H(bf) do { SWRITE_HV(bf); SWRITE_HK(bf); } while (0)
#define SLOAD_F(p, k0) do { S.sf0 = *(const f32x4*)ROW(p, D, k0, sr); S.sf1 = *(const f32x4*)(ROW(p, D, k0, sr) + 4);                \
                            S.sf2 = *(const f32x4*)ROW(p, D, k0, 32 + sr); S.sf3 = *(const f32x4*)(ROW(p, D, k0, 32 + sr) + 4); } while (0)
#define SWRITE_KF(bf) do { *(bf16x8*)(K_lds + (bf) * SHM_K + kws) = pack8(S.sf0, S.sf1); *(bf16x8*)(K_lds + (bf) * SHM_K + kws + 32 * 256) = pack8(S.sf2, S.sf3); } while (0)
#define SWRITE_VF(bf) do { *(bf16x8*)(V_lds + (bf) * SHM_V + vst0) = pack8(S.sf0, S.sf1); *(bf16x8*)(V_lds + (bf) * SHM_V + vst1) = pack8(S.sf2, S.sf3); } while (0)
template <class TIn, class TOut>
__device__ __forceinline__ void causal_swa_prime(const BlockRef<TIn, TOut>& cur, int W, char* lds, Seam<TIn>& S, const int wv) {
    constexpr bool F32 = same_t<TIn, float>::v;
    const int tid = tid_of(wv), wid = __builtin_amdgcn_readfirstlane(tid >> 6), lane = tid & 63, r32 = lane & 31, hi = lane >> 5;
    const int sr = tid >> 4, sc = (tid & 15) * 8, kws = KSWZ(sr, sc * 2); char* K_lds = lds + 2 * SHM_V;
    const int kb0 = swa_jlo(cur.P0, W) * KVBLK;
    for (int d0 = 0; d0 < 8; ++d0) S.qr[d0] = load8<TIn>(cur.Q + (size_t)(wid * QBLK + r32) * (size_t)cur.pitch + d0 * 16 + hi * 8);
    if constexpr (F32) { SLOAD_F((const float*)cur.K, kb0); VMW(); SWRITE_KF(0); SBAR(); SLOAD_F((const float*)cur.V, kb0); }
    else { SLOAD_H(cur.K, cur.V, cur.pitch, kb0); VMW(); SWRITE_HK(0); }
    __syncthreads();
}
template <class TIn, class TOut>
__device__ __forceinline__ void causal_swa_block(const BlockRef<TIn, TOut>& cur, const BlockRef<TIn, TOut>& nxt, int skv, int W, char* lds, Seam<TIn>& S, const int wv) {
    constexpr bool F32 = same_t<TIn, float>::v;
    const int tid = tid_of(wv), wid = __builtin_amdgcn_readfirstlane(tid >> 6), lane = tid & 63, r32 = lane & 31, hi = lane >> 5;
    const int j_lo = swa_jlo(cur.P0, W);
    int j_hi = (cur.P0 + QB - 1) / KVBLK + 1; if (j_hi > skv / KVBLK) j_hi = skv / KVBLK;
    const int NT = j_hi - j_lo;
    const int kbn = swa_jlo(nxt.P0, W) * KVBLK;
    const int qlo = cur.P0 + wid * QBLK, qm = qlo + r32 - 4 * hi;
    char* V_lds = lds; char* K_lds = lds + 2 * SHM_V;
    float* ws = (float*)(lds + 2 * SHM_V + 2 * SHM_K) + wid * 64; float* li_l = ws, * al_l = ws + 32;
    float m_reg = -1e30f, l_reg = 0; f32x16 o[4] = {};
    const int sr = tid >> 4, sc = (tid & 15) * 8, vst0 = v_st(sr, sc), vst1 = v_st(32 + sr, sc), kws = KSWZ(sr, sc * 2);
    const int vb0 = (int)(uintptr_t)V_lds + v_rd_base(lane);
    const TIn* Kh = cur.K; const TIn* Vh = cur.V; const int pch = cur.pitch; const float beta = cur.beta;
#define RESC(a) do { if (__any((a) < 1.f)) { if (hi == 0) al_l[r32] = (a); asm volatile("s_waitcnt lgkmcnt(0)" ::: "memory");              \
                     for (int d_ = 0; d_ < 4; ++d_) for (int r = 0; r < 16; ++r) o[d_][r] *= al_l[crow(r, hi)]; } } while (0)
#define KBASE(t) ((j_lo + (t)) * KVBLK)
#define ACT(t) (KBASE(t) <= qlo + QBLK - 1 && KBASE(t) + KVBLK - 1 >= qlo - W + 1)
#define MASKT(P0_, P1_, t) do { const int kb_ = KBASE(t); if ((!SK || ACT(t)) && (kb_ + KVBLK - 1 > qlo || kb_ <= qlo + QBLK - 1 - W)) mask_tile(P0_, P1_, qm - kb_, (unsigned)W); } while (0)
    constexpr int NQL = F32 ? 16 : 8;
    constexpr bool SK = WSKIP && !F32;
#define SEAM_K0() do { VMWN(NQL); if constexpr (F32) { SWRITE_KF(0); SBAR(); SLOAD_F((const float*)nxt.V, kbn); } else { SWRITE_HK(0); } SBAR(); } while (0)
    f32x16 pA0, pA1, pB0, pB1; float mnA, mnB, alA, alB; bf16x8 pa0, pa1, pa2, pa3;
    if constexpr (F32) { VMW(); SWRITE_VF(0); SBAR(); } else { SWRITE_HV(0); SBAR(); }
    if (NT > 1) { if constexpr (F32) SLOAD_F((const float*)Kh, KBASE(1)); else SLOAD_H(Kh, Vh, pch, KBASE(1)); }
    SBAR(); qkt<0, SK>(pA0, pA1, K_lds, r32, hi, S.qr, ACT(0), -beta * (float)(qm - KBASE(0)), beta);
    if constexpr (F32) { if (NT > 1) { VMW(); SWRITE_KF(1); SBAR(); SLOAD_F((const float*)Vh, KBASE(1)); } }
    MASKT(pA0, pA1, 0); partialSM(pA0, pA1, m_reg, mnA, alA);
    if (NT > 1) { VMW(); if constexpr (F32) { SWRITE_VF(1); SBAR(); if (NT > 2) SLOAD_F((const float*)Kh, KBASE(2)); } else SWRITE_H(1); }
    __syncthreads();
#define HALF_STEP(PX0, PX1, mnX, alX, PY0, PY1, alY, t, KB, VB, SB) do {                                                      \
        SBAR(); qkt<KB, SK>(PX0, PX1, K_lds, r32, hi, S.qr, ACT(t), -beta * (float)(qm - KBASE(t)), beta);                                             \
        finishSM(PY0, PY1, alY, l_reg, pa0, pa1, pa2, pa3); SBAR();                                                           \
        if ((t) + 1 < NT) { if constexpr (F32) { VMW(); SWRITE_KF(SB); SBAR(); SLOAD_F((const float*)Vh, KBASE((t) + 1)); }  \
                            else { SLOAD_H(Kh, Vh, pch, KBASE((t) + 1)); } SBAR(); }                                               \
        pv_tile<VB, SK>(o, vb0, pa0, pa1, pa2, pa3, ACT((t) - 1)); MASKT(PX0, PX1, (t)); partialSM(PX0, PX1, m_reg, mnX, alX);                                        \
        __syncthreads();                                                                                                      \
        if ((t) + 1 < NT) { VMW(); if constexpr (F32) { SWRITE_VF(SB); SBAR(); if ((t) + 2 < NT) SLOAD_F((const float*)Kh, KBASE((t) + 2)); } \
                            else { SWRITE_H(SB); } }                                                                          \
        RESC(alX); __syncthreads(); } while (0)
    for (int t = 1; t + 1 < NT; t += 2) {
        HALF_STEP(pB0, pB1, mnB, alB, pA0, pA1, alA, t, 1, 0, 0);
        HALF_STEP(pA0, pA1, mnA, alA, pB0, pB1, alB, t + 1, 0, 1, 1);
    }
    const bool even = (NT & 1) == 0;
    if (even) { SBAR(); qkt<1, SK>(pB0, pB1, K_lds, r32, hi, S.qr, ACT(NT - 1), -beta * (float)(qm - KBASE(NT - 1)), beta); SBAR(); }
#define QROW(e) (nxt.Q + (size_t)(wid * QBLK + r32) * D + ((e) >> 1) * 16 + hi * 8 + ((e) & 1) * 4)
    if constexpr (F32) { SLOAD_F((const float*)nxt.K, kbn); SBAR();
#pragma unroll
        for (int e = 0; e < 8; ++e) S.tq[e] = *(const f32x4*)QROW(e); }
    else { SLOAD_H(nxt.K, nxt.V, nxt.pitch, kbn); SBAR();
#pragma unroll
        for (int d0 = 0; d0 < 8; ++d0) S.qr[d0] = load8<TIn>(nxt.Q + (size_t)(wid * QBLK + r32) * (size_t)nxt.pitch + d0 * 16 + hi * 8); }
    SBAR();
    finishSM(pA0, pA1, alA, l_reg, pa0, pa1, pa2, pa3); SBAR();
    if constexpr (F32) {
#pragma unroll
        for (int e = 8; e < 16; ++e) S.tq[e] = *(const f32x4*)QROW(e); SBAR(); }
#undef QROW
    pv_tile<0, SK>(o, vb0, pa0, pa1, pa2, pa3, ACT(even ? NT - 2 : NT - 1));
    if (even) { MASKT(pB0, pB1, NT - 1); partialSM(pB0, pB1, m_reg, mnB, alB); __syncthreads(); RESC(alB);
        finishSM(pB0, pB1, alB, l_reg, pa0, pa1, pa2, pa3); SBAR(); pv_tile<1, SK>(o, vb0, pa0, pa1, pa2, pa3, ACT(NT - 1)); }
    SBAR(); SEAM_K0();
    if (hi == 0) { li_l[r32] = l_reg; cur.L[(size_t)(wid * QBLK + r32) * (size_t)cur.lpitch] = m_reg * SCALE + __logf(l_reg); }
    asm volatile("s_waitcnt lgkmcnt(0)" ::: "memory");
    float rli[16];
#pragma unroll
    for (int r = 0; r < 16; ++r) rli[r] = __builtin_amdgcn_rcpf(li_l[crow(r, hi)]);
    TOut* Ow = cur.O + (size_t)(wid * QBLK) * (size_t)cur.opitch; const size_t opch = (size_t)cur.opitch;
    if constexpr (same_t<TOut, float>::v) {
#pragma unroll
        for (int r = 0; r < 16; ++r) { const int orow = crow(r, hi);
#pragma unroll
            for (int d0 = 0; d0 < 4; ++d0) Ow[(size_t)orow * opch + d0 * 32 + r32] = o[d0][r] * rli[r]; }
    } else {
        constexpr int EST = 72, ETILE = D * EST;
        char* T = lds + LDS_BYTES + wid * ETILE;
#pragma unroll
        for (int d0 = 0; d0 < 4; ++d0)
#pragma unroll
            for (int rr = 0; rr < 4; ++rr) { typedef unsigned u32x2 __attribute__((ext_vector_type(2))); u32x2 w;
                w.x = cvtpk(o[d0][4 * rr] * rli[4 * rr], o[d0][4 * rr + 1] * rli[4 * rr + 1]); w.y = cvtpk(o[d0][4 * rr + 2] * rli[4 * rr + 2], o[d0][4 * rr + 3] * rli[4 * rr + 3]);
                *(u32x2*)(T + (32 * d0 + r32) * EST + (8 * rr + 4 * hi) * 2) = w; }
        asm volatile("s_waitcnt lgkmcnt(0)" ::: "memory");
        { const int g = (lane >> 4) & 1, i16 = lane & 15, q = i16 >> 2, p = i16 & 3;
          const int abase = (int)(uintptr_t)T + (8 * hi + q) * EST + (16 * g + 4 * p) * 2;
          TOut* orow = Ow + (size_t)(16 * g + i16) * opch + 8 * hi;
#pragma unroll
          for (int t = 0; t < 8; ++t) { s16x4 lo, hh;
              asm volatile("ds_read_b64_tr_b16 %0, %1 offset:%2" : "=&v"(lo) : "v"(abase), "i"(16 * t * EST) : "memory");
              asm volatile("ds_read_b64_tr_b16 %0, %1 offset:%2" : "=&v"(hh) : "v"(abase), "i"(16 * t * EST + 4 * EST) : "memory");
              asm volatile("s_waitcnt lgkmcnt(0)" : "+v"(lo), "+v"(hh) :: "memory");
              const bf16x8 ov = {lo[0], lo[1], lo[2], lo[3], hh[0], hh[1], hh[2], hh[3]};
              *(bf16x8*)(orow + 16 * t) = ov; } }
    }
    if constexpr (F32) {
#pragma unroll
        for (int d0 = 0; d0 < 8; ++d0) S.qr[d0] = pack8(S.tq[2 * d0], S.tq[2 * d0 + 1]); }
    __syncthreads();
#undef RESC
#undef KBASE
#undef ACT
#undef MASKT
#undef SEAM_K0
#undef HALF_STEP
}
#undef ROW
#undef VMW
#undef VMWN
#undef SLOAD_H
#undef SWRITE_HK
#undef SWRITE_HV
#undef SWRITE_H
#undef SLOAD_F
#undef SWRITE_KF
#undef SWRITE_VF

#undef KSWZ
#undef SBAR
}

typedef unsigned short bf16;
typedef unsigned v4u __attribute__((ext_vector_type(4)));
typedef float f32x4 __attribute__((ext_vector_type(4)));
constexpr int D_MODEL = 4096, BATCH = 2, SEQ = 4096, DEPTH = 2, HEAD_DIM = 128, D_ATTN = 2048, D_SGU = 2048, NH = 16, NG = 16, CHUNK = 128;
constexpr int N_IN = 10240, D_FF = 11008, N_UP = 2 * D_FF, M_TOK = BATCH * SEQ;
constexpr float NORM_EPS = 1e-6f;
constexpr int ZQ = 0, ZK = 2048, ZV = 4096, ZU = 6144, ZV2 = 8192;
constexpr int NWAVES = 8, NTHREADS = 512;
constexpr int NQ8 = 8192;
constexpr int RING_BYTES = 131072, MISC_OFF = 140 * 1024, LDS_BYTES = 147456;
constexpr size_t MiB = 1u << 20;
constexpr size_t SZ_WIN = (size_t)N_IN * D_MODEL * 2, SZ_WOUT = (size_t)D_MODEL * D_MODEL * 2, SZ_WUP = (size_t)N_UP * D_MODEL * 2, SZ_WDN = (size_t)D_MODEL * D_FF * 2;
constexpr size_t OFF_CTL = 0, OFF_RS = 16384, RS_BYTES = (size_t)M_TOK * 8, CTL_BYTES = OFF_RS + 5 * RS_BYTES;
constexpr size_t OFF_WIN = 1 * MiB, OFF_WOUT = OFF_WIN + 2 * SZ_WIN, OFF_WUP = OFF_WOUT + 2 * SZ_WOUT, OFF_WDN = OFF_WUP + 2 * SZ_WUP, OFF_H = OFF_WDN + 2 * SZ_WDN;
constexpr size_t OFF_Z = OFF_H + (size_t)M_TOK * D_MODEL * 2, OFF_MX = OFF_Z + (size_t)M_TOK * N_IN * 2, OFF_UP = OFF_MX + (size_t)M_TOK * D_MODEL * 2;
constexpr size_t OFF_ACT = OFF_UP + (size_t)M_TOK * N_UP * 2, OFF_OC = OFF_ACT + (size_t)M_TOK * D_FF * 2, OFF_LSE = OFF_OC + (size_t)3 * M_TOK * D_ATTN * 2, OFF_U4 = OFF_LSE + (size_t)3 * M_TOK * NH * 4, OFF_SB = OFF_U4 + (size_t)(M_TOK / 64) * 4 * N_UP * 4, OFF_SA = OFF_SB + (size_t)DEPTH * N_UP * 4, OFF_XQ = OFF_SA + (size_t)M_TOK * 4, WS_END = OFF_XQ + (size_t)M_TOK * D_MODEL;
constexpr size_t OFF_WINQ = OFF_UP, OFF_SBIN = OFF_WINQ + (size_t)DEPTH * NQ8 * D_MODEL;
static_assert(OFF_SBIN + (size_t)DEPTH * NQ8 * 4 <= OFF_ACT, "int8 input-projection weights fit");
static_assert(CTL_BYTES <= OFF_WIN && XCD_BAR_WORDS * 4 <= OFF_RS, "barrier words inside the memset region");

__device__ __forceinline__ unsigned f2bf(float f) { unsigned u = __builtin_bit_cast(unsigned, f); return (u + 0x7fffu + ((u >> 16) & 1u)) >> 16; }
__device__ __forceinline__ unsigned pk2(float lo, float hi) { return f2bf(lo) | (f2bf(hi) << 16); }
__device__ __forceinline__ float bf2f(unsigned short b) { return __builtin_bit_cast(float, (unsigned)b << 16); }
__device__ __forceinline__ float bflo(unsigned w) { return __builtin_bit_cast(float, w << 16); }
__device__ __forceinline__ float bfhi(unsigned w) { return __builtin_bit_cast(float, w & 0xffff0000u); }
#define LDS_WAIT() asm volatile("s_waitcnt lgkmcnt(0)" ::: "memory")

constexpr int CVT_STRIDE = 192, CVT_TILE = 64 * CVT_STRIDE;
struct CvtRegs { f32x4 v[16]; };
__device__ __forceinline__ void cvt_item_kn(int item, int nblk, int kbw, int& kb, int& nb) { const int nbw = 32 / kbw, st = item >> 5, w = item & 31, nst = nblk / nbw; const int sk = st / nst, sn = st - sk * nst; kb = kbw * sk + (w % kbw); nb = nbw * sn + (w / kbw); }
__device__ __forceinline__ void cvt_load(CvtRegs& R, const float* W, int N, int item, int lane, int nblk, int kbw) {
    int kb, nb; cvt_item_kn(item, nblk, kbw, kb, nb); const float* p = W + (size_t)(64 * kb + (lane >> 4)) * N + 64 * nb + 4 * (lane & 15);
#pragma unroll
    for (int i = 0; i < 16; ++i) R.v[i] = *(const f32x4*)(p + (size_t)(4 * i) * N);
}
__device__ __forceinline__ void cvt_store(const CvtRegs& R, int K, int N, bf16* WT, LAS unsigned char* tile, int item, int lane, int nblk, int kbw, bool glu, const float* gk) {
    int kb, nb; cvt_item_kn(item, nblk, kbw, kb, nb); const int k0 = 64 * kb, n0 = 64 * nb;
    const int half = N / 2, r0 = glu ? ((n0 < half) ? 256 * (n0 >> 7) + (n0 & 127) : 256 * ((n0 - half) >> 7) + 128 + ((n0 - half) & 127)) : n0;
    { LAS unsigned char* wp = tile + (lane >> 4) * CVT_STRIDE + 8 * (lane & 15);
#pragma unroll
      for (int i = 0; i < 16; ++i) { const float gg = gk ? gk[k0 + 4 * i + (lane >> 4)] : 1.f; const f32x4 x = R.v[i] * gg;
          typedef unsigned u32x2 __attribute__((ext_vector_type(2))); u32x2 w; w.x = pk2(x.x, x.y); w.y = pk2(x.z, x.w); *(LAS u32x2*)(wp + 4 * i * CVT_STRIDE) = w; } }
    LDS_WAIT();
    { const int hh = lane >> 5, g = (lane >> 4) & 1, i16 = lane & 15, q = i16 >> 2, p = i16 & 3;
      const int abase = (int)(uintptr_t)tile + (8 * hh + q) * CVT_STRIDE + (16 * g + 4 * p) * 2;
      bf16* orow = WT + (size_t)(r0 + 16 * g + i16) * K + k0 + 8 * hh;
#pragma unroll
      for (int nb2 = 0; nb2 < 2; ++nb2)
#pragma unroll
          for (int t = 0; t < 4; ++t) { typedef short s16x4 __attribute__((ext_vector_type(4))); s16x4 lo, hi;
              asm volatile("ds_read_b64_tr_b16 %0, %1 offset:%2" : "=&v"(lo) : "v"(abase), "i"(16 * t * CVT_STRIDE + 64 * nb2) : "memory");
              asm volatile("ds_read_b64_tr_b16 %0, %1 offset:%2" : "=&v"(hi) : "v"(abase), "i"(16 * t * CVT_STRIDE + 4 * CVT_STRIDE + 64 * nb2) : "memory");
              asm volatile("s_waitcnt lgkmcnt(0)" : "+v"(lo), "+v"(hi) :: "memory");
              typedef short s16x8 __attribute__((ext_vector_type(8))); const s16x8 o = {lo[0], lo[1], lo[2], lo[3], hi[0], hi[1], hi[2], hi[3]};
              *(s16x8*)(orow + (size_t)(32 * nb2) * K + 16 * t) = o; } }
    LDS_WAIT();
}
__device__ __forceinline__ void phase_convert(const float* W, int K, int N, bf16* WT, LAS unsigned char* lds, int gw, int NGW, int wave, int lane, const float* gk, bool glu = false, int ld = 0) {
    LAS unsigned char* tile = lds + wave * CVT_TILE;
    const int nblk = N / 64, items = (K / 64) * nblk, kbw = ((K / 64) % 8 == 0) ? 8 : 4; if (ld == 0) ld = N;
    int it = gw; if (it >= items) return;
    CvtRegs A, B; cvt_load(A, W, ld, it, lane, nblk, kbw);
    for (;;) {
        const int it1 = it + NGW; const bool h1 = it1 < items; if (h1) cvt_load(B, W, ld, it1, lane, nblk, kbw);
        cvt_store(A, K, N, WT, tile, it, lane, nblk, kbw, glu, gk);
        if (!h1) break;
        const int it2 = it1 + NGW; const bool h2 = it2 < items; if (h2) cvt_load(A, W, ld, it2, lane, nblk, kbw);
        cvt_store(B, K, N, WT, tile, it1, lane, nblk, kbw, glu, gk);
        if (!h2) break;
        it = it2;
    }
}
__device__ __forceinline__ int glu_row(int n, int N) { const int half = N / 2; return (n < half) ? 256 * (n >> 7) + (n & 127) : 256 * ((n - half) >> 7) + 128 + ((n - half) & 127); }
constexpr int ST_STRIDE = 528, ST_TILE = 32 * ST_STRIDE, ST_RED = NWAVES * ST_TILE;
static_assert(ST_RED + 2048 <= MISC_OFF, "strip tiles below the control words");
__device__ __forceinline__ unsigned pkbf(float lo, float hi) { unsigned r; asm("v_cvt_pk_bf16_f32 %0, %1, %2" : "=v"(r) : "v"(lo), "v"(hi)); return r; }
__device__ __forceinline__ void strip8(const float* W, int N, int n0, int r0, const float* gk, signed char* WQ, float* sB, LAS unsigned char* lds, int par, int wave, int lane) {
    const int a = lane & 7, b = lane >> 3, kw = 512 * wave;
    const float* p = W + (size_t)(kw + 4 * b) * N + n0 + 4 * a;
    const float* gp = gk + kw + 4 * b;
    unsigned P[16][4][2];
    f32x4 mx = {0.f, 0.f, 0.f, 0.f};
    f32x4 S[2][8], Gn[2][2];
#define ST_LOAD(buf, bi) do { _Pragma("unroll") for (int q = 0; q < 8; ++q) S[buf][q] = *(const f32x4*)(p + (size_t)(32 * (2 * (bi) + (q >> 2)) + (q & 3)) * N); \
        Gn[buf][0] = *(const f32x4*)(gp + 64 * (bi)); Gn[buf][1] = *(const f32x4*)(gp + 64 * (bi) + 32); } while (0)
    ST_LOAD(0, 0);
#pragma unroll
    for (int bi = 0; bi < 8; ++bi) {
        if (bi < 7) { if (bi & 1) ST_LOAD(0, bi + 1); else ST_LOAD(1, bi + 1); }
        __builtin_amdgcn_sched_barrier(0);
#pragma unroll
        for (int mm = 0; mm < 2; ++mm) { const int m = 2 * bi + mm; f32x4 x[4];
#pragma unroll
            for (int c = 0; c < 4; ++c) { x[c] = S[bi & 1][4 * mm + c] * Gn[bi & 1][mm][c];
                mx.x = fmaxf(mx.x, fabsf(x[c].x)); mx.y = fmaxf(mx.y, fabsf(x[c].y)); mx.z = fmaxf(mx.z, fabsf(x[c].z)); mx.w = fmaxf(mx.w, fabsf(x[c].w)); }
#pragma unroll
            for (int e = 0; e < 4; ++e) { P[m][e][0] = pkbf(x[0][e], x[1][e]); P[m][e][1] = pkbf(x[2][e], x[3][e]); } }
        __builtin_amdgcn_sched_barrier(0);
    }
#undef ST_LOAD
    LAS float* red = (LAS float*)(lds + ST_RED + par * 1024);
#pragma unroll
    for (int e = 0; e < 4; ++e) { float v = mx[e]; v = fmaxf(v, lane_xor<8>(v)); v = fmaxf(v, lane_xor<16>(v)); float va = v, vb = v; half_swap(va, vb); mx[e] = fmaxf(va, vb); }
    if (b == 0) *(LAS f32x4*)(red + wave * 32 + 4 * a) = mx;
    __syncthreads();
    f32x4 cm = *(LAS f32x4*)(red + 4 * a);
#pragma unroll
    for (int w2 = 1; w2 < NWAVES; ++w2) { const f32x4 o = *(LAS f32x4*)(red + w2 * 32 + 4 * a); cm.x = fmaxf(cm.x, o.x); cm.y = fmaxf(cm.y, o.y); cm.z = fmaxf(cm.z, o.z); cm.w = fmaxf(cm.w, o.w); }
    f32x4 inv;
#pragma unroll
    for (int e = 0; e < 4; ++e) { cm[e] = bflo(pkbf(cm[e], cm[e])); inv[e] = cm[e] > 0.f ? 127.f / cm[e] : 0.f; }
    if (wave == 0 && b == 0) *(f32x4*)(sB + r0 + 4 * a) = cm * (1.f / 127.f);
    LAS unsigned char* tile = lds + wave * ST_TILE;
    { LAS unsigned char* wp = tile + (4 * a) * ST_STRIDE + 4 * b;
#pragma unroll
      for (int m = 0; m < 16; ++m)
#pragma unroll
          for (int e = 0; e < 4; ++e) { const unsigned w0 = P[m][e][0], w1 = P[m][e][1];
              const unsigned t0 = __builtin_bit_cast(unsigned, __builtin_fmaf(bflo(w0), inv[e], 12582912.f)), t1 = __builtin_bit_cast(unsigned, __builtin_fmaf(bfhi(w0), inv[e], 12582912.f));
              const unsigned t2 = __builtin_bit_cast(unsigned, __builtin_fmaf(bflo(w1), inv[e], 12582912.f)), t3 = __builtin_bit_cast(unsigned, __builtin_fmaf(bfhi(w1), inv[e], 12582912.f));
              *(LAS unsigned*)(wp + e * ST_STRIDE + 32 * m) = __builtin_amdgcn_perm(t1, t0, 0x0c0c0400u) | __builtin_amdgcn_perm(t3, t2, 0x04000c0cu); } }
    LDS_WAIT();
    { signed char* orow = WQ + (size_t)(r0 + (lane >> 5)) * D_MODEL + kw + 16 * (lane & 31); LAS unsigned char* rp = tile + (lane >> 5) * ST_STRIDE + 16 * (lane & 31);
#pragma unroll
      for (int i = 0; i < 16; ++i) { const v4u v = *(LAS v4u*)(rp + 2 * i * ST_STRIDE); *(v4u*)(orow + (size_t)(2 * i) * D_MODEL) = v; } }
    LDS_WAIT();
}
__device__ __forceinline__ void phase_strips8(const float* Wup, const float* gup, signed char* WQup, float* sBup, const float* Win, const float* gin, signed char* WQin, float* sBin, LAS unsigned char* lds, int blk, int G, int wave, int lane) {
    constexpr int SPL = N_UP / 32, SPI = NQ8 / 32;
    int par = 0;
    for (int s = blk; s < DEPTH * (SPL + SPI); s += G, par ^= 1) {
        if (s < DEPTH * SPL) { const int cl = s >= SPL ? 1 : 0, n0 = 32 * (s - cl * SPL);
            strip8(Wup + (size_t)cl * D_MODEL * N_UP, N_UP, n0, glu_row(n0, N_UP), gup + (size_t)cl * D_MODEL, WQup + (size_t)cl * N_UP * D_MODEL, sBup + (size_t)cl * N_UP, lds, par, wave, lane); }
        else { const int s2 = s - DEPTH * SPL, cl = s2 >= SPI ? 1 : 0, n0 = 32 * (s2 - cl * SPI);
            strip8(Win + (size_t)cl * D_MODEL * N_IN, N_IN, n0, n0, gin + (size_t)cl * D_MODEL, WQin + (size_t)cl * NQ8 * D_MODEL, sBin + (size_t)cl * NQ8, lds, par, wave, lane); }
    }
}
struct QRow { v4u x[8]; };
__device__ __forceinline__ void qrow_load(QRow& R, const bf16* xb, int row, int lane) { const v4u* xr = (const v4u*)(xb + (size_t)row * D_MODEL) + lane;
#pragma unroll
    for (int j = 0; j < 8; ++j) R.x[j] = xr[64 * j]; }
__device__ __forceinline__ void qrow_store(const QRow& R, signed char* xq, float* sA, int row, int lane) {
    float mx = 0.f;
#pragma unroll
    for (int j = 0; j < 8; ++j) { const unsigned* w = (const unsigned*)&R.x[j];
#pragma unroll
        for (int e = 0; e < 4; ++e) mx = fmaxf(mx, fmaxf(fabsf(bflo(w[e])), fabsf(bfhi(w[e])))); }
    mx = fmaxf(mx, lane_xor<1>(mx)); mx = fmaxf(mx, lane_xor<2>(mx)); mx = fmaxf(mx, lane_xor<4>(mx)); mx = fmaxf(mx, lane_xor<8>(mx)); mx = fmaxf(mx, lane_xor<16>(mx));
    { float ma = mx, mb = mx; half_swap(ma, mb); mx = fmaxf(ma, mb); }
    const float inv = mx > 0.f ? 127.f / mx : 0.f;
    if (lane == 0) sA[row] = mx * (1.f / 127.f);
    typedef unsigned u32x2 __attribute__((ext_vector_type(2)));
    u32x2* o8 = (u32x2*)(xq + (size_t)row * D_MODEL) + lane;
#pragma unroll
    for (int j = 0; j < 8; ++j) { const unsigned* w = (const unsigned*)&R.x[j]; unsigned t[8];
#pragma unroll
        for (int e = 0; e < 4; ++e) { t[2 * e] = __builtin_bit_cast(unsigned, __builtin_fmaf(bflo(w[e]), inv, 12582912.f)); t[2 * e + 1] = __builtin_bit_cast(unsigned, __builtin_fmaf(bfhi(w[e]), inv, 12582912.f)); }
        u32x2 pk; pk.x = __builtin_amdgcn_perm(t[1], t[0], 0x0c0c0400u) | __builtin_amdgcn_perm(t[3], t[2], 0x04000c0cu); pk.y = __builtin_amdgcn_perm(t[5], t[4], 0x0c0c0400u) | __builtin_amdgcn_perm(t[7], t[6], 0x04000c0cu);
        o8[64 * j] = pk; }
}
__device__ __forceinline__ void phase_quant_rows(const bf16* xb, signed char* xq, float* sA, int gw, int NGW, int lane) {
    int row = gw; if (row >= M_TOK) return;
    QRow A, B; qrow_load(A, xb, row, lane);
    for (;;) {
        const int r1 = row + NGW; const bool h1 = r1 < M_TOK; if (h1) qrow_load(B, xb, r1, lane);
        qrow_store(A, xq, sA, row, lane);
        if (!h1) break;
        const int r2 = r1 + NGW; const bool h2 = r2 < M_TOK; if (h2) qrow_load(A, xb, r2, lane);
        qrow_store(B, xq, sA, r1, lane);
        if (!h2) break;
        row = r2;
    }
}
__device__ __forceinline__ void phase_xprep(const float* x, bf16* xb, unsigned long long* rowss, signed char* xq, float* sA, int gw, int NGW, int lane) {
    for (int row = gw; row < M_TOK; row += NGW) {
        const f32x4* xr = (const f32x4*)(x + (size_t)row * D_MODEL) + lane; float s = 0.f, mx = 0.f; unsigned w[16][2];
#pragma unroll
        for (int j = 0; j < 16; ++j) { const f32x4 v = xr[64 * j]; s += (v.x * v.x + v.y * v.y) + (v.z * v.z + v.w * v.w);
            w[j][0] = pk2(v.x, v.y); w[j][1] = pk2(v.z, v.w);
            mx = fmaxf(fmaxf(mx, fmaxf(fabsf(bflo(w[j][0])), fabsf(bfhi(w[j][0])))), fmaxf(fabsf(bflo(w[j][1])), fabsf(bfhi(w[j][1]))));
            unsigned long long* o8 = (unsigned long long*)(xb + (size_t)row * D_MODEL) + lane + 64 * j; *o8 = (unsigned long long)w[j][0] | ((unsigned long long)w[j][1] << 32); }
        s = wave_sum(s);
        if (lane == 0) rowss[row] = (unsigned long long)(long long)__builtin_rintf(s * 16777216.f);
        mx = fmaxf(mx, lane_xor<1>(mx)); mx = fmaxf(mx, lane_xor<2>(mx)); mx = fmaxf(mx, lane_xor<4>(mx)); mx = fmaxf(mx, lane_xor<8>(mx)); mx = fmaxf(mx, lane_xor<16>(mx));
        { float ma = mx, mb = mx; half_swap(ma, mb); mx = fmaxf(ma, mb); }
        const float inv = mx > 0.f ? 127.f / mx : 0.f;
        if (lane == 0) sA[row] = mx * (1.f / 127.f);
        unsigned* o4 = (unsigned*)(xq + (size_t)row * D_MODEL) + lane;
#pragma unroll
        for (int j = 0; j < 16; ++j) { const int q0 = (int)__builtin_rintf(bflo(w[j][0]) * inv), q1 = (int)__builtin_rintf(bfhi(w[j][0]) * inv), q2 = (int)__builtin_rintf(bflo(w[j][1]) * inv), q3 = (int)__builtin_rintf(bfhi(w[j][1]) * inv);
            o4[64 * j] = ((unsigned)q0 & 0xffu) | (((unsigned)q1 & 0xffu) << 8) | (((unsigned)q2 & 0xffu) << 16) | ((unsigned)q3 << 24); }
    }
}
struct FRow { uint2 x[16]; };
__device__ __forceinline__ void frow_load(FRow& R, const bf16* xb, int row, int lane) { const uint2* xr = (const uint2*)(xb + (size_t)row * D_MODEL) + lane;
#pragma unroll
    for (int k = 0; k < 16; ++k) R.x[k] = xr[64 * k]; }
__device__ __forceinline__ void frow_store(const FRow& R, float* out, const unsigned long long* rowss, const float* g, int row, int lane) {
    const float rstd = rsqrtf((float)rowss[row] * (1.f / (16777216.f * D_MODEL)) + NORM_EPS);
    f32x4* orow = (f32x4*)(out + (size_t)row * D_MODEL) + lane; const f32x4* gr = (const f32x4*)g + lane;
#pragma unroll
    for (int k = 0; k < 16; ++k) { const f32x4 ga = gr[64 * k];
        orow[64 * k] = (f32x4){bflo(R.x[k].x) * rstd * ga.x, bfhi(R.x[k].x) * rstd * ga.y, bflo(R.x[k].y) * rstd * ga.z, bfhi(R.x[k].y) * rstd * ga.w}; }
}
__device__ __forceinline__ void phase_final(const bf16* xb, float* out, const unsigned long long* rowss, const float* g, int gw, int NGW, int lane) {
    int row = gw; if (row >= M_TOK) return;
    FRow A, B; frow_load(A, xb, row, lane);
    for (;;) {
        const int r1 = row + NGW; const bool h1 = r1 < M_TOK; if (h1) frow_load(B, xb, r1, lane);
        frow_store(A, out, rowss, g, row, lane);
        if (!h1) break;
        const int r2 = r1 + NGW; const bool h2 = r2 < M_TOK; if (h2) frow_load(A, xb, r2, lane);
        frow_store(B, out, rowss, g, r1, lane);
        if (!h2) break;
        row = r2;
    }
}
constexpr int SGU_STRIDE = 320, SGU_SLOT = CHUNK * SGU_STRIDE;
typedef short sg_bf16x8 __attribute__((ext_vector_type(8)));
typedef short sg_s16x4 __attribute__((ext_vector_type(4)));
typedef float sg_f32x16 __attribute__((ext_vector_type(16)));
__device__ __forceinline__ void phase_sgu(const bf16* Z, const float* sgug, const float* Ws, const float* bs, const float* mixg, bf16* Mx, LAS unsigned char* lds, int blk, int G, int tid, int wv) {
    const int lane = tid & 63, h = lane >> 5, l31 = lane & 31;
    const int uh = wv >> 2, tt = wv & 3;
    const int srow = tid >> 2, sq = tid & 3;
    for (int wq = blk; wq < 256; wq += G) {
        const int g = wq & 15, cq = wq >> 4;
        sg_bf16x8 wf[8];
        { const int t = 32 * tt + l31; const float* wrow = Ws + ((size_t)g * CHUNK + t) * CHUNK;
#pragma unroll
          for (int ks = 0; ks < 8; ++ks) { wf[ks] = sg_bf16x8{0, 0, 0, 0, 0, 0, 0, 0};
              if (ks <= 2 * tt + 1) { const int s0 = 16 * ks + 8 * h; const f32x4 a = *(const f32x4*)(wrow + s0), b = *(const f32x4*)(wrow + s0 + 4);
                  float v[8] = {a.x, a.y, a.z, a.w, b.x, b.y, b.z, b.w};
#pragma unroll
                  for (int e = 0; e < 8; ++e) v[e] = (s0 + e <= t) ? v[e] : 0.f;
                  v4u pk; pk.x = pk2(v[0], v[1]); pk.y = pk2(v[2], v[3]); pk.z = pk2(v[4], v[5]); pk.w = pk2(v[6], v[7]); wf[ks] = __builtin_bit_cast(sg_bf16x8, pk); } } }
        const float bias_t = bs[g * CHUNK + 32 * tt + l31];
        f32x4 sgv[8];
#pragma unroll
        for (int e = 0; e < 8; ++e) sgv[e] = *(const f32x4*)(sgug + g * 128 + sq * 32 + 4 * e);
        for (int rnd = 0; rnd < 2; ++rnd) {
            uint2 uu[4][4];
            { const bf16* up0 = Z + (size_t)((4 * cq + 2 * rnd + uh) * CHUNK + 32 * tt + l31) * N_IN + ZU + g * 128 + 4 * h;
#pragma unroll
              for (int ct = 0; ct < 4; ++ct)
#pragma unroll
                  for (int rq = 0; rq < 4; ++rq) uu[ct][rq] = *(const uint2*)(up0 + 32 * ct + 8 * rq); }
#pragma unroll
            for (int ub = 0; ub < 2; ++ub) { const int row0 = (4 * cq + 2 * rnd + ub) * CHUNK;
                const v4u* vp = (const v4u*)(Z + (size_t)(row0 + srow) * N_IN + ZV2 + g * 128 + sq * 32);
                v4u raw[4]; float x[32]; float ss = 0.f;
#pragma unroll
                for (int e = 0; e < 4; ++e) raw[e] = vp[e];
#pragma unroll
                for (int e = 0; e < 4; ++e) { x[8 * e + 0] = bflo(raw[e].x); x[8 * e + 1] = bfhi(raw[e].x); x[8 * e + 2] = bflo(raw[e].y); x[8 * e + 3] = bfhi(raw[e].y);
                    x[8 * e + 4] = bflo(raw[e].z); x[8 * e + 5] = bfhi(raw[e].z); x[8 * e + 6] = bflo(raw[e].w); x[8 * e + 7] = bfhi(raw[e].w); }
#pragma unroll
                for (int e = 0; e < 32; ++e) ss += x[e] * x[e];
                ss += lane_xor<1>(ss); ss += lane_xor<2>(ss);
                const float rstd = rsqrtf(ss * (1.f / 128.f) + NORM_EPS);
                LAS v4u* dst = (LAS v4u*)(lds + ub * SGU_SLOT + srow * SGU_STRIDE + sq * 64);
#pragma unroll
                for (int e = 0; e < 4; ++e) { v4u o; const f32x4 s0 = sgv[2 * e], s1 = sgv[2 * e + 1];
                    o.x = pk2(x[8 * e + 0] * rstd * s0.x, x[8 * e + 1] * rstd * s0.y); o.y = pk2(x[8 * e + 2] * rstd * s0.z, x[8 * e + 3] * rstd * s0.w);
                    o.z = pk2(x[8 * e + 4] * rstd * s1.x, x[8 * e + 5] * rstd * s1.y); o.w = pk2(x[8 * e + 6] * rstd * s1.z, x[8 * e + 7] * rstd * s1.w); dst[e] = o; } }
            __syncthreads();
            sg_f32x16 acc[4];
#pragma unroll
            for (int ct = 0; ct < 4; ++ct) acc[ct] = sg_f32x16{};
            { const int g4 = lane >> 4, i16 = lane & 15, q = i16 >> 2, p = i16 & 3;
              const int abase = (int)(uintptr_t)(lds + uh * SGU_SLOT) + (8 * h + q) * SGU_STRIDE + (16 * (g4 & 1) + 4 * p) * 2;
#pragma unroll
              for (int ks = 0; ks < 8; ++ks) {
                  if (ks <= 2 * tt + 1) {
#pragma unroll
                      for (int ct = 0; ct < 4; ++ct) { sg_s16x4 lo, hi;
                          asm volatile("ds_read_b64_tr_b16 %0, %1 offset:%2" : "=&v"(lo) : "v"(abase), "i"(16 * ks * SGU_STRIDE + ct * 64) : "memory");
                          asm volatile("ds_read_b64_tr_b16 %0, %1 offset:%2" : "=&v"(hi) : "v"(abase), "i"(16 * ks * SGU_STRIDE + 4 * SGU_STRIDE + ct * 64) : "memory");
                          asm volatile("s_waitcnt lgkmcnt(0)" ::: "memory"); __builtin_amdgcn_sched_barrier(0);
                          acc[ct] = __builtin_amdgcn_mfma_f32_32x32x16_bf16((sg_bf16x8){lo[0], lo[1], lo[2], lo[3], hi[0], hi[1], hi[2], hi[3]}, wf[ks], acc[ct], 0, 0, 0); } } } }
            { const int row = (4 * cq + 2 * rnd + uh) * CHUNK + 32 * tt + l31;
              const float* mg = mixg + D_ATTN + g * 128 + 4 * h;
              float ss = 0.f;
#pragma unroll
              for (int ct = 0; ct < 4; ++ct)
#pragma unroll
                  for (int rq = 0; rq < 4; ++rq) { const uint2 uv = uu[ct][rq];
                      const float u0 = bflo(uv.x), u1 = bfhi(uv.x), u2 = bflo(uv.y), u3 = bfhi(uv.y);
                      float o0 = u0 * (acc[ct][4 * rq + 0] + bias_t), o1 = u1 * (acc[ct][4 * rq + 1] + bias_t), o2 = u2 * (acc[ct][4 * rq + 2] + bias_t), o3 = u3 * (acc[ct][4 * rq + 3] + bias_t);
                      acc[ct][4 * rq + 0] = o0; acc[ct][4 * rq + 1] = o1; acc[ct][4 * rq + 2] = o2; acc[ct][4 * rq + 3] = o3; ss += (o0 * o0 + o1 * o1) + (o2 * o2 + o3 * o3); }
              { float sa = ss, sb = ss; half_swap(sa, sb); ss = sa + sb; }
              const float rstd = rsqrtf(ss * (1.f / 128.f) + NORM_EPS);
              bf16* op = Mx + (size_t)row * D_MODEL + D_ATTN + g * 128 + 4 * h;
#pragma unroll
              for (int ct = 0; ct < 4; ++ct)
#pragma unroll
                  for (int rq = 0; rq < 4; ++rq) { const f32x4 mm = *(const f32x4*)(mg + 32 * ct + 8 * rq);
                      uint2 w; w.x = pk2(acc[ct][4 * rq + 0] * rstd * mm.x, acc[ct][4 * rq + 1] * rstd * mm.y); w.y = pk2(acc[ct][4 * rq + 2] * rstd * mm.z, acc[ct][4 * rq + 3] * rstd * mm.w);
                      *(uint2*)(op + 32 * ct + 8 * rq) = w; } }
            __syncthreads();
        }
    }
}
__device__ __forceinline__ void phase_convfix(const float* U4, const float* cw, const float* cb, bf16* ACT, size_t gtid, size_t nthreads) {
    constexpr int per_row = D_FF / 4, NB = M_TOK / 64; const size_t total = (size_t)NB * per_row;
    for (size_t i = gtid; i < total; i += nthreads) {
        const int blk64 = (int)(i / per_row), c = (int)(i % per_row) * 4;
        if ((blk64 & (SEQ / 64 - 1)) == 0) continue;
        const float* um2 = U4 + ((size_t)(blk64 - 1) * 4 + 2) * N_UP; const float* um1 = um2 + N_UP; const float* u0 = U4 + (size_t)blk64 * 4 * N_UP; const float* u1 = u0 + N_UP;
        f32x4 y0[2], y1[2];
#pragma unroll
        for (int hv = 0; hv < 2; ++hv) { const int cc = hv * D_FF + c;
            const f32x4 a = *(const f32x4*)(um2 + cc), b = *(const f32x4*)(um1 + cc), x0 = *(const f32x4*)(u0 + cc), x1 = *(const f32x4*)(u1 + cc);
            const f32x4 w0 = *(const f32x4*)(cw + cc), w1 = *(const f32x4*)(cw + N_UP + cc), w2 = *(const f32x4*)(cw + 2 * N_UP + cc), bb = *(const f32x4*)(cb + cc);
#pragma unroll
            for (int e = 0; e < 4; ++e) { y0[hv][e] = fmaf(w0[e], a[e], fmaf(w1[e], b[e], fmaf(w2[e], x0[e], bb[e]))); y1[hv][e] = fmaf(w0[e], b[e], fmaf(w1[e], x0[e], fmaf(w2[e], x1[e], bb[e]))); } }
        float r0[4], r1[4];
#pragma unroll
        for (int e = 0; e < 4; ++e) { const float g0 = y0[0][e], g1 = y1[0][e]; r0[e] = g0 / (1.f + __expf(-g0)) * y0[1][e]; r1[e] = g1 / (1.f + __expf(-g1)) * y1[1][e]; }
        uint2 o; o.x = pk2(r0[0], r0[1]); o.y = pk2(r0[2], r0[3]);
        *(uint2*)(ACT + (size_t)(blk64 * 64) * D_FF + c) = o;
        o.x = pk2(r1[0], r1[1]); o.y = pk2(r1[2], r1[3]);
        *(uint2*)(ACT + (size_t)(blk64 * 64 + 1) * D_FF + c) = o;
    }
}
typedef attn::BlockRef<bf16, bf16> ABlock;
__device__ __forceinline__ ABlock attn_ref(int L, const bf16* Z, bf16* OC, float* LSE) {
    const int c = L >> 9, x = L & 511; const int bh = (x & 7) + 8 * ((x >> 3) & 3), bi = x >> 5;
    const int d = (c == 0) ? 1 : ((c == 1) ? 4 : 16);
    const int r = (c == 0) ? 0 : ((c == 1) ? (bi >> 2) : bi), qb = (c == 0) ? bi : ((c == 1) ? (bi & 3) : 0);
    const int b = bh >> 4, h = bh & 15; const int P0 = qb * attn::QB;
    const size_t row0 = (size_t)b * SEQ + r, rowq = row0 + (size_t)P0 * d;
    ABlock R;
    R.Q = Z + rowq * N_IN + ZQ + h * HEAD_DIM; R.K = Z + row0 * N_IN + ZK + h * HEAD_DIM; R.V = Z + row0 * N_IN + ZV + h * HEAD_DIM;
    R.O = OC + (size_t)c * M_TOK * D_ATTN + rowq * D_ATTN + h * HEAD_DIM; R.L = LSE + (size_t)c * M_TOK * NH + rowq * NH + h;
    R.P0 = P0; R.pitch = d * N_IN; R.opitch = d * D_ATTN; R.lpitch = d * NH;
    { const int j2 = 6 - h + ((c == 0) ? 0 : ((c == 1) ? 4 : 8)); const int n = j2 >> 1;
      R.beta = __builtin_bit_cast(float, (unsigned)(((127 + n) << 23) | ((j2 & 1) ? 0x3504F3 : 0))); }
    return R;
}
__device__ __forceinline__ int attn_skv(int L) { return (L < 512) ? SEQ : ((L < 1024) ? SEQ / 4 : SEQ / 16); }
__device__ __forceinline__ void phase_attn(const bf16* Z, bf16* OC, float* LSE, char* lds, int blk, int G, const int wv) {
    constexpr int TOTAL = 3 * 512, W = 129;
    int L = blk; if (L >= TOTAL) return;
    ABlock cur = attn_ref(L, Z, OC, LSE);
    attn::Seam<bf16> S;
    attn::causal_swa_prime<bf16, bf16>(cur, W, lds, S, wv);
    for (;;) {
        const int Ln = L + G; const bool last = Ln >= TOTAL;
        const ABlock nxt = last ? cur : attn_ref(Ln, Z, OC, LSE);
        attn::causal_swa_block<bf16, bf16>(cur, nxt, attn_skv(L), W, lds, S, wv);
        if (last) break;
        cur = nxt; L = Ln;
    }
}
struct CRows { v4u a[2][3]; float ls[2][3]; };
__device__ __forceinline__ void phase_combine(const bf16* OC, const float* LSE, const float* mixg, bf16* Mx, int gw, int NGW, int lane) {
    const int hq = gw & 3, h = hq * 4 + (lane >> 4), col = h * HEAD_DIM + 8 * (lane & 15);
    const f32x4 g0 = *(const f32x4*)(mixg + col), g1 = *(const f32x4*)(mixg + col + 4);
    constexpr size_t SO = (size_t)M_TOK * D_ATTN, SL = (size_t)M_TOK * NH;
    const int step = NGW >> 2;
    auto load = [&](CRows& R, int row) { const int row2 = row + step; const int rb = row2 < M_TOK ? row2 : row;
#pragma unroll
        for (int u = 0; u < 2; ++u) { const int r = u ? rb : row;
#pragma unroll
            for (int c = 0; c < 3; ++c) { R.a[u][c] = *(const v4u*)(OC + c * SO + (size_t)r * D_ATTN + col); R.ls[u][c] = LSE[c * SL + (size_t)r * NH + h]; } } };
    auto finish = [&](const CRows& R, int row) { const int row2 = row + step; const bool two = row2 < M_TOK; const int rb = two ? row2 : row;
#pragma unroll
        for (int u = 0; u < 2; ++u) { const int r = u ? rb : row;
            const float mx = fmaxf(R.ls[u][0], fmaxf(R.ls[u][1], R.ls[u][2])); float w0 = __expf(R.ls[u][0] - mx), w1 = __expf(R.ls[u][1] - mx), w2 = __expf(R.ls[u][2] - mx); const float inv = 1.f / (w0 + w1 + w2);
            w0 *= inv; w1 *= inv; w2 *= inv;
            float o[8]; const unsigned* pa = (const unsigned*)&R.a[u][0]; const unsigned* pb = (const unsigned*)&R.a[u][1]; const unsigned* pc = (const unsigned*)&R.a[u][2]; float ss = 0.f;
#pragma unroll
            for (int e = 0; e < 4; ++e) { o[2 * e] = w0 * bflo(pa[e]) + w1 * bflo(pb[e]) + w2 * bflo(pc[e]); o[2 * e + 1] = w0 * bfhi(pa[e]) + w1 * bfhi(pb[e]) + w2 * bfhi(pc[e]); ss += o[2 * e] * o[2 * e] + o[2 * e + 1] * o[2 * e + 1]; }
            ss += lane_xor<1>(ss); ss += lane_xor<2>(ss); ss += lane_xor<4>(ss); ss += lane_xor<8>(ss);
            const float rstd = rsqrtf(ss * (1.f / HEAD_DIM) + NORM_EPS);
            v4u w; w.x = pk2(o[0] * rstd * g0.x, o[1] * rstd * g0.y); w.y = pk2(o[2] * rstd * g0.z, o[3] * rstd * g0.w); w.z = pk2(o[4] * rstd * g1.x, o[5] * rstd * g1.y); w.w = pk2(o[6] * rstd * g1.z, o[7] * rstd * g1.w);
            if (u == 0 || two) *(v4u*)(Mx + (size_t)r * D_MODEL + col) = w; } };
    int row = gw >> 2; if (row >= M_TOK) return;
    CRows A, B; load(A, row);
    for (;;) {
        const int r1 = row + 2 * step; const bool h1 = r1 < M_TOK; if (h1) load(B, r1);
        finish(A, row);
        if (!h1) break;
        const int r2 = r1 + 2 * step; const bool h2 = r2 < M_TOK; if (h2) load(A, r2);
        finish(B, r1);
        if (!h2) break;
        row = r2;
    }
}

struct Args { const float* in[14]; float* out; unsigned char* ws; };
typedef const __attribute__((address_space(4))) Args* KArgs;
__global__ void __launch_bounds__(NTHREADS, 2) mega_fwd(Args args) {
    extern __shared__ __attribute__((aligned(16))) unsigned char lds_raw[];
    LAS unsigned char* lds = (LAS unsigned char*)lds_raw;
    volatile LAS unsigned* MISC = (volatile LAS unsigned*)(lds + MISC_OFF);
    const int wv = __builtin_amdgcn_readfirstlane((int)(threadIdx.x >> 6));
    { const int t0 = tid_of(wv); if (t0 < 32) MISC[t0] = 0u; }
    __syncthreads();
#define PHASE_BEGIN() KArgs ka = (KArgs)__builtin_amdgcn_kernarg_segment_ptr(); asm volatile("" : "+s"(ka)); unsigned char* const ws = ka->ws; int wvp = wv; asm volatile("" : "+s"(wvp)); \
    const int tid = tid_of(wvp); const int lane = tid & 63, wave = wvp; int blk_o = blockIdx.x; asm volatile("" : "+s"(blk_o)); int lyr = l; asm volatile("" : "+s"(lyr)); \
    const int G = gridDim.x, blk = blk_o, gw = blk * NWAVES + wave, NGW = G * NWAVES; (void)lane; (void)gw; (void)NGW; (void)blk; (void)G; (void)tid; (void)ws; (void)lyr
#define WSP(T, off) ((T*)(ws + (off)))
#define GRID_BARRIER() do { KArgs kb = (KArgs)__builtin_amdgcn_kernarg_segment_ptr(); asm volatile("" : "+s"(kb)); XcdBarrier bar; bar.bar = (unsigned*)(kb->ws + OFF_CTL); bar.x = xcc; bar.st = MISC + 8; xcd_barrier(bar, wv); } while (0)
    const unsigned xcc = xcd_barrier_post((unsigned*)(args.ws + OFF_CTL), MISC + 8, wv).x;

    { const int l = 0; PHASE_BEGIN();
      phase_xprep(ka->in[0], WSP(bf16, OFF_H), WSP(unsigned long long, OFF_RS), WSP(signed char, OFF_XQ), WSP(float, OFF_SA), gw, NGW, lane);
      phase_strips8(ka->in[9], ka->in[8], WSP(signed char, OFF_WUP), WSP(float, OFF_SB), ka->in[2], ka->in[1], WSP(signed char, OFF_WINQ), WSP(float, OFF_SBIN), lds, blk, G, wave, lane); }
    __syncthreads();
    { const int l = 0; PHASE_BEGIN();
      for (int cl = 0; cl < DEPTH; ++cl) {
        phase_convert(ka->in[2] + (size_t)cl * D_MODEL * N_IN + NQ8, D_MODEL, N_IN - NQ8, WSP(bf16, OFF_WIN) + (size_t)cl * N_IN * D_MODEL + (size_t)NQ8 * D_MODEL, lds, gw, NGW, wave, lane, ka->in[1] + (size_t)cl * D_MODEL, false, N_IN);
        phase_convert(ka->in[7] + (size_t)cl * D_MODEL * D_MODEL, D_MODEL, D_MODEL, WSP(bf16, OFF_WOUT) + (size_t)cl * D_MODEL * D_MODEL, lds, gw, NGW, wave, lane, nullptr);
        phase_convert(ka->in[12] + (size_t)cl * D_FF * D_MODEL, D_FF, D_MODEL, WSP(bf16, OFF_WDN) + (size_t)cl * D_MODEL * D_FF, lds, gw, NGW, wave, lane, nullptr);
      } }
    GRID_BARRIER();

    for (int l = 0; l < DEPTH; ++l) {
        { PHASE_BEGIN();
          pg8::Gemm g{(const bf16*)WSP(signed char, OFF_XQ), (const bf16*)(WSP(signed char, OFF_WINQ) + (size_t)lyr * NQ8 * D_MODEL), M_TOK, NQ8, D_MODEL / 2}; pg8::StaticOrder S; S.init(M_TOK, NQ8, G, blk);
          pg8::EpiIn8 E{pg8::EpiIn{WSP(bf16, OFF_Z), (long)N_IN, 24, WSP(unsigned long long, OFF_RS) + (size_t)(2 * lyr) * M_TOK, 1.f / (16777216.f * D_MODEL), NORM_EPS}, WSP(float, OFF_SA), WSP(float, OFF_SBIN) + (size_t)lyr * NQ8};
          pg8::gemm_phase<pg8::EpiIn8, pg8::StaticOrder, true, true>(lds, g, S, E, wvp); }
        __syncthreads();
        { PHASE_BEGIN();
          pg8::Gemm g{WSP(bf16, OFF_H), WSP(bf16, OFF_WIN) + (size_t)lyr * N_IN * D_MODEL + (size_t)NQ8 * D_MODEL, M_TOK, N_IN - NQ8, D_MODEL}; pg8::StaticOrder S; S.init(M_TOK, N_IN - NQ8, G, blk);
          pg8::EpiIn E{WSP(bf16, OFF_Z) + NQ8, (long)N_IN, 24 - NQ8 / 256, WSP(unsigned long long, OFF_RS) + (size_t)(2 * lyr) * M_TOK, 1.f / (16777216.f * D_MODEL), NORM_EPS};
          pg8::gemm_phase<pg8::EpiIn, pg8::StaticOrder, true, true>(lds, g, S, E, wvp); }
        GRID_BARRIER();
        { PHASE_BEGIN();
          phase_attn(WSP(bf16, OFF_Z), WSP(bf16, OFF_OC), WSP(float, OFF_LSE), (char*)lds_raw, blk, G, wvp); }
        __syncthreads();
        { PHASE_BEGIN();
          phase_sgu(WSP(bf16, OFF_Z), ka->in[3] + (size_t)lyr * D_SGU, ka->in[4] + (size_t)lyr * NG * CHUNK * CHUNK, ka->in[5] + (size_t)lyr * NG * CHUNK, ka->in[6] + (size_t)lyr * D_MODEL, WSP(bf16, OFF_MX), lds, blk, G, tid, wvp); }
        GRID_BARRIER();
        { PHASE_BEGIN(); phase_combine(WSP(bf16, OFF_OC), WSP(float, OFF_LSE), ka->in[6] + (size_t)lyr * D_MODEL, WSP(bf16, OFF_MX), gw, NGW, lane); }
        GRID_BARRIER();
        { PHASE_BEGIN();
          pg8::Gemm g{WSP(bf16, OFF_MX), WSP(bf16, OFF_WOUT) + (size_t)lyr * D_MODEL * D_MODEL, M_TOK, D_MODEL, D_MODEL}; pg8::StaticOrder S; S.init(M_TOK, D_MODEL, G, blk);
          pg8::EpiRes E{WSP(bf16, OFF_H), WSP(unsigned long long, OFF_RS) + (size_t)(2 * lyr + 1) * M_TOK, (long)D_MODEL};
          pg8::gemm_phase<pg8::EpiRes, pg8::StaticOrder, true, true>(lds, g, S, E, wvp); }
        GRID_BARRIER();
        { PHASE_BEGIN(); phase_quant_rows(WSP(bf16, OFF_H), WSP(signed char, OFF_XQ), WSP(float, OFF_SA), gw, NGW, lane); }
        GRID_BARRIER();
        { PHASE_BEGIN();
          pg8::Gemm g{(const bf16*)WSP(signed char, OFF_XQ), (const bf16*)(WSP(signed char, OFF_WUP) + (size_t)lyr * N_UP * D_MODEL), M_TOK, N_UP, D_MODEL / 2}; pg8::StaticOrder S; S.init(M_TOK, N_UP, G, blk);
          pg8::EpiConv8 E{pg8::EpiConv{WSP(bf16, OFF_ACT), WSP(float, OFF_U4), ka->in[10] + (size_t)lyr * 3 * N_UP, ka->in[11] + (size_t)lyr * N_UP, (long)D_FF, WSP(unsigned long long, OFF_RS) + (size_t)(2 * lyr + 1) * M_TOK, 1.f / (16777216.f * D_MODEL), NORM_EPS},
                            WSP(float, OFF_SA), WSP(float, OFF_SB) + (size_t)lyr * N_UP};
          pg8::gemm_phase<pg8::EpiConv8, pg8::StaticOrder, true, true>(lds, g, S, E, wvp); }
        GRID_BARRIER();
        { PHASE_BEGIN(); phase_convfix(WSP(float, OFF_U4), ka->in[10] + (size_t)lyr * 3 * N_UP, ka->in[11] + (size_t)lyr * N_UP, WSP(bf16, OFF_ACT), (size_t)blk * NTHREADS + tid, (size_t)G * NTHREADS); }
        GRID_BARRIER();
        { PHASE_BEGIN();
          pg8::Gemm g{WSP(bf16, OFF_ACT), WSP(bf16, OFF_WDN) + (size_t)lyr * D_MODEL * D_FF, M_TOK, D_MODEL, D_FF}; pg8::StaticOrder S; S.init(M_TOK, D_MODEL, G, blk);
          pg8::EpiRes E{WSP(bf16, OFF_H), WSP(unsigned long long, OFF_RS) + (size_t)(2 * lyr + 2) * M_TOK, (long)D_MODEL};
          pg8::gemm_phase<pg8::EpiRes, pg8::StaticOrder, true, true>(lds, g, S, E, wvp); }
        GRID_BARRIER();
        if (l + 1 < DEPTH) {
            { PHASE_BEGIN(); phase_quant_rows(WSP(bf16, OFF_H), WSP(signed char, OFF_XQ), WSP(float, OFF_SA), gw, NGW, lane); }
            GRID_BARRIER();
        }
    }
    { const int l = 0; PHASE_BEGIN(); phase_final(WSP(bf16, OFF_H), ka->out, WSP(unsigned long long, OFF_RS) + (size_t)(2 * DEPTH) * M_TOK, ka->in[13], gw, NGW, lane); }
#undef PHASE_BEGIN
#undef WSP
#undef GRID_BARRIER
}

extern "C" void kernel_launch(void* const* d_in, const int* in_sizes, int n_in, void* d_out, int out_size, void* d_ws, size_t ws_size, hipStream_t stream) {
    static int grid = 0;
    if (grid == 0) {
        if (n_in != 14 || out_size != M_TOK * D_MODEL || ws_size < WS_END) { fprintf(stderr, "kernel_launch: unexpected shapes (n_in %d out %d ws %zu need %zu)\n", n_in, out_size, ws_size, (size_t)WS_END); grid = -1; return; }
        int dev = 0, cus = 0, per_cu = 0;
        if (hipGetDevice(&dev) != hipSuccess || hipDeviceGetAttribute(&cus, hipDeviceAttributeMultiprocessorCount, dev) != hipSuccess) { grid = -1; return; }
        if (hipFuncSetAttribute((const void*)mega_fwd, hipFuncAttributeMaxDynamicSharedMemorySize, LDS_BYTES) != hipSuccess) { fprintf(stderr, "kernel_launch: hipFuncSetAttribute failed\n"); grid = -1; return; }
        if (hipOccupancyMaxActiveBlocksPerMultiprocessor(&per_cu, (const void*)mega_fwd, NTHREADS, LDS_BYTES) != hipSuccess || per_cu < 1) { fprintf(stderr, "kernel_launch: occupancy query says %d blocks per CU\n", per_cu); grid = -1; (void)hipGetLastError(); return; }
        grid = cus;
    }
    if (grid < 0) return;
    (void)hipMemsetAsync((char*)d_ws + OFF_CTL, 0, CTL_BYTES, stream);
    Args a{};
    for (int i = 0; i < 14; ++i) a.in[i] = (const float*)d_in[i];
    a.out = (float*)d_out; a.ws = (unsigned char*)d_ws;
    hipLaunchKernelGGL(mega_fwd, dim3(grid), dim3(NTHREADS), LDS_BYTES, stream, a);
}
```
